# Optimizing an MI355X kernel written in HIP

```python
import jax
import jax.numpy as jnp
from jax import lax
import numpy as np

D_MODEL = 1024
BATCH = 4
SEQ = 4096
DEPTH = 1
DEC_BATCH = 128
DEC_SEQ = 1
PAST_LEN = 2048
PAGE_SIZE = 128

HEAD_DIM = 64
DN_HEADS = 8
NSA_HEADS = 8
NSA_KV_HEADS = 2
NSA_GROUP = NSA_HEADS // NSA_KV_HEADS
DN_WIDTH = DN_HEADS * HEAD_DIM
NSA_WIDTH = NSA_HEADS * HEAD_DIM
MIX_WIDTH = DN_WIDTH + NSA_WIDTH
CONV_WIDTH = 4
DN_CONV_DIM = 3 * DN_WIDTH
DN_CHUNK = 64
CMP_BLOCK = 64
SEL_BLOCK = 64
TOP_N = 16
N_LOCAL_BLOCKS = 2
WINDOW = 512
CMP_HIDDEN = 128
Q_BLOCK = 128
NSA_KV_KINDS = 6
MEM_LEN = 256
MEM_HEADS = 4
MEM_HEAD_DIM = D_MODEL // MEM_HEADS
D_FF = 4 * D_MODEL
RMS_EPS = 1e-6
FORCE_SCORE = 1e3
NEG_INF = -1e30
ATTN_SCALE = HEAD_DIM ** -0.5

OFF_DN_QKV = 0
OFF_DN_Z = OFF_DN_QKV + DN_CONV_DIM
OFF_DN_B = OFF_DN_Z + DN_WIDTH
OFF_DN_A = OFF_DN_B + DN_HEADS
OFF_NSA_Q = OFF_DN_A + DN_HEADS
OFF_NSA_KV = OFF_NSA_Q + NSA_WIDTH
OFF_NSA_G = OFF_NSA_KV + NSA_KV_KINDS * NSA_KV_HEADS * HEAD_DIM
IN_COLS = OFF_NSA_G + 3 * NSA_HEADS

kernel_name = 'hymba_deltanet_nsa_decode_step'


def rms_norm(x, gain):
    xf = x.astype(jnp.float32)
    y = xf * lax.rsqrt(jnp.mean(xf * xf, axis=-1, keepdims=True) + RMS_EPS)
    return (y * gain.astype(jnp.float32)).astype(x.dtype)


def masked_softmax(s, mask):
    s = jnp.where(mask, s.astype(jnp.float32), NEG_INF)
    p = jnp.where(mask, jnp.exp(s - jnp.max(s, axis=-1, keepdims=True)), 0.0)
    return p / jnp.maximum(jnp.sum(p, axis=-1, keepdims=True), 1e-30)


def l2_normalize(x):
    return x * lax.rsqrt(jnp.sum(x * x, axis=-1, keepdims=True) + 1e-6)


def causal_depthwise_conv(x_ext, w):
    return lax.conv_general_dilated(
        x_ext, w[:, None, :].astype(x_ext.dtype), window_strides=(1,), padding='VALID',
        dimension_numbers=('NWC', 'WIO', 'NWC'), feature_group_count=x_ext.shape[-1])


def gated_delta_chunked(q, k, v, g, beta, s0):
    B, T, H, _ = q.shape
    C = min(DN_CHUNK, T)
    n = -(-T // C)
    pad = n * C - T

    def to_chunks(a):
        a = jnp.pad(a, [(0, 0), (0, pad)] + [(0, 0)] * (a.ndim - 2))
        a = a.reshape((B, n, C) + a.shape[2:])
        return jnp.swapaxes(jnp.moveaxis(a, 1, 0), 2, 3)

    qc, kc, vc, gc, bc = (to_chunks(a) for a in (q, k, v, g, beta))
    gcum = jnp.cumsum(gc, axis=-1)
    pos = jnp.arange(C)
    incl = pos[:, None] >= pos[None, :]
    strict = pos[:, None] > pos[None, :]
    decay = jnp.exp(jnp.where(incl, gcum[..., :, None] - gcum[..., None, :], NEG_INF))
    kb = kc * bc[..., None]
    a = jnp.where(strict, jnp.einsum('nbhid,nbhjd->nbhij', kb, kc) * decay, 0.0)
    m = a + jnp.eye(C, dtype=a.dtype)
    u = lax.linalg.triangular_solve(m, vc * bc[..., None], left_side=True, lower=True, unit_diagonal=True)
    w = lax.linalg.triangular_solve(m, kb * jnp.exp(gcum)[..., None], left_side=True, lower=True,
                                    unit_diagonal=True)
    aqk = jnp.where(incl, jnp.einsum('nbhid,nbhjd->nbhij', qc, kc) * decay, 0.0)

    def step(S, inp):
        q_i, k_i, u_i, w_i, g_i, aqk_i = inp
        v_new = u_i - jnp.einsum('bhck,bhkv->bhcv', w_i, S)
        o_i = (jnp.einsum('bhck,bhkv->bhcv', q_i * jnp.exp(g_i)[..., None], S)
               + jnp.einsum('bhij,bhjv->bhiv', aqk_i, v_new))
        g_last = g_i[..., -1:]
        S = (S * jnp.exp(g_last)[..., None]
             + jnp.einsum('bhck,bhcv->bhkv', k_i * jnp.exp(g_last - g_i)[..., None], v_new))
        return S, o_i

    s_final, o = lax.scan(step, s0, (qc, kc, u, w, gcum, aqk))
    o = jnp.moveaxis(jnp.swapaxes(o, 2, 3), 0, 1).reshape(B, n * C, H, -1)[:, :T]
    return o, s_final


def deltanet_mixer(p_qkv, p_z, p_b, p_a, conv_state, rec_state, conv_w, a_log, dt_bias, norm_gain):
    B, T, _ = p_qkv.shape
    x_ext = jnp.concatenate([conv_state.astype(p_qkv.dtype), p_qkv], axis=1)
    c = jax.nn.silu(causal_depthwise_conv(x_ext, conv_w).astype(jnp.float32))
    c = c.reshape(B, T, 3, DN_HEADS, HEAD_DIM)
    q = l2_normalize(c[:, :, 0]) * HEAD_DIM ** -0.5
    k = l2_normalize(c[:, :, 1])
    v = c[:, :, 2]
    beta = jax.nn.sigmoid(p_b.astype(jnp.float32))
    g = -jnp.exp(a_log.astype(jnp.float32)) * jax.nn.softplus(
        p_a.astype(jnp.float32) + dt_bias.astype(jnp.float32))
    o, new_rec = gated_delta_chunked(q, k, v, g, beta, rec_state.astype(jnp.float32))
    z = p_z.astype(jnp.float32).reshape(B, T, DN_HEADS, HEAD_DIM)
    o = rms_norm(o, norm_gain) * jax.nn.silu(z)
    return o.reshape(B, T, DN_WIDTH).astype(p_qkv.dtype), x_ext[:, -(CONV_WIDTH - 1):], new_rec


def compress_blocks(k, pe, w1, b1, w2):
    B, T, G, dh = k.shape
    nb = T // CMP_BLOCK
    kb = k[:, :nb * CMP_BLOCK].reshape(B, nb, CMP_BLOCK, G, dh) + pe[:, None, :]
    flat = kb.transpose(0, 1, 3, 2, 4).reshape(B, nb, G, CMP_BLOCK * dh)
    return jax.nn.relu(flat @ w1 + b1) @ w2


def slc_win_block(qg_t, q_pos, sel_idx, kv_slc, kv_win, win_pos):
    B, G, Sq, n = sel_idx.shape
    bi = jnp.arange(B)[:, None, None, None]
    gi = jnp.arange(G)[None, :, None, None]
    kv = kv_slc[bi, gi, sel_idx].reshape(B, G, Sq, n * SEL_BLOCK, 2, HEAD_DIM)
    kpos = (sel_idx[..., None] * SEL_BLOCK + jnp.arange(SEL_BLOCK)).reshape(B, G, Sq, n * SEL_BLOCK)
    s = jnp.einsum('bgrqd,bgqkd->bgrqk', qg_t, kv[..., 0, :], preferred_element_type=jnp.float32) * ATTN_SCALE
    p = masked_softmax(s, (kpos <= q_pos[None, None, :, None])[:, :, None])
    o_slc = jnp.einsum('bgrqk,bgqkd->bqgrd', p, kv[..., 1, :].astype(jnp.float32))
    s = jnp.einsum('bgrqd,bkgd->bgrqk', qg_t, kv_win[:, :, 0], preferred_element_type=jnp.float32) * ATTN_SCALE
    dpos = q_pos[:, None] - win_pos[None, :]
    wmask = (dpos >= 0) & (dpos < WINDOW) & (win_pos >= 0)[None, :]
    p = masked_softmax(s, wmask)
    o_win = jnp.einsum('bgrqk,bkgd->bqgrd', p, kv_win[:, :, 1].astype(jnp.float32))
    return o_slc, o_win


def nsa_mixer(q, gate_logits, kv_all, win_ctx, q_pos, win_pos, banded, cmp_pe, cmp_w1, cmp_b1, cmp_w2):
    B, Sq, _, _ = q.shape
    T = kv_all.shape[1]
    k_cmp = compress_blocks(kv_all[:, :, 0], cmp_pe[0], cmp_w1[0], cmp_b1[0], cmp_w2[0])
    v_cmp = compress_blocks(kv_all[:, :, 1], cmp_pe[1], cmp_w1[1], cmp_b1[1], cmp_w2[1])
    nb = k_cmp.shape[1]
    qg = q.reshape(B, Sq, NSA_KV_HEADS, NSA_GROUP, HEAD_DIM)
    s = jnp.einsum('bqgrd,bngd->bgrqn', qg, k_cmp, preferred_element_type=jnp.float32) * ATTN_SCALE
    blk_end = (jnp.arange(nb) + 1) * CMP_BLOCK - 1
    p = masked_softmax(s, blk_end[None, :] <= q_pos[:, None])
    o_cmp = jnp.einsum('bgrqn,bngd->bqgrd', p, v_cmp.astype(jnp.float32))
    n_sel = -(-T // SEL_BLOCK)
    imp = jnp.pad(p.sum(axis=2), ((0, 0), (0, 0), (0, 0), (0, n_sel - nb)))
    blk = jnp.arange(n_sel)[None, :]
    cur = (q_pos // SEL_BLOCK)[:, None]
    valid = blk <= cur
    forced = valid & ((blk == 0) | (cur - blk < N_LOCAL_BLOCKS))
    score = jnp.where(valid, imp + jnp.where(forced, FORCE_SCORE, 0.0), -1.0)
    _, sel_idx = lax.top_k(score, min(TOP_N, n_sel))
    kv_slc = jnp.pad(kv_all[:, :, 2:4], ((0, 0), (0, n_sel * SEL_BLOCK - T), (0, 0), (0, 0), (0, 0)))
    kv_slc = kv_slc.reshape(B, n_sel, SEL_BLOCK, 2, NSA_KV_HEADS, HEAD_DIM).transpose(0, 4, 1, 2, 3, 5)
    qg_t = qg.transpose(0, 2, 3, 1, 4)
    if banded:
        nqb = Sq // Q_BLOCK
        kv_win_pad = jnp.pad(win_ctx, ((0, 0), (WINDOW, 0), (0, 0), (0, 0), (0, 0)))

        def body(args):
            qb, posb, idxb, start = args
            kvw = lax.dynamic_slice_in_dim(kv_win_pad, start, WINDOW + Q_BLOCK, axis=1)
            wpos = start - WINDOW + jnp.arange(WINDOW + Q_BLOCK)
            return slc_win_block(qb, posb, idxb, kv_slc, kvw, wpos)

        qb = qg_t.reshape(B, NSA_KV_HEADS, NSA_GROUP, nqb, Q_BLOCK, HEAD_DIM).transpose(3, 0, 1, 2, 4, 5)
        posb = q_pos.reshape(nqb, Q_BLOCK)
        idxb = sel_idx.reshape(B, NSA_KV_HEADS, nqb, Q_BLOCK, -1).transpose(2, 0, 1, 3, 4)
        starts = jnp.arange(nqb) * Q_BLOCK
        o_slc, o_win = lax.map(body, (qb, posb, idxb, starts))
        o_slc = jnp.moveaxis(o_slc, 0, 1).reshape(B, Sq, NSA_KV_HEADS, NSA_GROUP, HEAD_DIM)
        o_win = jnp.moveaxis(o_win, 0, 1).reshape(B, Sq, NSA_KV_HEADS, NSA_GROUP, HEAD_DIM)
    else:
        o_slc, o_win = slc_win_block(qg_t, q_pos, sel_idx, kv_slc, win_ctx, win_pos)
    gates = jax.nn.sigmoid(gate_logits.astype(jnp.float32)).reshape(B, Sq, NSA_KV_HEADS, NSA_GROUP, 3)
    o = gates[..., 0:1] * o_cmp + gates[..., 1:2] * o_slc + gates[..., 2:3] * o_win
    return o.reshape(B, Sq, NSA_WIDTH).astype(q.dtype)


def mem_cross_attn(h, mem_kv, w_q, w_o):
    B, T, _ = h.shape
    q = (h @ w_q).reshape(B, T, MEM_HEADS, MEM_HEAD_DIM)
    s = jnp.einsum('bthd,bmhd->bhtm', q, mem_kv[:, :, 0], preferred_element_type=jnp.float32) * MEM_HEAD_DIM ** -0.5
    p = jax.nn.softmax(s, axis=-1)
    o = jnp.einsum('bhtm,bmhd->bthd', p, mem_kv[:, :, 1].astype(jnp.float32))
    return o.reshape(B, T, MEM_HEADS * MEM_HEAD_DIM).astype(h.dtype) @ w_o


def trunk_layer(x, mem_kv, conv_state, rec_state, kv_past, win_past, q_pos, win_pos, win_keep, banded,
                ln_mix, w_in, dn_conv_w, dn_a_log, dn_dt_bias, dn_norm, cmp_pe, cmp_w1, cmp_b1, cmp_w2,
                w_out, ln_mem, w_mem_q, w_mem_o, ln_ffn, w_up, w_down):
    B, T, _ = x.shape
    proj = rms_norm(x, ln_mix) @ w_in
    dn_out, new_conv, new_rec = deltanet_mixer(
        proj[..., OFF_DN_QKV:OFF_DN_Z], proj[..., OFF_DN_Z:OFF_DN_B], proj[..., OFF_DN_B:OFF_DN_A],
        proj[..., OFF_DN_A:OFF_NSA_Q], conv_state, rec_state, dn_conv_w, dn_a_log, dn_dt_bias, dn_norm)
    q = proj[..., OFF_NSA_Q:OFF_NSA_KV].reshape(B, T, NSA_HEADS, HEAD_DIM)
    kv_new = proj[..., OFF_NSA_KV:OFF_NSA_G].reshape(B, T, NSA_KV_KINDS, NSA_KV_HEADS, HEAD_DIM)
    kv_rows = kv_new[:, :, :4]
    win_rows = kv_new[:, :, 4:]
    kv_all = kv_rows if kv_past is None else jnp.concatenate([kv_past.astype(kv_rows.dtype), kv_rows], axis=1)
    win_ctx = win_rows if win_past is None else jnp.concatenate([win_past.astype(win_rows.dtype), win_rows], axis=1)
    nsa_out = nsa_mixer(q, proj[..., OFF_NSA_G:], kv_all, win_ctx, q_pos, win_pos, banded,
                        cmp_pe, cmp_w1, cmp_b1, cmp_w2)
    x = x + jnp.concatenate([dn_out, nsa_out], axis=-1) @ w_out
    x = x + mem_cross_attn(rms_norm(x, ln_mem), mem_kv, w_mem_q, w_mem_o)
    x = x + jnp.square(jax.nn.relu(rms_norm(x, ln_ffn) @ w_up)) @ w_down
    return x, new_conv, new_rec, kv_rows, win_ctx[:, win_ctx.shape[1] - win_keep:]


def setup_inputs(seed: int = 0) -> dict:
    key = jax.random.key(seed)
    ks = jax.random.split(key, 32)
    f32 = jnp.float32

    def nrm(k, shape, scale):
        return jax.random.normal(k, shape, f32) * scale

    def gain(k, shape):
        return 1.0 + 0.05 * jax.random.normal(k, shape, f32)

    n_pages = PAST_LEN // PAGE_SIZE
    n_used = DEC_BATCH * n_pages
    n_phys = n_used + max(1, n_used // 4)
    wbuf = min(WINDOW, PAST_LEN)
    page_table = jax.random.permutation(ks[0], n_phys)[:n_used].reshape(DEC_BATCH, n_pages).astype(jnp.int32)
    dt = jnp.exp(jax.random.uniform(ks[1], (DEPTH, DN_HEADS), f32, float(np.log(1e-3)), float(np.log(1e-1))))
    return {
        'x_prompt': nrm(ks[2], (BATCH, SEQ, D_MODEL), 1.0),
        'x_sample': nrm(ks[3], (DEC_BATCH, DEC_SEQ, D_MODEL), 1.0),
        'mem_prompt': nrm(ks[4], (BATCH, MEM_LEN, D_MODEL), 1.0),
        'cache_nsa_kv': nrm(ks[5], (DEPTH, n_phys, PAGE_SIZE, 4, NSA_KV_HEADS, HEAD_DIM), 1.0),
        'cache_win_kv': nrm(ks[6], (DEPTH, DEC_BATCH, wbuf, 2, NSA_KV_HEADS, HEAD_DIM), 1.0),
        'cache_mem_kv': nrm(ks[7], (DEPTH, DEC_BATCH, MEM_LEN, 2, MEM_HEADS, MEM_HEAD_DIM), 1.0),
        'state_dn_conv': nrm(ks[8], (DEPTH, DEC_BATCH, CONV_WIDTH - 1, DN_CONV_DIM), 1.0),
        'state_dn_rec': nrm(ks[9], (DEPTH, DEC_BATCH, DN_HEADS, HEAD_DIM, HEAD_DIM), HEAD_DIM ** -0.5),
        'page_table': page_table,
        'ln_mix': gain(ks[10], (DEPTH, D_MODEL)),
        'w_in': nrm(ks[11], (DEPTH, D_MODEL, IN_COLS), D_MODEL ** -0.5),
        'dn_conv_w': nrm(ks[12], (DEPTH, CONV_WIDTH, DN_CONV_DIM), CONV_WIDTH ** -0.5),
        'dn_a_log': jnp.log(jax.random.uniform(ks[13], (DEPTH, DN_HEADS), f32, 1.0, 16.0)),
        'dn_dt_bias': dt + jnp.log(-jnp.expm1(-dt)),
        'dn_norm': gain(ks[14], (DEPTH, HEAD_DIM)),
        'cmp_pe': nrm(ks[15], (DEPTH, 2, CMP_BLOCK, HEAD_DIM), 0.5),
        'cmp_w1': nrm(ks[16], (DEPTH, 2, CMP_BLOCK * HEAD_DIM, CMP_HIDDEN), (CMP_BLOCK * HEAD_DIM) ** -0.5),
        'cmp_b1': nrm(ks[17], (DEPTH, 2, CMP_HIDDEN), 0.01),
        'cmp_w2': nrm(ks[18], (DEPTH, 2, CMP_HIDDEN, HEAD_DIM), (2.0 / CMP_HIDDEN) ** 0.5),
        'w_out': nrm(ks[19], (DEPTH, MIX_WIDTH, D_MODEL), MIX_WIDTH ** -0.5),
        'ln_mem': gain(ks[20], (DEPTH, D_MODEL)),
        'ln_memkv': gain(ks[21], (DEPTH, D_MODEL)),
        'w_mem_q': nrm(ks[22], (DEPTH, D_MODEL, MEM_HEADS * MEM_HEAD_DIM), D_MODEL ** -0.5),
        'w_mem_kv': nrm(ks[23], (DEPTH, D_MODEL, 2 * MEM_HEADS * MEM_HEAD_DIM), D_MODEL ** -0.5),
        'w_mem_o': nrm(ks[24], (DEPTH, MEM_HEADS * MEM_HEAD_DIM, D_MODEL), (MEM_HEADS * MEM_HEAD_DIM) ** -0.5),
        'ln_ffn': gain(ks[25], (DEPTH, D_MODEL)),
        'w_up': nrm(ks[26], (DEPTH, D_MODEL, D_FF), D_MODEL ** -0.5),
        'w_down': nrm(ks[27], (DEPTH, D_FF, D_MODEL), D_FF ** -0.5),
        'ln_final': gain(ks[28], (D_MODEL,)),
    }


def reference(x_prompt, x_sample, mem_prompt, cache_nsa_kv, cache_win_kv, cache_mem_kv, state_dn_conv,
              state_dn_rec, page_table, ln_mix, w_in, dn_conv_w, dn_a_log, dn_dt_bias, dn_norm, cmp_pe,
              cmp_w1, cmp_b1, cmp_w2, w_out, ln_mem, ln_memkv, w_mem_q, w_mem_kv, w_mem_o, ln_ffn, w_up,
              w_down, ln_final):
    B, S, _ = x_prompt.shape
    DB, DS, _ = x_sample.shape
    past = page_table.shape[1] * PAGE_SIZE
    wbuf = cache_win_kv.shape[2]
    mem_len = mem_prompt.shape[1]
    q_pos_p = jnp.arange(S)
    q_pos_s = past + jnp.arange(DS)
    win_pos_s = past - wbuf + jnp.arange(wbuf + DS)
    xp, xs = x_prompt, x_sample
    p_nsa, p_win, p_mem, p_conv, p_rec = [], [], [], [], []
    s_nsa, s_win, s_conv, s_rec = [], [], [], []
    for l in range(DEPTH):
        lw = (ln_mix[l], w_in[l], dn_conv_w[l], dn_a_log[l], dn_dt_bias[l], dn_norm[l], cmp_pe[l], cmp_w1[l],
              cmp_b1[l], cmp_w2[l], w_out[l], ln_mem[l], w_mem_q[l], w_mem_o[l], ln_ffn[l], w_up[l], w_down[l])
        mem_kv = (rms_norm(mem_prompt, ln_memkv[l]) @ w_mem_kv[l]).reshape(B, mem_len, 2, MEM_HEADS, MEM_HEAD_DIM)
        xp, conv_n, rec_n, nsa_n, win_n = trunk_layer(
            xp, mem_kv, jnp.zeros((B, CONV_WIDTH - 1, DN_CONV_DIM), xp.dtype),
            jnp.zeros((B, DN_HEADS, HEAD_DIM, HEAD_DIM), jnp.float32), None, None,
            q_pos_p, q_pos_p, min(WINDOW, S), True, *lw)
        p_nsa.append(nsa_n)
        p_win.append(win_n)
        p_mem.append(mem_kv)
        p_conv.append(conv_n)
        p_rec.append(rec_n)
        kv_past = cache_nsa_kv[l][page_table].reshape(DB, past, 4, NSA_KV_HEADS, HEAD_DIM)
        xs, conv_n, rec_n, nsa_n, win_n = trunk_layer(
            xs, cache_mem_kv[l], state_dn_conv[l], state_dn_rec[l], kv_past, cache_win_kv[l],
            q_pos_s, win_pos_s, wbuf, False, *lw)
        s_nsa.append(nsa_n)
        s_win.append(win_n)
        s_conv.append(conv_n)
        s_rec.append(rec_n)
    y_prompt = rms_norm(xp, ln_final)
    y_sample = rms_norm(xs, ln_final)
    return (y_prompt, y_sample, jnp.stack(p_nsa), jnp.stack(p_win), jnp.stack(p_mem), jnp.stack(p_conv),
            jnp.stack(p_rec), jnp.stack(s_nsa), jnp.stack(s_win), jnp.stack(s_conv), jnp.stack(s_rec))
```

```cpp
#include <hip/hip_runtime.h>
#include <cstdio>
#include <cstdint>
#define LAS __attribute__((address_space(3)))
#define GAS __attribute__((address_space(1)))
namespace pg8 {
#define PG8_LAS __attribute__((address_space(3)))
typedef unsigned short bf16_t;
typedef short bf16x8 __attribute__((ext_vector_type(8)));
typedef float f32x4 __attribute__((ext_vector_type(4)));
typedef unsigned u32x4 __attribute__((ext_vector_type(4)));
constexpr int BM = 256, BK = 64, HALF = 128, HTB = HALF * BK * 2  , STAGE_BYTES = 8 * HTB, NXCD = 8, WGM = 8;

__host__ __device__ __forceinline__ int lds_byte(int r, int c) { const int st = (r >> 4) * 2 + (c >> 5), rr = r & 15, cc = c & 31, ob = rr * 64 + cc * 2; return st * 1024 + (ob ^ (((ob >> 9) & 1) << 5)); }
__host__ __device__ __forceinline__ void stage_rc(int b, int& R, int& C) { const int st = b / 1024, sb = b % 1024, swz = sb ^ (((sb >> 9) & 1) << 5); R = (st >> 1) * 16 + swz / 64; C = (st & 1) * 32 + (swz % 64) / 2; }
__host__ __device__ __forceinline__ int perm32(int rho) { const int n = rho >> 4, i = rho & 15; return 8 * (i >> 2) + 4 * n + (i & 3); }

struct Unit { int pm, pn; };
struct Gemm { const bf16_t* A; const bf16_t* Bt; int M, N, K; };

struct StaticOrder {
    int nM, nN, nwg, G, c;
    __host__ __device__ void init(int M, int N, int G_, int c_) { nM = M / BM; nN = N / BM; nwg = nM * nN; G = G_; c = c_; }
    __host__ __device__ bool next(int i, Unit& u) const {
        const long L = (long)i * G + c; if (L >= nwg) return false;
        int wgid = (int)L; { const int q = nwg / NXCD, r = nwg % NXCD, xcd = wgid % NXCD, off = wgid / NXCD; wgid = (xcd < r ? xcd * (q + 1) : r * (q + 1) + (xcd - r) * q) + off; }
        const int nig = WGM * nN, gid = wgid / nig, fm = gid * WGM, gsz = (nM - fm) < WGM ? (nM - fm) : WGM;
        u.pm = fm + ((wgid % nig) % gsz); u.pn = (wgid % nig) / gsz; return true;
    }
    __device__ __forceinline__ void a_ready(const Unit&) const {}
    __device__ __forceinline__ void done(const Unit&) const {}
};

template <class Epi, class Sched, bool ALIGN_EPI = false, bool SP2 = false>
__device__ __forceinline__ void gemm_phase(PG8_LAS unsigned char* lds, const Gemm g, const Sched& S, const Epi& E) {
    const int tid = threadIdx.x, wid = __builtin_amdgcn_readfirstlane(tid >> 6), lane = tid & 63, wr = wid >> 2, wc = wid & 3, fr = lane & 15, fq = lane >> 4;
    const int K = g.K, nt = K / BK;
    unsigned voffA[2], voffB[2];
#pragma unroll
    for (int i = 0; i < 2; ++i) { int R, C; stage_rc(tid * 16 + i * 8192, R, C); const int Rb = Epi::PERM ? ((R & ~31) + perm32(R & 31)) : R;
        voffA[i] = (unsigned)(R * K + C) * 2u; voffB[i] = (unsigned)(Rb * K + C) * 2u; }
    const size_t kstep = (size_t)(BK * 2);
    const size_t hstep = (size_t)HALF * K * 2;
    const size_t tstep = 2 * hstep;
    const unsigned ldsw = (unsigned)wid * 1024u;
    const int aoff = lds_byte(wr * 64 + fr, fq * 8), boff = lds_byte(wc * 32 + fr, fq * 8);
#define PG8_SA(b, h) (((b) * 2 + (h)) * HTB)
#define PG8_SB(b, h) ((4 + (b) * 2 + (h)) * HTB)
#define PG8_STAGE(bufoff, gbase, voff) do { _Pragma("unroll") for (int _i = 0; _i < 2; ++_i) \
        __builtin_amdgcn_global_load_lds((const unsigned*)((const char*)(gbase) + (voff)[_i]), (PG8_LAS unsigned*)(lds + (bufoff) + ldsw + _i * 8192), 16, 0, 0); } while (0)
#define PG8_LDA(dst, b, h) do { _Pragma("unroll") for (int m = 0; m < 4; ++m) _Pragma("unroll") for (int k = 0; k < 2; ++k) dst[m][k] = *(const PG8_LAS bf16x8*)(lds + PG8_SA(b, h) + aoff + m * 2048 + k * 1024); } while (0)
#define PG8_LDB(dst, b, h) do { _Pragma("unroll") for (int n = 0; n < 2; ++n) _Pragma("unroll") for (int k = 0; k < 2; ++k) dst[n][k] = *(const PG8_LAS bf16x8*)(lds + PG8_SB(b, h) + boff + n * 2048 + k * 1024); } while (0)
#define PG8_MMA(ai, bj, At, Bt) do { __builtin_amdgcn_s_setprio(1); _Pragma("unroll") for (int m = 0; m < 4; ++m) _Pragma("unroll") for (int n = 0; n < 2; ++n) _Pragma("unroll") for (int k = 0; k < 2; ++k) \
        acc[ai][bj][m][n] = __builtin_amdgcn_mfma_f32_16x16x32_bf16(Bt[n][k], At[m][k], acc[ai][bj][m][n], 0, 0, 0); __builtin_amdgcn_s_setprio(0); } while (0)
#define PG8_WAIT_V(n) asm volatile("s_waitcnt vmcnt(" #n ")" ::: "memory")
#define PG8_WAIT_L(n) asm volatile("s_waitcnt lgkmcnt(" #n ")" ::: "memory")
#define PG8_BAR __builtin_amdgcn_s_barrier()
#define PG8_SCHED __builtin_amdgcn_sched_barrier(0)
    Unit cur, nxt; int ui = 0;
    if (!S.next(0, cur)) return;
    f32x4 acc[2][2][4][2];
#pragma unroll
    for (int a = 0; a < 2; ++a)
#pragma unroll
        for (int b = 0; b < 2; ++b)
#pragma unroll
            for (int m = 0; m < 4; ++m)
#pragma unroll
                for (int n = 0; n < 2; ++n) acc[a][b][m][n] = (f32x4){0.f, 0.f, 0.f, 0.f};
    bf16x8 At[4][2], B0[2][2], B1[2][2];
    const char* cA = (const char*)g.A + (size_t)cur.pm * tstep; const char* cB = (const char*)g.Bt + (size_t)cur.pn * tstep;
    S.a_ready(cur);
    if constexpr (SP2) {
        PG8_STAGE(PG8_SB(0, 0), cB, voffB); PG8_STAGE(PG8_SB(0, 1), cB + hstep, voffB); PG8_STAGE(PG8_SA(0, 0), cA, voffA); PG8_STAGE(PG8_SA(0, 1), cA + hstep, voffA);
        if (wr == 1) PG8_BAR;
        PG8_WAIT_V(2); PG8_BAR;
        PG8_STAGE(PG8_SB(1, 0), cB + kstep, voffB); PG8_STAGE(PG8_SA(1, 0), cA + kstep, voffA); PG8_STAGE(PG8_SB(1, 1), cB + hstep + kstep, voffB);
        PG8_WAIT_V(6); PG8_BAR;
    } else {
        PG8_STAGE(PG8_SB(0, 0), cB, voffB); PG8_STAGE(PG8_SA(0, 0), cA, voffA); PG8_STAGE(PG8_SB(0, 1), cB + hstep, voffB); PG8_STAGE(PG8_SA(0, 1), cA + hstep, voffA);
        if (wr == 1) PG8_BAR;
        PG8_WAIT_V(4); PG8_BAR;
        PG8_STAGE(PG8_SB(1, 0), cB + kstep, voffB); PG8_STAGE(PG8_SA(1, 0), cA + kstep, voffA); PG8_STAGE(PG8_SB(1, 1), cB + hstep + kstep, voffB);
        PG8_WAIT_V(6); PG8_BAR;
    }
    for (;;) {
        const bool has_next = S.next(ui + 1, nxt);
        const char* nA = has_next ? (const char*)g.A + (size_t)nxt.pm * tstep : cA; const char* nB = has_next ? (const char*)g.Bt + (size_t)nxt.pn * tstep : cB;
        for (int t = 0; t < nt; t += 2) {
            const bool last = (t == nt - 2);
            const char* a1 = cA + (size_t)(t + 1) * kstep;
            const char* a2 = last ? nA : cA + (size_t)(t + 2) * kstep; const char* b2 = last ? nB : cB + (size_t)(t + 2) * kstep;
            const char* a3 = a2 + kstep; const char* b3 = b2 + kstep;
            if (last && has_next) S.a_ready(nxt);
            if constexpr (SP2) {
            PG8_LDB(B0, 0, 0); PG8_LDB(B1, 0, 1); PG8_SCHED; PG8_LDA(At, 0, 0); PG8_STAGE(PG8_SA(1, 1), a1 + hstep, voffA);
            PG8_WAIT_V(8); PG8_WAIT_L(0); PG8_BAR; PG8_MMA(0, 0, At, B0); PG8_MMA(0, 1, At, B1); PG8_BAR; PG8_SCHED;
            PG8_LDA(At, 0, 1); PG8_STAGE(PG8_SB(0, 0), b2, voffB); PG8_STAGE(PG8_SB(0, 1), b2 + hstep, voffB); PG8_STAGE(PG8_SA(0, 0), a2, voffA);
            PG8_WAIT_V(8); PG8_WAIT_L(0); PG8_BAR; PG8_MMA(1, 0, At, B0); PG8_MMA(1, 1, At, B1); PG8_BAR; PG8_SCHED;
            PG8_LDB(B0, 1, 0); PG8_LDB(B1, 1, 1); PG8_SCHED; PG8_LDA(At, 1, 0); PG8_STAGE(PG8_SA(0, 1), a2 + hstep, voffA);
            PG8_WAIT_V(8); PG8_WAIT_L(0); PG8_BAR; PG8_MMA(0, 0, At, B0); PG8_MMA(0, 1, At, B1); PG8_BAR; PG8_SCHED;
            PG8_LDA(At, 1, 1); PG8_STAGE(PG8_SB(1, 0), b3, voffB); PG8_STAGE(PG8_SB(1, 1), b3 + hstep, voffB); PG8_STAGE(PG8_SA(1, 0), a3, voffA);
            PG8_WAIT_V(8); PG8_WAIT_L(0); PG8_BAR; PG8_MMA(1, 0, At, B0); PG8_MMA(1, 1, At, B1); PG8_BAR; PG8_SCHED;
            } else {
            PG8_LDB(B0, 0, 0); PG8_SCHED; PG8_LDA(At, 0, 0); PG8_STAGE(PG8_SA(1, 1), a1 + hstep, voffA);
            PG8_WAIT_L(8); PG8_BAR; PG8_WAIT_L(0); PG8_MMA(0, 0, At, B0); PG8_BAR; PG8_SCHED;
            PG8_LDB(B1, 0, 1); PG8_STAGE(PG8_SB(0, 0), b2, voffB);
            PG8_BAR; PG8_WAIT_L(0); PG8_MMA(0, 1, At, B1); PG8_BAR;
            PG8_LDA(At, 0, 1); PG8_STAGE(PG8_SA(0, 0), a2, voffA);
            PG8_BAR; PG8_WAIT_L(0); PG8_MMA(1, 0, At, B0); PG8_BAR; PG8_SCHED;
            PG8_STAGE(PG8_SB(0, 1), b2 + hstep, voffB);
            PG8_WAIT_V(6); PG8_BAR; PG8_MMA(1, 1, At, B1); PG8_BAR;
            PG8_LDB(B0, 1, 0); PG8_SCHED; PG8_LDA(At, 1, 0); PG8_STAGE(PG8_SA(0, 1), a2 + hstep, voffA);
            PG8_WAIT_L(8); PG8_BAR; PG8_WAIT_L(0); PG8_MMA(0, 0, At, B0); PG8_BAR; PG8_SCHED;
            PG8_LDB(B1, 1, 1); PG8_STAGE(PG8_SB(1, 0), b3, voffB);
            PG8_BAR; PG8_WAIT_L(0); PG8_MMA(0, 1, At, B1); PG8_BAR;
            PG8_LDA(At, 1, 1); PG8_STAGE(PG8_SA(1, 0), a3, voffA);
            PG8_BAR; PG8_WAIT_L(0); PG8_MMA(1, 0, At, B0); PG8_BAR; PG8_SCHED;
            PG8_STAGE(PG8_SB(1, 1), b3 + hstep, voffB);
            PG8_WAIT_V(6); PG8_BAR; PG8_MMA(1, 1, At, B1); PG8_BAR;
            }
        }
        if constexpr (ALIGN_EPI) { if (wr == 0) PG8_BAR; }
        if constexpr (!Epi::AFTER_DRAIN) { E(acc, cur, wr, wc, fr, fq); S.done(cur); }
        if (!has_next) break;
#pragma unroll
        for (int a = 0; a < 2; ++a)
#pragma unroll
            for (int b = 0; b < 2; ++b)
#pragma unroll
                for (int m = 0; m < 4; ++m)
#pragma unroll
                    for (int n = 0; n < 2; ++n) acc[a][b][m][n] = (f32x4){0.f, 0.f, 0.f, 0.f};
        cur = nxt; cA = nA; cB = nB; ++ui;
        if constexpr (ALIGN_EPI) { if (wr == 1) PG8_BAR; }
    }
    PG8_WAIT_V(0);
    if constexpr (!ALIGN_EPI) { if (wr == 0) PG8_BAR; }
    PG8_BAR;
    if constexpr (Epi::AFTER_DRAIN) { E.fused(acc, cur, wr, wc, fr, fq, lds, wid, lane); S.done(cur); }
#undef PG8_SA
#undef PG8_SB
#undef PG8_STAGE
#undef PG8_LDA
#undef PG8_LDB
#undef PG8_MMA
#undef PG8_WAIT_V
#undef PG8_WAIT_L
#undef PG8_BAR
#undef PG8_SCHED
}
}
#define XB_TMO      128
#define XB_XCNT(j)  (256  + 64 * (j))
#define XB_XSUB(j)  (1280 + 64 * (j))
#define XB_XGEN(j)  (2304 + 64 * (j))
#define XB_TOP      3328
#define XB_TOPGEN   3392
#define XCD_BAR_WORDS 3456
#define XB_SPIN_CAP (1u << 18)

__device__ __forceinline__ unsigned xb_ld(unsigned* p)              { return __hip_atomic_load(p, __ATOMIC_RELAXED, __HIP_MEMORY_SCOPE_AGENT); }
__device__ __forceinline__ unsigned xb_add(unsigned* p, unsigned v) { return __hip_atomic_fetch_add(p, v, __ATOMIC_RELAXED, __HIP_MEMORY_SCOPE_AGENT); }
__device__ __forceinline__ unsigned xb_xcc_id() { return (unsigned)__builtin_amdgcn_s_getreg((3 << 11) | 20) & 0xFu; }
#define XB_SPIN(cond, bar) do { unsigned _sp = 0; while (cond) { __builtin_amdgcn_s_sleep(1); \
    if ((++_sp & 255u) == 0u) { if (xb_ld(&(bar)[XB_TMO])) break; if (_sp > XB_SPIN_CAP) { atomicAdd(&(bar)[XB_TMO], 1u); break; } } } } while (0)

struct XcdBarrier {
    unsigned* bar; unsigned x;
    volatile LAS unsigned* st;
};

__device__ __forceinline__ XcdBarrier xcd_barrier_post(unsigned* bar, volatile LAS unsigned* st) {
    XcdBarrier b; b.bar = bar; b.x = xb_xcc_id(); b.st = st;
    if (threadIdx.x == 0) (void)xb_add(&bar[XB_XCNT(b.x)], 1u);
    return b;
}
__device__ __forceinline__ void xcd_barrier_complete(unsigned* bar, unsigned x, unsigned& nloc, unsigned& nx) {
    const unsigned G = gridDim.x * gridDim.y * gridDim.z;
    unsigned sum, cnt, mine, sp = 0u;
    for (;;) {
        sum = 0u; cnt = 0u; mine = 0u;
#pragma unroll
        for (unsigned j = 0; j < 16; ++j) { const unsigned c = xb_ld(&bar[XB_XCNT(j)]); sum += c; cnt += (c > 0u) ? 1u : 0u; mine = (j == x) ? c : mine; }
        if (sum == G) break;
        __builtin_amdgcn_s_sleep(1);
        if ((++sp & 255u) == 0u) { if (xb_ld(&bar[XB_TMO])) break; if (sp > XB_SPIN_CAP) { atomicAdd(&bar[XB_TMO], 1u); break; } }
    }
    nloc = mine > 0u ? mine : 1u; nx = cnt > 0u ? cnt : 1u;
}

__device__ __forceinline__ void xcd_barrier(const XcdBarrier& b) {
    asm volatile("s_waitcnt vmcnt(0)" ::: "memory");
    __syncthreads();
    if (threadIdx.x == 0) {
        unsigned* bar = b.bar;
        __builtin_amdgcn_s_waitcnt(0);
        unsigned nloc = b.st[0], nx = b.st[1];
        if (nloc == 0u) { xcd_barrier_complete(bar, b.x, nloc, nx); b.st[0] = nloc; b.st[1] = nx; }
        const unsigned old = xb_add(&bar[XB_XSUB(b.x)], 1u);
        const unsigned gen = old / nloc;
        if (old + 1u == (gen + 1u) * nloc) {
            __builtin_amdgcn_fence(__ATOMIC_RELEASE, "agent");
            asm volatile("s_waitcnt vmcnt(0)" ::: "memory");
            const unsigned og = xb_add(&bar[XB_TOP], 1u);
            const unsigned tg = og / nx;
            if (og + 1u == (tg + 1u) * nx) xb_add(&bar[XB_TOPGEN], 1u);
            else XB_SPIN(xb_ld(&bar[XB_TOPGEN]) == tg, bar);
            __builtin_amdgcn_fence(__ATOMIC_ACQUIRE, "agent");
            xb_add(&bar[XB_XGEN(b.x)], 1u);
            asm volatile("s_waitcnt vmcnt(0)" ::: "memory");
        } else {
            XB_SPIN(xb_ld(&bar[XB_XGEN(b.x)]) == gen, bar);
            __builtin_amdgcn_fence(__ATOMIC_ACQUIRE, "agent");
            asm volatile("s_waitcnt vmcnt(0)" ::: "memory");
        }
    }
    __syncthreads();
}
constexpr int NWAVES = 8, NTHREADS = NWAVES * 64;
constexpr int DM = 1024, NB = 4, SEQ = 4096, MP = NB * SEQ;
constexpr int DBATCH = 128;
constexpr int MT = MP + 256;
constexpr int PAST = 2048, PAGE = 128, NPAGES = PAST / PAGE, NPHYS = 2560, WBUF = 512;
constexpr int HD = 64, NG = 2;
constexpr int C_QKV = 0, C_Z = 1536, C_B = 2048, C_A = 2056, C_NQ = 2064, C_NKV = 2576, C_WIN = 3088, C_G = 3344, NPROJ = 3368, NPROJ_PAD = 3584;
constexpr int DFF = 4096, MEMLEN = 256, MEMH = 4, MEMD = 256;
constexpr int NCHUNK = SEQ / 64;
constexpr float RMS_EPS = 1e-6f;

enum { I_XP = 0, I_XS, I_MEMP, I_CNSA, I_CWIN, I_CMEM, I_SCONV, I_SREC, I_PT, I_LNMIX, I_WIN, I_CONVW, I_ALOG, I_DTB, I_DNNORM, I_PE, I_W1, I_B1, I_W2,
       I_WOUT, I_LNMEM, I_LNMEMKV, I_WMQ, I_WMKV, I_WMO, I_LNFFN, I_WUP, I_WDN, I_LNF, N_IN };
constexpr size_t O_YP = 0, O_YS = O_YP + (size_t)MP * DM, O_PNSA = O_YS + (size_t)DBATCH * DM, O_PWIN = O_PNSA + (size_t)MP * 512,
                 O_PMEM = O_PWIN + (size_t)NB * 512 * 256, O_PCONV = O_PMEM + (size_t)NB * MEMLEN * 2048, O_PREC = O_PCONV + (size_t)NB * 3 * 1536,
                 O_SNSA = O_PREC + (size_t)NB * 8 * 4096, O_SWIN = O_SNSA + (size_t)DBATCH * 512, O_SCONV = O_SWIN + (size_t)DBATCH * 512 * 256,
                 O_SREC = O_SCONV + (size_t)DBATCH * 3 * 1536, O_END = O_SREC + (size_t)DBATCH * 8 * 4096;
static_assert(O_END == 49694720, "output map");

constexpr size_t MiB = 1u << 20;
constexpr size_t WS_CTL = 0, CTL_ZERO_BYTES = 1 * MiB;
constexpr size_t WS_WIN_T = 2 * MiB;
constexpr size_t WS_WOUT_T = 10 * MiB;
constexpr size_t WS_WMQ_T = 12 * MiB;
constexpr size_t WS_WMKV_T = 14 * MiB;
constexpr size_t WS_WMO_T = 18 * MiB;
constexpr size_t WS_WUP_T = 20 * MiB;
constexpr size_t WS_WDN_T = 28 * MiB;
constexpr size_t WS_W1_T = 36 * MiB;
constexpr size_t WS_SSQ0 = 38 * MiB;
constexpr size_t WS_SSQM = WS_SSQ0 + 128 * 1024;
constexpr size_t WS_PEB = WS_SSQM + 64 * 1024;
constexpr size_t WS_SSQ1 = 40 * MiB, WS_SSQ2 = 42 * MiB, WS_SSQ3 = 44 * MiB;
constexpr size_t WS_BA = 46 * MiB;
constexpr size_t WS_GL = 48 * MiB;
constexpr size_t WS_KCMP_P = 50 * MiB;
constexpr size_t WS_KCMP_S = 52 * MiB;
constexpr size_t WS_XB = 64 * MiB;
constexpr size_t WS_MB = 98 * MiB;
constexpr size_t WS_MEMKV = 100 * MiB;
constexpr size_t WS_PROJ = 104 * MiB;
constexpr size_t WS_MIX = 220 * MiB;
constexpr size_t WS_X1 = 256 * MiB;
constexpr size_t WS_X1B = 322 * MiB;
constexpr size_t WS_QM = 356 * MiB;
constexpr size_t WS_OM = 390 * MiB;
constexpr size_t WS_X2 = 424 * MiB;
constexpr size_t WS_X2B = 490 * MiB;
constexpr size_t WS_UP = 524 * MiB;
constexpr size_t WS_DN = 656 * MiB;
constexpr size_t WS_GLAST = 740 * MiB;
constexpr size_t WS_ODN = 744 * MiB;
constexpr size_t WS_QKVN = 768 * MiB;
constexpr size_t WS_BG = 872 * MiB;
constexpr size_t WS_WINF = 876 * MiB;
constexpr size_t WS_END = 896 * MiB;
static_assert(WS_XB + (size_t)MT * DM * 2 <= WS_MB && WS_PROJ + (size_t)MT * NPROJ_PAD * 2 <= WS_MIX && WS_MIX + (size_t)MT * DM * 2 <= WS_X1 &&
              WS_X1 + (size_t)MT * DM * 4 <= WS_X1B && WS_X2 + (size_t)MT * DM * 4 <= WS_X2B && WS_UP + (size_t)MT * DFF * 2 <= WS_DN &&
              WS_DN + (size_t)2048 * 5 * 4096 * 2 <= WS_GLAST && WS_ODN + (size_t)MP * 512 * 2 <= WS_QKVN && WS_QKVN + (size_t)MT * 1536 * 4 <= WS_BG && WS_BG + (size_t)MT * 64 <= WS_WINF && WS_WINF + (size_t)MP * 1024 <= WS_END, "ws map");
constexpr int CW_BAR = 4096;

constexpr int RING_BYTES = 131072;
constexpr int MISC_OFF = RING_BYTES + 320;
constexpr int LDS_BYTES = 147456;

typedef unsigned short bf16;
typedef unsigned v4u __attribute__((ext_vector_type(4)));
typedef unsigned v2u __attribute__((ext_vector_type(2)));
typedef float f32x2 __attribute__((ext_vector_type(2)));
typedef float f32x4 __attribute__((ext_vector_type(4)));
typedef float f32x16 __attribute__((ext_vector_type(16)));
typedef short bf16x8 __attribute__((ext_vector_type(8)));
typedef short bf16x4 __attribute__((ext_vector_type(4)));
typedef __bf16 hbf2 __attribute__((ext_vector_type(2)));
#define LDS_WAIT() asm volatile("s_waitcnt lgkmcnt(0)" ::: "memory")
#define VM_WAIT() asm volatile("s_waitcnt vmcnt(0)" ::: "memory")
__device__ __forceinline__ unsigned pk2(float lo, float hi) { return __builtin_bit_cast(unsigned, __builtin_convertvector((f32x2){lo, hi}, hbf2)); }
__device__ __forceinline__ float bflo(unsigned u) { return __uint_as_float(u << 16); }
__device__ __forceinline__ float bfhi(unsigned u) { return __uint_as_float(u & 0xffff0000u); }
__device__ __forceinline__ float bf2f(bf16 b) { return __uint_as_float((unsigned)b << 16); }
__device__ __forceinline__ float wave_sum(float v) {
#pragma unroll
    for (int o = 1; o < 64; o <<= 1) v += __shfl_xor(v, o);
    return v;
}
__device__ __forceinline__ float fast_exp2(float x) { return __builtin_amdgcn_exp2f(x); }
__device__ __forceinline__ float fast_rcp(float x) { return __builtin_amdgcn_rcpf(x); }
#define MFMA32(a, b, c) __builtin_amdgcn_mfma_f32_32x32x16_bf16((a), (b), (c), 0, 0, 0)
#define MFMA16(a, b, c) __builtin_amdgcn_mfma_f32_16x16x32_bf16((a), (b), (c), 0, 0, 0)

struct Args { const float* in[N_IN]; float* out; unsigned char* ws; int ph_lo, ph_hi; };
struct Frame {
    LAS unsigned char* lds;
    int tid, lane, wave;
    int G, bid;
};
__device__ __forceinline__ void p0_transpose_item(const float* W, int K, int N, const float* gain, bf16* WT, LAS float* scr, int nblk, int item, int lane) {
    const int kb = item / nblk, nb = item % nblk, k0 = 64 * kb, n0 = 32 * nb;
    const int n = n0 + (lane & 31);
#pragma unroll 8
    for (int i = 0; i < 32; ++i) { const int kk = 2 * i + (lane >> 5);
        float v = (n < N) ? W[(size_t)(k0 + kk) * N + n] : 0.f;
        if (gain) v *= gain[k0 + kk];
        scr[kk * 33 + (lane & 31)] = v; }
    LDS_WAIT(); asm volatile("" ::: "memory");
    const int c = lane & 7;
#pragma unroll
    for (int j = 0; j < 4; ++j) { const int nn = (lane >> 3) + 8 * j; const LAS float* s = scr + (8 * c) * 33 + nn;
        v4u o; o.x = pk2(s[0 * 33], s[1 * 33]); o.y = pk2(s[2 * 33], s[3 * 33]); o.z = pk2(s[4 * 33], s[5 * 33]); o.w = pk2(s[6 * 33], s[7 * 33]);
        *(GAS v4u*)(WT + (size_t)(n0 + nn) * K + k0 + 8 * c) = o; }
    LDS_WAIT(); asm volatile("" ::: "memory");
}
__device__ __forceinline__ void p0_row(const float* src, bf16* dst, float* ssq, int lane) {
    f32x4 v[4]; float s = 0.f;
#pragma unroll
    for (int j = 0; j < 4; ++j) { v[j] = src ? ((const GAS f32x4*)src)[lane + 64 * j] : (f32x4){0.f, 0.f, 0.f, 0.f}; s += (v[j].x * v[j].x + v[j].y * v[j].y) + (v[j].z * v[j].z + v[j].w * v[j].w); }
    s = wave_sum(s);
    GAS v2u* o8 = (GAS v2u*)dst + lane;
#pragma unroll
    for (int j = 0; j < 4; ++j) { v2u w; w.x = pk2(v[j].x, v[j].y); w.y = pk2(v[j].z, v[j].w); o8[64 * j] = w; }
    if (lane == 0) *ssq = s;
}
__device__ __forceinline__ void p0_prologue(const Frame& F, const Args& a) {
    LAS float* scr = (LAS float*)(F.lds + F.wave * 16384);
    const int gw = F.bid * NWAVES + F.wave, NGW = F.G * NWAVES;
    unsigned char* ws = a.ws;
    constexpr int I0 = 16 * 112, I1 = 16 * 32, I2 = 16 * 32, I3 = 16 * 64, I4 = 16 * 32, I5 = 16 * 128, I6 = 64 * 32, I7 = 64 * 4, I8 = 64 * 4;
    constexpr int NITEMS = I0 + I1 + I2 + I3 + I4 + I5 + I6 + I7 + I8;
    for (int it = gw; it < NITEMS; it += NGW) {
        int r = it;
        if (r < I0) { p0_transpose_item(a.in[I_WIN], 1024, NPROJ, a.in[I_LNMIX], (bf16*)(ws + WS_WIN_T), scr, 112, r, F.lane); continue; } r -= I0;
        if (r < I1) { p0_transpose_item(a.in[I_WOUT], 1024, 1024, nullptr, (bf16*)(ws + WS_WOUT_T), scr, 32, r, F.lane); continue; } r -= I1;
        if (r < I2) { p0_transpose_item(a.in[I_WMQ], 1024, 1024, a.in[I_LNMEM], (bf16*)(ws + WS_WMQ_T), scr, 32, r, F.lane); continue; } r -= I2;
        if (r < I3) { p0_transpose_item(a.in[I_WMKV], 1024, 2048, a.in[I_LNMEMKV], (bf16*)(ws + WS_WMKV_T), scr, 64, r, F.lane); continue; } r -= I3;
        if (r < I4) { p0_transpose_item(a.in[I_WMO], 1024, 1024, nullptr, (bf16*)(ws + WS_WMO_T), scr, 32, r, F.lane); continue; } r -= I4;
        if (r < I5) { p0_transpose_item(a.in[I_WUP], 1024, 4096, a.in[I_LNFFN], (bf16*)(ws + WS_WUP_T), scr, 128, r, F.lane); continue; } r -= I5;
        if (r < I6) { p0_transpose_item(a.in[I_WDN], 4096, 1024, nullptr, (bf16*)(ws + WS_WDN_T), scr, 32, r, F.lane); continue; } r -= I6;
        if (r < I7) { p0_transpose_item(a.in[I_W1], 4096, 128, nullptr, (bf16*)(ws + WS_W1_T), scr, 4, r, F.lane); continue; } r -= I7;
        p0_transpose_item(a.in[I_W1] + (size_t)4096 * 128, 4096, 128, nullptr, (bf16*)(ws + WS_W1_T) + (size_t)128 * 4096, scr, 4, r, F.lane);
    }
    for (int m = gw; m < MT + 1024; m += NGW) {
        if (m < MT) {
            const float* src = (m < MP) ? a.in[I_XP] + (size_t)m * DM : (m < MP + DBATCH) ? a.in[I_XS] + (size_t)(m - MP) * DM : nullptr;
            p0_row(src, (bf16*)(ws + WS_XB) + (size_t)m * DM, (float*)(ws + WS_SSQ0) + m, F.lane);
        } else { const int r = m - MT; p0_row(a.in[I_MEMP] + (size_t)r * DM, (bf16*)(ws + WS_MB) + (size_t)r * DM, (float*)(ws + WS_SSQM) + r, F.lane); }
    }
    for (int it = gw; it < 64; it += NGW) {
        const int kr = it >> 1, kind = it & 1; const float* w1 = a.in[I_W1] + (size_t)kind * 4096 * 128; const float* pe = a.in[I_PE] + (size_t)kind * 4096;
        float s0 = 0.f, s1 = 0.f;
        for (int k = kr * 128; k < kr * 128 + 128; ++k) { const float p = pe[k]; s0 += p * w1[(size_t)k * 128 + F.lane]; s1 += p * w1[(size_t)k * 128 + 64 + F.lane]; }
        float* o = (float*)(ws + WS_PEB) + kr * 256 + kind * 128; o[F.lane] = s0; o[64 + F.lane] = s1;
    }
}
template <int MODE> struct Epi {
    static constexpr bool PERM = true, AFTER_DRAIN = false;
    float* out; unsigned char* ws; const float* xp; const float* xs;
    __device__ __forceinline__ static float rstd16(const float* p) {
        const f32x4 a = ((const f32x4*)p)[0], b = ((const f32x4*)p)[1], c = ((const f32x4*)p)[2], d = ((const f32x4*)p)[3];
        const float s = ((a.x + a.y) + (a.z + a.w)) + ((b.x + b.y) + (b.z + b.w)) + ((c.x + c.y) + (c.z + c.w)) + ((d.x + d.y) + (d.z + d.w));
        return rsqrtf(s * (1.f / 1024.f) + RMS_EPS);
    }
    __device__ __forceinline__ void operator()(const pg8::f32x4 (&acc)[2][2][4][2], const pg8::Unit& u, int wr, int wc, int fr, int fq) const {
        const int rbase = u.pm * 256 + wr * 64 + fr, cbase = u.pn * 256 + wc * 32 + 8 * fq;
#pragma unroll
        for (int ai = 0; ai < 2; ++ai)
#pragma unroll
            for (int m = 0; m < 4; ++m) {
                const int row = rbase + ai * 128 + m * 16;
                const bool isP = row < MP, isS = !isP && row < MP + DBATCH; const int sidx = row - MP;
                float rs = 1.f;
                if (MODE == 0) rs = rsqrtf(((const float*)(ws + WS_SSQ0))[row] * (1.f / 1024.f) + RMS_EPS);
                if (MODE == 1) rs = rsqrtf(((const float*)(ws + WS_SSQM))[row] * (1.f / 1024.f) + RMS_EPS);
                if (MODE == 3) rs = rstd16((const float*)(ws + WS_SSQ1) + (size_t)row * 16);
                if (MODE == 5) rs = rstd16((const float*)(ws + WS_SSQ2) + (size_t)row * 16);
                float ssq = 0.f;
#pragma unroll
                for (int bj = 0; bj < 2; ++bj) {
                    const int col = cbase + bj * 128;
                    f32x4 v0 = acc[ai][bj][m][0], v1 = acc[ai][bj][m][1];
                    if (MODE == 0) {
                        v0 = v0 * rs; v1 = v1 * rs;
                        v4u w; w.x = pk2(v0.x, v0.y); w.y = pk2(v0.z, v0.w); w.z = pk2(v1.x, v1.y); w.w = pk2(v1.z, v1.w);
                        *(v4u*)((bf16*)(ws + WS_PROJ) + (size_t)row * NPROJ_PAD + col) = w;
                        float* dst = nullptr;
                        if (col < C_Z) {
                            if (isP) { const int t = row & (SEQ - 1); if (t >= SEQ - 3) dst = out + O_PCONV + (size_t)((row >> 12) * 3 + (t - (SEQ - 3))) * 1536 + col; }
                            else if (isS) dst = out + O_SCONV + (size_t)(sidx * 3 + 2) * 1536 + col;
                        } else if (col >= C_B && col < C_NQ) { dst = (float*)(ws + WS_BA) + (size_t)row * 16 + (col - C_B); }
                        else if (col >= C_NKV && col < C_WIN) {
                            if (isP) dst = out + O_PNSA + (size_t)row * 512 + (col - C_NKV);
                            else if (isS) dst = out + O_SNSA + (size_t)sidx * 512 + (col - C_NKV);
                        } else if (col >= C_WIN && col < C_G) {
                            if (isP) { float* wf = (float*)(ws + WS_WINF) + (size_t)row * 256 + (col - C_WIN); ((f32x4*)wf)[0] = v0; ((f32x4*)wf)[1] = v1; }
                            if (isP) { const int t = row & (SEQ - 1); if (t >= SEQ - 512) dst = out + O_PWIN + (size_t)((row >> 12) * 512 + (t - (SEQ - 512))) * 256 + (col - C_WIN); }
                            else if (isS) dst = out + O_SWIN + (size_t)(sidx * 512 + 511) * 256 + (col - C_WIN);
                        } else if (col >= C_G && col < NPROJ) { dst = (float*)(ws + WS_GL) + (size_t)row * 24 + (col - C_G); }
                        if (dst) { ((f32x4*)dst)[0] = v0; ((f32x4*)dst)[1] = v1; }
                    } else if (MODE == 1) {
                        v0 = v0 * rs; v1 = v1 * rs;
                        float* dst = out + O_PMEM + (size_t)row * 2048 + col; ((f32x4*)dst)[0] = v0; ((f32x4*)dst)[1] = v1;
                        v4u w; w.x = pk2(v0.x, v0.y); w.y = pk2(v0.z, v0.w); w.z = pk2(v1.x, v1.y); w.w = pk2(v1.z, v1.w);
                        *(v4u*)((bf16*)(ws + WS_MEMKV) + (size_t)row * 2048 + col) = w;
                    } else if (MODE == 2 || MODE == 4 || MODE == 6) {
                        const float* res = nullptr;
                        if (MODE == 2) res = isP ? xp + (size_t)row * DM + col : isS ? xs + (size_t)sidx * DM + col : nullptr;
                        if (MODE == 4) res = (const float*)(ws + WS_X1) + (size_t)row * DM + col;
                        if (MODE == 6) res = (const float*)(ws + WS_X2) + (size_t)row * DM + col;
                        if (res) { v0 = v0 + ((const f32x4*)res)[0]; v1 = v1 + ((const f32x4*)res)[1]; }
                        ssq += ((v0.x * v0.x + v0.y * v0.y) + (v0.z * v0.z + v0.w * v0.w)) + ((v1.x * v1.x + v1.y * v1.y) + (v1.z * v1.z + v1.w * v1.w));
                        float* dst;
                        if (MODE == 2) dst = (float*)(ws + WS_X1) + (size_t)row * DM + col;
                        else if (MODE == 4) dst = (float*)(ws + WS_X2) + (size_t)row * DM + col;
                        else dst = isP ? out + O_YP + (size_t)row * DM + col : isS ? out + O_YS + (size_t)sidx * DM + col : nullptr;
                        if (dst) { ((f32x4*)dst)[0] = v0; ((f32x4*)dst)[1] = v1; }
                        if (MODE != 6) {
                            v4u w; w.x = pk2(v0.x, v0.y); w.y = pk2(v0.z, v0.w); w.z = pk2(v1.x, v1.y); w.w = pk2(v1.z, v1.w);
                            *(v4u*)((bf16*)(ws + (MODE == 2 ? WS_X1B : WS_X2B)) + (size_t)row * DM + col) = w;
                        }
                    } else if (MODE == 3) {
                        v0 = v0 * rs; v1 = v1 * rs;
                        v4u w; w.x = pk2(v0.x, v0.y); w.y = pk2(v0.z, v0.w); w.z = pk2(v1.x, v1.y); w.w = pk2(v1.z, v1.w);
                        *(v4u*)((bf16*)(ws + WS_QM) + (size_t)row * DM + col) = w;
                    } else if (MODE == 5) {
                        v0 = v0 * rs; v1 = v1 * rs;
#pragma unroll
                        for (int e = 0; e < 4; ++e) { const float p = fmaxf(v0[e], 0.f), q = fmaxf(v1[e], 0.f); v0[e] = p * p; v1[e] = q * q; }
                        v4u w; w.x = pk2(v0.x, v0.y); w.y = pk2(v0.z, v0.w); w.z = pk2(v1.x, v1.y); w.w = pk2(v1.z, v1.w);
                        *(v4u*)((bf16*)(ws + WS_UP) + (size_t)row * DFF + col) = w;
                    }
                }
                if (MODE == 2 || MODE == 4 || MODE == 6) {
                    ssq += __shfl_xor(ssq, 16); ssq += __shfl_xor(ssq, 32);
                    if (fq == 0) ((float*)(ws + (MODE == 2 ? WS_SSQ1 : MODE == 4 ? WS_SSQ2 : WS_SSQ3)))[(size_t)row * 16 + u.pn * 4 + wc] = ssq;
                }
            }
    }
};
__device__ __forceinline__ void sample_copies(const Frame& F, const Args& a) {
    const size_t gt = (size_t)F.bid * NTHREADS + F.tid, GT = (size_t)F.G * NTHREADS;
    { const f32x4* src = (const f32x4*)a.in[I_CWIN]; f32x4* dst = (f32x4*)(a.out + O_SWIN);
      constexpr size_t PER = 511 * 64;
      for (size_t i = gt; i < (size_t)DBATCH * PER; i += GT) { const size_t s = i / PER, r = i % PER; dst[s * 512 * 64 + r] = src[s * 512 * 64 + 64 + r]; } }
    { const f32x4* src = (const f32x4*)a.in[I_SCONV]; f32x4* dst = (f32x4*)(a.out + O_SCONV);
      constexpr size_t PER = 2 * 384;
      for (size_t i = gt; i < (size_t)DBATCH * PER; i += GT) { const size_t s = i / PER, r = i % PER; dst[s * 3 * 384 + r] = src[s * 3 * 384 + 384 + r]; } }
}
__device__ __forceinline__ void temp_fill(const Frame& F, const Args& a, size_t off, size_t n) {
    const size_t gt = (size_t)F.bid * NTHREADS + F.tid, GT = (size_t)F.G * NTHREADS;
    f32x4* dst = (f32x4*)(a.out + off);
    for (size_t i = gt; i < n / 4; i += GT) dst[i] = (f32x4){0.f, 0.f, 0.f, 0.f};
}
__device__ __forceinline__ float rdl(float v, int l) { return __builtin_bit_cast(float, __builtin_amdgcn_readlane(__builtin_bit_cast(int, v), l)); }
__device__ __forceinline__ float wave_max(float v) {
#pragma unroll
    for (int o = 1; o < 64; o <<= 1) v = fmaxf(v, __shfl_xor(v, o));
    return v;
}
__device__ __forceinline__ float sigmoidf_(float x) { return 1.f / (1.f + expf(-x)); }

__device__ __forceinline__ void nv_conv_row(const Args& a, int row, int lane) {
    unsigned char* ws = a.ws;
    const bf16* PROJ = (const bf16*)(ws + WS_PROJ);
    const bool isP = row < MP; const int s = row - MP, t = row & (SEQ - 1);
    const float* cw = a.in[I_CONVW];
    float* outp = (float*)(ws + WS_QKVN) + (size_t)row * 1536;
    for (int j = 0; j < 24; ++j) {
        const int ch = j * 64 + lane;
        float acc = 0.f;
#pragma unroll
        for (int jj = 0; jj < 4; ++jj) {
            float x;
            if (isP) { const int tt = t - 3 + jj; x = (tt >= 0) ? bf2f(PROJ[(size_t)(row - 3 + jj) * NPROJ_PAD + ch]) : 0.f; }
            else { x = (jj < 3) ? a.in[I_SCONV][((size_t)s * 3 + jj) * 1536 + ch] : bf2f(PROJ[(size_t)row * NPROJ_PAD + ch]); }
            acc += cw[jj * 1536 + ch] * x;
        }
        float c = acc / (1.f + expf(-acc));
        if (j < 16) { const float ss = wave_sum(c * c); c *= rsqrtf(ss + 1e-6f); if (j < 8) c *= 0.125f; }
        outp[ch] = c;
    }
    if (lane < 8) {
        const float* BA = (const float*)(ws + WS_BA) + (size_t)row * 16;
        const float beta = sigmoidf_(BA[lane]); const float x = BA[8 + lane] + a.in[I_DTB][lane];
        const float sp = x > 20.f ? x : log1pf(expf(x));
        float* BG = (float*)(ws + WS_BG) + (size_t)row * 16;
        BG[lane] = beta; BG[8 + lane] = -expf(a.in[I_ALOG][lane]) * sp;
    }
}

__device__ __forceinline__ void nv_dn_seq(const Args& a, int seq, int h, int lane) {
    unsigned char* ws = a.ws;
    const bool isP = seq < NB; const int s = seq - NB;
    const int row0 = isP ? seq * SEQ : MP + s, nsteps = isP ? SEQ : 1;
    float S[64];
#pragma unroll
    for (int k = 0; k < 64; ++k) S[k] = isP ? 0.f : a.in[I_SREC][((size_t)(s * 8 + h) * 64 + k) * 64 + lane];
    const float gain = a.in[I_DNNORM][lane];
    for (int st = 0; st < nsteps; ++st) {
        const int row = row0 + st;
        const float* qkv = (const float*)(ws + WS_QKVN) + (size_t)row * 1536 + h * 64 + lane;
        const float qv = qkv[0], kv = qkv[512], vv = qkv[1024];
        const float* BG = (const float*)(ws + WS_BG) + (size_t)row * 16;
        const float beta = BG[h], ag = expf(BG[8 + h]);
        const float z = bf2f(((const bf16*)(ws + WS_PROJ))[(size_t)row * NPROJ_PAD + C_Z + h * 64 + lane]);
        float kS = 0.f;
#pragma unroll
        for (int k = 0; k < 64; ++k) kS += rdl(kv, k) * S[k];
        const float vn = beta * (vv - ag * kS);
        float o = 0.f;
#pragma unroll
        for (int k = 0; k < 64; ++k) { S[k] = ag * S[k] + rdl(kv, k) * vn; o += rdl(qv, k) * S[k]; }
        const float ss = wave_sum(o * o);
        const float y = o * rsqrtf(ss * (1.f / 64.f) + RMS_EPS) * gain * (z / (1.f + expf(-z)));
        ((bf16*)(ws + WS_MIX))[(size_t)row * DM + h * 64 + lane] = (bf16)(pk2(y, 0.f) & 0xffffu);
    }
    float* dst = isP ? a.out + O_PREC + (size_t)(seq * 8 + h) * 4096 : a.out + O_SREC + (size_t)(s * 8 + h) * 4096;
#pragma unroll
    for (int k = 0; k < 64; ++k) dst[k * 64 + lane] = S[k];
}

__device__ __forceinline__ void nv_compress(const Args& a, int item, int lane) {
    unsigned char* ws = a.ws;
    int kind, idx, n, g; bool isP;
    if (item < 1024) { isP = true; kind = item >> 9; const int r = item & 511; idx = r >> 7; n = (r >> 1) & 63; g = r & 1; }
    else { isP = false; const int it = item - 1024; kind = it >> 13; const int r = it & 8191; idx = r >> 6; n = (r >> 1) & 31; g = r & 1; }
    const float* w1 = a.in[I_W1] + (size_t)kind * 4096 * 128; const float* pe = a.in[I_PE] + (size_t)kind * 4096;
    const int* pt = (const int*)a.in[I_PT];
    float h0 = 0.f, h1 = 0.f;
    for (int c = 0; c < 64; ++c) {
        const float* kvrow;
        if (isP) kvrow = a.out + O_PNSA + ((size_t)(idx * SEQ + n * 64 + c) * 512 + (kind * 2 + g) * 64);
        else { const int page = pt[idx * NPAGES + (n >> 1)]; kvrow = a.in[I_CNSA] + (((size_t)page * PAGE + (n & 1) * 64 + c) * 512 + (kind * 2 + g) * 64); }
        const float x = kvrow[lane] + pe[c * 64 + lane];
        const float* wr = w1 + (size_t)c * 64 * 128 + lane;
#pragma unroll 16
        for (int d = 0; d < 64; ++d) { const float xd = __shfl(x, d); h0 += xd * wr[d * 128]; h1 += xd * wr[d * 128 + 64]; }
    }
    h0 = fmaxf(h0 + a.in[I_B1][kind * 128 + lane], 0.f); h1 = fmaxf(h1 + a.in[I_B1][kind * 128 + 64 + lane], 0.f);
    const float* w2 = a.in[I_W2] + (size_t)kind * 128 * 64 + lane;
    float o = 0.f;
#pragma unroll 16
    for (int hd = 0; hd < 64; ++hd) { o += __shfl(h0, hd) * w2[hd * 64]; o += __shfl(h1, hd) * w2[(64 + hd) * 64]; }
    float* dst = isP ? (float*)(ws + WS_KCMP_P) + (size_t)kind * (NB * 64 * 2 * 64) + ((size_t)(idx * 64 + n) * 2 + g) * 64
                     : (float*)(ws + WS_KCMP_S) + (size_t)kind * (DBATCH * 32 * 2 * 64) + ((size_t)(idx * 32 + n) * 2 + g) * 64;
    dst[lane] = o;
}

__device__ __forceinline__ void nv_attend(LAS float* scr, const float* kf, bool ok, const float* vf, size_t vstride, int nkeys, int lane,
                                          f32x4& m, f32x4& l, f32x4& O) {
    f32x4 sc = {0.f, 0.f, 0.f, 0.f};
#pragma unroll 8
    for (int d = 0; d < 64; ++d) sc += *(const LAS f32x4*)(scr + 4 * d) * kf[d];
    f32x4 pr;
#pragma unroll
    for (int r = 0; r < 4; ++r) {
        const float s = ok ? sc[r] * 0.125f : -1e30f; const float mx = wave_max(s), mn = fmaxf(m[r], mx), alpha = expf(m[r] - mn);
        const float e = ok ? expf(s - mn) : 0.f; l[r] = l[r] * alpha + wave_sum(e); O[r] *= alpha; m[r] = mn; pr[r] = e;
    }
    *(LAS f32x4*)(scr + 256 + 4 * lane) = pr;
    LDS_WAIT(); asm volatile("" ::: "memory");
#pragma unroll 4
    for (int key = 0; key < nkeys; ++key) {
        O += *(const LAS f32x4*)(scr + 256 + 4 * key) * vf[(size_t)key * vstride + lane];
    }
    LDS_WAIT(); asm volatile("" ::: "memory");
}

__device__ __forceinline__ void nv_nsa_token(const Args& a, LAS float* scr, bool isP, int idx, int g, int t, int row, int lane) {
    unsigned char* ws = a.ws;
    const bf16* PROJ = (const bf16*)(ws + WS_PROJ);
    const int* pt = (const int*)a.in[I_PT];
    {   f32x4 q4;
#pragma unroll
        for (int r = 0; r < 4; ++r) q4[r] = bf2f(PROJ[(size_t)row * NPROJ_PAD + C_NQ + (g * 4 + r) * 64 + lane]);
        *(LAS f32x4*)(scr + 4 * lane) = q4; LDS_WAIT(); asm volatile("" ::: "memory"); }
    const int ncmp = isP ? 64 : 32, nvis = isP ? (t + 1) / 64 : 32;
    const float* kcb = isP ? (const float*)(ws + WS_KCMP_P) + ((size_t)idx * 64 * 2 + g) * 64 : (const float*)(ws + WS_KCMP_S) + ((size_t)idx * 32 * 2 + g) * 64;
    const float* vcb = kcb + (isP ? (size_t)NB * 64 * 2 * 64 : (size_t)DBATCH * 32 * 2 * 64);
    const bool vis = lane < nvis;
    f32x4 p; float imp = 0.f;
    {
        const float* kc = kcb + (size_t)(lane < ncmp ? lane : 0) * 128;
        f32x4 sc = {0.f, 0.f, 0.f, 0.f};
#pragma unroll 8
        for (int d = 0; d < 64; ++d) sc += *(const LAS f32x4*)(scr + 4 * d) * kc[d];
#pragma unroll
        for (int r = 0; r < 4; ++r) { const float s = vis ? sc[r] * 0.125f : -1e30f; const float mx = wave_max(s); const float e = vis ? expf(s - mx) : 0.f;
            const float sum = wave_sum(e); p[r] = e / fmaxf(sum, 1e-30f); imp += p[r]; }
    }
    f32x4 oc = {0.f, 0.f, 0.f, 0.f};
    *(LAS f32x4*)(scr + 256 + 4 * lane) = p; LDS_WAIT(); asm volatile("" ::: "memory");
    for (int n = 0; n < nvis; ++n) oc += *(const LAS f32x4*)(scr + 256 + 4 * n) * vcb[(size_t)n * 128 + lane];
    LDS_WAIT(); asm volatile("" ::: "memory");
    const int cur = t / 64, nsel = isP ? 64 : 33;
    const bool inarr = lane < nsel, valid = inarr && lane <= cur, forced = valid && (lane == 0 || cur - lane < 2);
    const float score = !inarr ? -2.f : (valid ? imp + (forced ? 1000.f : 0.f) : -1.f);
    int rank = 0;
    for (int j = 0; j < 64; ++j) { const float sj = __shfl(score, j); rank += (sj > score || (sj == score && j < lane)) ? 1 : 0; }
    const unsigned long long selmask = __ballot(valid && rank < 16);
    f32x4 ob[2];
#pragma unroll 1
    for (int br = 0; br < 2; ++br) {
        f32x4 m = {-1e30f, -1e30f, -1e30f, -1e30f}, l = {0.f, 0.f, 0.f, 0.f}, O = {0.f, 0.f, 0.f, 0.f};
        const int nblk = br == 0 ? cur + 1 : (isP ? 8 : 9);
#pragma unroll 1
        for (int j = 0; j < nblk; ++j) {
            const float* kf = nullptr; const float* vf = nullptr; size_t vstride = 0; int nkeys = 0; bool ok = false;
            if (br == 0) {
                if (!((selmask >> j) & 1ull)) continue;
                const int kpos = 64 * j + lane; ok = kpos <= t; const int kc = ok ? kpos : t;
                nkeys = (t - 64 * j + 1) < 64 ? (t - 64 * j + 1) : 64; vstride = 512;
                if (isP) { kf = a.out + O_PNSA + ((size_t)(idx * SEQ + kc) * 512 + (4 + g) * 64); vf = a.out + O_PNSA + ((size_t)(idx * SEQ + 64 * j) * 512 + (6 + g) * 64); }
                else if (j < 32) { const int page = pt[idx * NPAGES + (j >> 1)]; const float* base = a.in[I_CNSA] + ((size_t)page * PAGE + (j & 1) * 64) * 512;
                    kf = base + (size_t)lane * 512 + (4 + g) * 64; vf = base + (6 + g) * 64; }
                else { const float* base = a.out + O_SNSA + (size_t)idx * 512; kf = base + (4 + g) * 64; vf = base + (6 + g) * 64; nkeys = 1; }
            } else if (isP) {
                const int k0 = t - 511 + 64 * j;
                if (k0 + 63 < 0) continue;
                const int kb = k0 < 0 ? 0 : k0;
                nkeys = k0 < 0 ? k0 + 64 : 64; ok = lane < nkeys; const int kc = ok ? kb + lane : kb;
                const float* WF = (const float*)(ws + WS_WINF);
                kf = WF + (size_t)(idx * SEQ + kc) * 256 + g * 64; vf = WF + (size_t)(idx * SEQ + kb) * 256 + (2 + g) * 64; vstride = 256;
            } else {
                vstride = 256;
                if (j < 8) { const int c0 = 1 + 64 * j; nkeys = j < 7 ? 64 : 63; ok = lane < nkeys; const int ci = ok ? c0 + lane : c0;
                    kf = a.in[I_CWIN] + ((size_t)idx * 512 + ci) * 256 + g * 64; vf = a.in[I_CWIN] + ((size_t)idx * 512 + c0) * 256 + (2 + g) * 64; }
                else { const float* nb_ = a.out + O_SWIN + ((size_t)idx * 512 + 511) * 256; kf = nb_ + g * 64; vf = nb_ + (2 + g) * 64; nkeys = 1; ok = lane == 0; }
            }
            nv_attend(scr, kf, ok, vf, vstride, nkeys, lane, m, l, O);
        }
#pragma unroll
        for (int r = 0; r < 4; ++r) O[r] = O[r] / fmaxf(l[r], 1e-30f);
        ob[br] = O;
    }
    const float* GL = (const float*)(ws + WS_GL) + (size_t)row * 24;
#pragma unroll
    for (int r = 0; r < 4; ++r) {
        const float gc = sigmoidf_(GL[(g * 4 + r) * 3 + 0]), gs = sigmoidf_(GL[(g * 4 + r) * 3 + 1]), gw = sigmoidf_(GL[(g * 4 + r) * 3 + 2]);
        const float y = gc * oc[r] + gs * ob[0][r] + gw * ob[1][r];
        ((bf16*)(ws + WS_MIX))[(size_t)row * DM + 512 + (g * 4 + r) * 64 + lane] = (bf16)(pk2(y, 0.f) & 0xffffu);
    }
}

__device__ __forceinline__ void nv_mem_attn(const Args& a, LAS float* scr, int row, int head, int lane) {
    unsigned char* ws = a.ws;
    const bool isP = row < MP; const int s = row - MP, b = row >> 12;
    const bf16* qm = (const bf16*)(ws + WS_QM) + (size_t)row * DM + head * 256;
#pragma unroll
    for (int j = 0; j < 4; ++j) scr[lane + 64 * j] = bf2f(qm[lane + 64 * j]);
    LDS_WAIT(); asm volatile("" ::: "memory");
    float sc[4];
#pragma unroll
    for (int j = 0; j < 4; ++j) {
        const int mkey = lane + 64 * j; float acc = 0.f;
        if (isP) { const bf16* kr = (const bf16*)(ws + WS_MEMKV) + (size_t)(b * MEMLEN + mkey) * 2048 + head * 256;
            for (int d = 0; d < 256; ++d) acc += scr[d] * bf2f(kr[d]); }
        else { const float* kr = a.in[I_CMEM] + ((size_t)(s * MEMLEN + mkey) * 2 + 0) * 1024 + head * 256;
            for (int d = 0; d < 256; ++d) acc += scr[d] * kr[d]; }
        sc[j] = acc * 0.0625f;
    }
    float mx = fmaxf(fmaxf(sc[0], sc[1]), fmaxf(sc[2], sc[3])); mx = wave_max(mx);
    float sum = 0.f;
#pragma unroll
    for (int j = 0; j < 4; ++j) { sc[j] = expf(sc[j] - mx); sum += sc[j]; }
    sum = wave_sum(sum); const float inv = 1.f / sum;
    LDS_WAIT(); asm volatile("" ::: "memory");
#pragma unroll
    for (int j = 0; j < 4; ++j) scr[256 + lane + 64 * j] = sc[j] * inv;
    LDS_WAIT(); asm volatile("" ::: "memory");
    float o[4] = {0.f, 0.f, 0.f, 0.f};
    for (int mkey = 0; mkey < MEMLEN; ++mkey) {
        const float pm = scr[256 + mkey];
        if (isP) { const bf16* vr = (const bf16*)(ws + WS_MEMKV) + (size_t)(b * MEMLEN + mkey) * 2048 + 1024 + head * 256;
#pragma unroll
            for (int j = 0; j < 4; ++j) o[j] += pm * bf2f(vr[lane + 64 * j]); }
        else { const float* vr = a.in[I_CMEM] + ((size_t)(s * MEMLEN + mkey) * 2 + 1) * 1024 + head * 256;
#pragma unroll
            for (int j = 0; j < 4; ++j) o[j] += pm * vr[lane + 64 * j]; }
    }
    bf16* om = (bf16*)(ws + WS_OM) + (size_t)row * DM + head * 256;
#pragma unroll
    for (int j = 0; j < 4; ++j) om[lane + 64 * j] = (bf16)(pk2(o[j], 0.f) & 0xffffu);
    LDS_WAIT(); asm volatile("" ::: "memory");
}

__device__ __forceinline__ void final_norm_row(const Args& a, int row, int lane) {
    float* y = (row < MP) ? a.out + O_YP + (size_t)row * DM : a.out + O_YS + (size_t)(row - MP) * DM;
    const float* sp = (const float*)(a.ws + WS_SSQ3) + (size_t)row * 16;
    float s = 0.f;
#pragma unroll
    for (int i = 0; i < 16; ++i) s += sp[i];
    const float rs = rsqrtf(s * (1.f / 1024.f) + RMS_EPS);
#pragma unroll
    for (int j = 0; j < 4; ++j) { f32x4 v = ((f32x4*)y)[lane + 64 * j]; const f32x4 gq = ((const f32x4*)a.in[I_LNF])[lane + 64 * j]; v = v * rs * gq; ((f32x4*)y)[lane + 64 * j] = v; }
}
constexpr int N_PHASES = 11;
template <int LO, int HI> __global__ void __launch_bounds__(NTHREADS, 2) fwd(Args a) {
    extern __shared__ __attribute__((aligned(16))) unsigned char lds_raw[];
    Frame F; F.lds = (LAS unsigned char*)lds_raw; F.tid = threadIdx.x; F.lane = F.tid & 63; F.wave = __builtin_amdgcn_readfirstlane(F.tid >> 6); F.G = gridDim.x; F.bid = blockIdx.x;
    volatile LAS unsigned* MISC = (volatile LAS unsigned*)(F.lds + MISC_OFF);
    for (int u = F.tid; u < (LDS_BYTES - RING_BYTES) / 4; u += NTHREADS) ((LAS unsigned*)(F.lds + RING_BYTES))[u] = 0u;
    __syncthreads();
    constexpr int lo = LO, hi = HI;
    unsigned* barw = (unsigned*)(a.ws + WS_CTL) + CW_BAR;
    XcdBarrier bar; bar.bar = barw; bar.x = 0; bar.st = nullptr;
    if (hi - lo > 1) bar = xcd_barrier_post(barw, MISC + 8);
#define IN(k) (lo <= (k) && (k) < hi)
#define SEAM(k) do { if (IN(k) && IN((k) + 1)) xcd_barrier(bar); } while (0)
    unsigned char* ws = a.ws;

    if (IN(0)) { p0_prologue(F, a); }
    SEAM(0);
    if (IN(1)) {
        { pg8::Gemm g{(const bf16*)(ws + WS_XB), (const bf16*)(ws + WS_WIN_T), MT, NPROJ_PAD, DM}; pg8::StaticOrder S; S.init(MT, NPROJ_PAD, F.G, F.bid);
          Epi<0> E{a.out, ws, a.in[I_XP], a.in[I_XS]};
          pg8::gemm_phase<Epi<0>, pg8::StaticOrder, false, true>(F.lds, g, S, E); }
        __syncthreads();
        { pg8::Gemm g{(const bf16*)(ws + WS_MB), (const bf16*)(ws + WS_WMKV_T), 1024, 2048, DM}; pg8::StaticOrder S; S.init(1024, 2048, F.G, (F.bid + 32) % F.G);
          Epi<1> E{a.out, ws, a.in[I_XP], a.in[I_XS]};
          pg8::gemm_phase<Epi<1>, pg8::StaticOrder, false, true>(F.lds, g, S, E); }
    }
    SEAM(1);
    if (IN(2)) {
        sample_copies(F, a);
        {
          const size_t gt = (size_t)F.bid * NTHREADS + F.tid, GT = (size_t)F.G * NTHREADS;
          v4u* m0 = (v4u*)((bf16*)(ws + WS_MIX) + (size_t)(MP + DBATCH) * DM); v4u* m1 = (v4u*)((bf16*)(ws + WS_OM) + (size_t)(MP + DBATCH) * DM);
          for (size_t i = gt; i < (size_t)128 * DM / 8; i += GT) { m0[i] = (v4u){0u, 0u, 0u, 0u}; m1[i] = (v4u){0u, 0u, 0u, 0u}; } }
        const int gw = F.bid * NWAVES + F.wave, NGW = F.G * NWAVES;
        for (int r = gw; r < MP + DBATCH; r += NGW) nv_conv_row(a, r, F.lane);
        for (int it = gw; it < 1024 + 16384; it += NGW) nv_compress(a, it, F.lane);
    }
    SEAM(2);
    if (IN(3)) {
        const int gw = F.bid * NWAVES + F.wave, NGW = F.G * NWAVES;
        for (int it = gw; it < (NB + DBATCH) * 8; it += NGW) nv_dn_seq(a, it >> 3, it & 7, F.lane);
    }
    if (IN(11)) {
        const int gw = F.bid * NWAVES + F.wave, NGW = F.G * NWAVES;
        LAS float* scr = (LAS float*)(F.lds + F.wave * 16384);
        for (int r = gw; r < (MP + DBATCH) * 2; r += NGW) { const int tok = r >> 1, g = r & 1;
            const bool isP = tok < MP;
            nv_nsa_token(a, scr, isP, isP ? tok >> 12 : tok - MP, g, isP ? (tok & (SEQ - 1)) : PAST, tok, F.lane); }
    }
    SEAM(3);
    if (IN(4)) { pg8::Gemm g{(const bf16*)(ws + WS_MIX), (const bf16*)(ws + WS_WOUT_T), MT, DM, DM}; pg8::StaticOrder S; S.init(MT, DM, F.G, F.bid);
        Epi<2> E{a.out, ws, a.in[I_XP], a.in[I_XS]}; pg8::gemm_phase<Epi<2>, pg8::StaticOrder, false, true>(F.lds, g, S, E); }
    SEAM(4);
    if (IN(5)) { pg8::Gemm g{(const bf16*)(ws + WS_X1B), (const bf16*)(ws + WS_WMQ_T), MT, DM, DM}; pg8::StaticOrder S; S.init(MT, DM, F.G, F.bid);
        Epi<3> E{a.out, ws, a.in[I_XP], a.in[I_XS]}; pg8::gemm_phase<Epi<3>, pg8::StaticOrder, false, true>(F.lds, g, S, E); }
    SEAM(5);
    if (IN(6)) {
        const int gw = F.bid * NWAVES + F.wave, NGW = F.G * NWAVES;
        LAS float* scr = (LAS float*)(F.lds + F.wave * 16384);
        for (int it = gw; it < (MP + DBATCH) * 4; it += NGW) nv_mem_attn(a, scr, it >> 2, it & 3, F.lane);
    }
    SEAM(6);
    if (IN(7)) { pg8::Gemm g{(const bf16*)(ws + WS_OM), (const bf16*)(ws + WS_WMO_T), MT, DM, DM}; pg8::StaticOrder S; S.init(MT, DM, F.G, F.bid);
        Epi<4> E{a.out, ws, a.in[I_XP], a.in[I_XS]}; pg8::gemm_phase<Epi<4>, pg8::StaticOrder, false, true>(F.lds, g, S, E); }
    SEAM(7);
    if (IN(8)) { pg8::Gemm g{(const bf16*)(ws + WS_X2B), (const bf16*)(ws + WS_WUP_T), MT, DFF, DM}; pg8::StaticOrder S; S.init(MT, DFF, F.G, F.bid);
        Epi<5> E{a.out, ws, a.in[I_XP], a.in[I_XS]}; pg8::gemm_phase<Epi<5>, pg8::StaticOrder, false, true>(F.lds, g, S, E); }
    SEAM(8);
    if (IN(9)) { pg8::Gemm g{(const bf16*)(ws + WS_UP), (const bf16*)(ws + WS_WDN_T), MT, DM, DFF}; pg8::StaticOrder S; S.init(MT, DM, F.G, F.bid);
        Epi<6> E{a.out, ws, a.in[I_XP], a.in[I_XS]}; pg8::gemm_phase<Epi<6>, pg8::StaticOrder, false, true>(F.lds, g, S, E); }
    SEAM(9);
    if (IN(10)) {
        const int gw = F.bid * NWAVES + F.wave, NGW = F.G * NWAVES;
        for (int r = gw; r < MP + DBATCH; r += NGW) final_norm_row(a, r, F.lane);
    }
#undef IN
#undef SEAM
}

template <int LO, int HI> static bool launch_range(int& grid, const Args& a, hipStream_t stream) {
    static bool prepared = false;
    if (!prepared) { if (hipFuncSetAttribute((const void*)fwd<LO, HI>, hipFuncAttributeMaxDynamicSharedMemorySize, LDS_BYTES) != hipSuccess) { fprintf(stderr, "kernel_launch: hipFuncSetAttribute failed\n"); return false; } prepared = true; }
    hipLaunchKernelGGL((fwd<LO, HI>), dim3(grid), dim3(NTHREADS), LDS_BYTES, stream, a);
    return hipPeekAtLastError() == hipSuccess;
}
extern "C" void kernel_launch(void* const* d_in, const int* in_sizes, int n_in, void* d_out, int out_size, void* d_ws, size_t ws_size, hipStream_t stream) {
    static int grid = 0;
    if (grid == 0) {
        if (n_in != N_IN || (size_t)out_size != O_END || ws_size < WS_END) { fprintf(stderr, "kernel_launch: unexpected shapes n_in %d out %d ws %zu\n", n_in, out_size, ws_size); grid = -1; return; }
        int dev = 0, cus = 0;
        if (hipGetDevice(&dev) != hipSuccess || hipDeviceGetAttribute(&cus, hipDeviceAttributeMultiprocessorCount, dev) != hipSuccess) { grid = -1; return; }
        grid = cus;
    }
    if (grid < 0) return;
    (void)hipMemsetAsync((char*)d_ws + WS_CTL, 0, CTL_ZERO_BYTES, stream);
    Args a{};
    for (int i = 0; i < N_IN; ++i) a.in[i] = (const float*)d_in[i];
    a.out = (float*)d_out; a.ws = (unsigned char*)d_ws;
    launch_range<0, 1>(grid, a, stream); launch_range<1, 2>(grid, a, stream); launch_range<2, 3>(grid, a, stream); launch_range<3, 4>(grid, a, stream); launch_range<11, 12>(grid, a, stream);
    launch_range<4, 5>(grid, a, stream); launch_range<5, 6>(grid, a, stream); launch_range<6, 7>(grid, a, stream); launch_range<7, 8>(grid, a, stream);
    launch_range<8, 9>(grid, a, stream); launch_range<9, 10>(grid, a, stream); launch_range<10, 11>(grid, a, stream);
}
```

```cpp
#include <hip/hip_runtime.h>
#include <cstdio>
#include <cstdint>
#define LAS __attribute__((address_space(3)))
#define GAS __attribute__((address_space(1)))
namespace pg8 {
#define PG8_LAS __attribute__((address_space(3)))
typedef unsigned short bf16_t;
typedef short bf16x8 __attribute__((ext_vector_type(8)));
typedef float f32x4 __attribute__((ext_vector_type(4)));
typedef unsigned u32x4 __attribute__((ext_vector_type(4)));
constexpr int BM = 256, BK = 64, HALF = 128, HTB = HALF * BK * 2  , STAGE_BYTES = 8 * HTB, NXCD = 8, WGM = 8;

__host__ __device__ __forceinline__ int lds_byte(int r, int c) { const int st = (r >> 4) * 2 + (c >> 5), rr = r & 15, cc = c & 31, ob = rr * 64 + cc * 2; return st * 1024 + (ob ^ (((ob >> 9) & 1) << 5)); }
__host__ __device__ __forceinline__ void stage_rc(int b, int& R, int& C) { const int st = b / 1024, sb = b % 1024, swz = sb ^ (((sb >> 9) & 1) << 5); R = (st >> 1) * 16 + swz / 64; C = (st & 1) * 32 + (swz % 64) / 2; }
__host__ __device__ __forceinline__ int perm32(int rho) { const int n = rho >> 4, i = rho & 15; return 8 * (i >> 2) + 4 * n + (i & 3); }

struct Unit { int pm, pn; };
struct Gemm { const bf16_t* A; const bf16_t* Bt; int M, N, K; };

struct StaticOrder {
    int nM, nN, nwg, G, c;
    __host__ __device__ void init(int M, int N, int G_, int c_) { nM = M / BM; nN = N / BM; nwg = nM * nN; G = G_; c = c_; }
    __host__ __device__ bool next(int i, Unit& u) const {
        const long L = (long)i * G + c; if (L >= nwg) return false;
        int wgid = (int)L; { const int q = nwg / NXCD, r = nwg % NXCD, xcd = wgid % NXCD, off = wgid / NXCD; wgid = (xcd < r ? xcd * (q + 1) : r * (q + 1) + (xcd - r) * q) + off; }
        const int nig = WGM * nN, gid = wgid / nig, fm = gid * WGM, gsz = (nM - fm) < WGM ? (nM - fm) : WGM;
        u.pm = fm + ((wgid % nig) % gsz); u.pn = (wgid % nig) / gsz; return true;
    }
    __device__ __forceinline__ void a_ready(const Unit&) const {}
    __device__ __forceinline__ void done(const Unit&) const {}
};

template <class Epi, class Sched, bool ALIGN_EPI = false, bool SP2 = false>
__device__ __forceinline__ void gemm_phase(PG8_LAS unsigned char* lds, const Gemm g, const Sched& S, const Epi& E) {
    const int tid = threadIdx.x, wid = __builtin_amdgcn_readfirstlane(tid >> 6), lane = tid & 63, wr = wid >> 2, wc = wid & 3, fr = lane & 15, fq = lane >> 4;
    const int K = g.K, nt = K / BK;
    unsigned voffA[2], voffB[2];
#pragma unroll
    for (int i = 0; i < 2; ++i) { int R, C; stage_rc(tid * 16 + i * 8192, R, C); const int Rb = Epi::PERM ? ((R & ~31) + perm32(R & 31)) : R;
        voffA[i] = (unsigned)(R * K + C) * 2u; voffB[i] = (unsigned)(Rb * K + C) * 2u; }
    const size_t kstep = (size_t)(BK * 2);
    const size_t hstep = (size_t)HALF * K * 2;
    const size_t tstep = 2 * hstep;
    const unsigned ldsw = (unsigned)wid * 1024u;
    const int aoff = lds_byte(wr * 64 + fr, fq * 8), boff = lds_byte(wc * 32 + fr, fq * 8);
#define PG8_SA(b, h) (((b) * 2 + (h)) * HTB)
#define PG8_SB(b, h) ((4 + (b) * 2 + (h)) * HTB)
#define PG8_STAGE(bufoff, gbase, voff) do { _Pragma("unroll") for (int _i = 0; _i < 2; ++_i) \
        __builtin_amdgcn_global_load_lds((const unsigned*)((const char*)(gbase) + (voff)[_i]), (PG8_LAS unsigned*)(lds + (bufoff) + ldsw + _i * 8192), 16, 0, 0); } while (0)
#define PG8_LDA(dst, b, h) do { _Pragma("unroll") for (int m = 0; m < 4; ++m) _Pragma("unroll") for (int k = 0; k < 2; ++k) dst[m][k] = *(const PG8_LAS bf16x8*)(lds + PG8_SA(b, h) + aoff + m * 2048 + k * 1024); } while (0)
#define PG8_LDB(dst, b, h) do { _Pragma("unroll") for (int n = 0; n < 2; ++n) _Pragma("unroll") for (int k = 0; k < 2; ++k) dst[n][k] = *(const PG8_LAS bf16x8*)(lds + PG8_SB(b, h) + boff + n * 2048 + k * 1024); } while (0)
#define PG8_MMA(ai, bj, At, Bt) do { __builtin_amdgcn_s_setprio(1); _Pragma("unroll") for (int m = 0; m < 4; ++m) _Pragma("unroll") for (int n = 0; n < 2; ++n) _Pragma("unroll") for (int k = 0; k < 2; ++k) \
        acc[ai][bj][m][n] = __builtin_amdgcn_mfma_f32_16x16x32_bf16(Bt[n][k], At[m][k], acc[ai][bj][m][n], 0, 0, 0); __builtin_amdgcn_s_setprio(0); } while (0)
#define PG8_WAIT_V(n) asm volatile("s_waitcnt vmcnt(" #n ")" ::: "memory")
#define PG8_WAIT_L(n) asm volatile("s_waitcnt lgkmcnt(" #n ")" ::: "memory")
#define PG8_BAR __builtin_amdgcn_s_barrier()
#define PG8_SCHED __builtin_amdgcn_sched_barrier(0)
    Unit cur, nxt; int ui = 0;
    if (!S.next(0, cur)) return;
    f32x4 acc[2][2][4][2];
#pragma unroll
    for (int a = 0; a < 2; ++a)
#pragma unroll
        for (int b = 0; b < 2; ++b)
#pragma unroll
            for (int m = 0; m < 4; ++m)
#pragma unroll
                for (int n = 0; n < 2; ++n) acc[a][b][m][n] = (f32x4){0.f, 0.f, 0.f, 0.f};
    bf16x8 At[4][2], B0[2][2], B1[2][2];
    const char* cA = (const char*)g.A + (size_t)cur.pm * tstep; const char* cB = (const char*)g.Bt + (size_t)cur.pn * tstep;
    S.a_ready(cur);
    if constexpr (SP2) {
        PG8_STAGE(PG8_SB(0, 0), cB, voffB); PG8_STAGE(PG8_SB(0, 1), cB + hstep, voffB); PG8_STAGE(PG8_SA(0, 0), cA, voffA); PG8_STAGE(PG8_SA(0, 1), cA + hstep, voffA);
        if (wr == 1) PG8_BAR;
        PG8_WAIT_V(2); PG8_BAR;
        PG8_STAGE(PG8_SB(1, 0), cB + kstep, voffB); PG8_STAGE(PG8_SA(1, 0), cA + kstep, voffA); PG8_STAGE(PG8_SB(1, 1), cB + hstep + kstep, voffB);
        PG8_WAIT_V(6); PG8_BAR;
    } else {
        PG8_STAGE(PG8_SB(0, 0), cB, voffB); PG8_STAGE(PG8_SA(0, 0), cA, voffA); PG8_STAGE(PG8_SB(0, 1), cB + hstep, voffB); PG8_STAGE(PG8_SA(0, 1), cA + hstep, voffA);
        if (wr == 1) PG8_BAR;
        PG8_WAIT_V(4); PG8_BAR;
        PG8_STAGE(PG8_SB(1, 0), cB + kstep, voffB); PG8_STAGE(PG8_SA(1, 0), cA + kstep, voffA); PG8_STAGE(PG8_SB(1, 1), cB + hstep + kstep, voffB);
        PG8_WAIT_V(6); PG8_BAR;
    }
    for (;;) {
        const bool has_next = S.next(ui + 1, nxt);
        const char* nA = has_next ? (const char*)g.A + (size_t)nxt.pm * tstep : cA; const char* nB = has_next ? (const char*)g.Bt + (size_t)nxt.pn * tstep : cB;
        for (int t = 0; t < nt; t += 2) {
            const bool last = (t == nt - 2);
            const char* a1 = cA + (size_t)(t + 1) * kstep;
            const char* a2 = last ? nA : cA + (size_t)(t + 2) * kstep; const char* b2 = last ? nB : cB + (size_t)(t + 2) * kstep;
            const char* a3 = a2 + kstep; const char* b3 = b2 + kstep;
            if (last && has_next) S.a_ready(nxt);
            if constexpr (SP2) {
            PG8_LDB(B0, 0, 0); PG8_LDB(B1, 0, 1); PG8_SCHED; PG8_LDA(At, 0, 0); PG8_STAGE(PG8_SA(1, 1), a1 + hstep, voffA);
            PG8_WAIT_V(8); PG8_WAIT_L(0); PG8_BAR; PG8_MMA(0, 0, At, B0); PG8_MMA(0, 1, At, B1); PG8_BAR; PG8_SCHED;
            PG8_LDA(At, 0, 1); PG8_STAGE(PG8_SB(0, 0), b2, voffB); PG8_STAGE(PG8_SB(0, 1), b2 + hstep, voffB); PG8_STAGE(PG8_SA(0, 0), a2, voffA);
            PG8_WAIT_V(8); PG8_WAIT_L(0); PG8_BAR; PG8_MMA(1, 0, At, B0); PG8_MMA(1, 1, At, B1); PG8_BAR; PG8_SCHED;
            PG8_LDB(B0, 1, 0); PG8_LDB(B1, 1, 1); PG8_SCHED; PG8_LDA(At, 1, 0); PG8_STAGE(PG8_SA(0, 1), a2 + hstep, voffA);
            PG8_WAIT_V(8); PG8_WAIT_L(0); PG8_BAR; PG8_MMA(0, 0, At, B0); PG8_MMA(0, 1, At, B1); PG8_BAR; PG8_SCHED;
            PG8_LDA(At, 1, 1); PG8_STAGE(PG8_SB(1, 0), b3, voffB); PG8_STAGE(PG8_SB(1, 1), b3 + hstep, voffB); PG8_STAGE(PG8_SA(1, 0), a3, voffA);
            PG8_WAIT_V(8); PG8_WAIT_L(0); PG8_BAR; PG8_MMA(1, 0, At, B0); PG8_MMA(1, 1, At, B1); PG8_BAR; PG8_SCHED;
            } else {
            PG8_LDB(B0, 0, 0); PG8_SCHED; PG8_LDA(At, 0, 0); PG8_STAGE(PG8_SA(1, 1), a1 + hstep, voffA);
            PG8_WAIT_L(8); PG8_BAR; PG8_WAIT_L(0); PG8_MMA(0, 0, At, B0); PG8_BAR; PG8_SCHED;
            PG8_LDB(B1, 0, 1); PG8_STAGE(PG8_SB(0, 0), b2, voffB);
            PG8_BAR; PG8_WAIT_L(0); PG8_MMA(0, 1, At, B1); PG8_BAR;
            PG8_LDA(At, 0, 1); PG8_STAGE(PG8_SA(0, 0), a2, voffA);
            PG8_BAR; PG8_WAIT_L(0); PG8_MMA(1, 0, At, B0); PG8_BAR; PG8_SCHED;
            PG8_STAGE(PG8_SB(0, 1), b2 + hstep, voffB);
            PG8_WAIT_V(6); PG8_BAR; PG8_MMA(1, 1, At, B1); PG8_BAR;
            PG8_LDB(B0, 1, 0); PG8_SCHED; PG8_LDA(At, 1, 0); PG8_STAGE(PG8_SA(0, 1), a2 + hstep, voffA);
            PG8_WAIT_L(8); PG8_BAR; PG8_WAIT_L(0); PG8_MMA(0, 0, At, B0); PG8_BAR; PG8_SCHED;
            PG8_LDB(B1, 1, 1); PG8_STAGE(PG8_SB(1, 0), b3, voffB);
            PG8_BAR; PG8_WAIT_L(0); PG8_MMA(0, 1, At, B1); PG8_BAR;
            PG8_LDA(At, 1, 1); PG8_STAGE(PG8_SA(1, 0), a3, voffA);
            PG8_BAR; PG8_WAIT_L(0); PG8_MMA(1, 0, At, B0); PG8_BAR; PG8_SCHED;
            PG8_STAGE(PG8_SB(1, 1), b3 + hstep, voffB);
            PG8_WAIT_V(6); PG8_BAR; PG8_MMA(1, 1, At, B1); PG8_BAR;
            }
        }
        if constexpr (ALIGN_EPI) { if (wr == 0) PG8_BAR; }
        if constexpr (!Epi::AFTER_DRAIN) { E(acc, cur, wr, wc, fr, fq); S.done(cur); }
        if (!has_next) break;
#pragma unroll
        for (int a = 0; a < 2; ++a)
#pragma unroll
            for (int b = 0; b < 2; ++b)
#pragma unroll
                for (int m = 0; m < 4; ++m)
#pragma unroll
                    for (int n = 0; n < 2; ++n) acc[a][b][m][n] = (f32x4){0.f, 0.f, 0.f, 0.f};
        cur = nxt; cA = nA; cB = nB; ++ui;
        if constexpr (ALIGN_EPI) { if (wr == 1) PG8_BAR; }
    }
    PG8_WAIT_V(0);
    if constexpr (!ALIGN_EPI) { if (wr == 0) PG8_BAR; }
    PG8_BAR;
    if constexpr (Epi::AFTER_DRAIN) { E.fused(acc, cur, wr, wc, fr, fq, lds, wid, lane); S.done(cur); }
#undef PG8_SA
#undef PG8_SB
#undef PG8_STAGE
#undef PG8_LDA
#undef PG8_LDB
#undef PG8_MMA
#undef PG8_WAIT_V
#undef PG8_WAIT_L
#undef PG8_BAR
#undef PG8_SCHED
}
}
#define XB_TMO      128
#define XB_XCNT(j)  (256  + 64 * (j))
#define XB_XSUB(j)  (1280 + 64 * (j))
#define XB_XGEN(j)  (2304 + 64 * (j))
#define XB_TOP      3328
#define XB_TOPGEN   3392
#define XCD_BAR_WORDS 3456
#define XB_SPIN_CAP (1u << 18)

__device__ __forceinline__ unsigned xb_ld(unsigned* p)              { return __hip_atomic_load(p, __ATOMIC_RELAXED, __HIP_MEMORY_SCOPE_AGENT); }
__device__ __forceinline__ unsigned xb_add(unsigned* p, unsigned v) { return __hip_atomic_fetch_add(p, v, __ATOMIC_RELAXED, __HIP_MEMORY_SCOPE_AGENT); }
__device__ __forceinline__ unsigned xb_xcc_id() { return (unsigned)__builtin_amdgcn_s_getreg((3 << 11) | 20) & 0xFu; }
#define XB_SPIN(cond, bar) do { unsigned _sp = 0; while (cond) { __builtin_amdgcn_s_sleep(1); \
    if ((++_sp & 255u) == 0u) { if (xb_ld(&(bar)[XB_TMO])) break; if (_sp > XB_SPIN_CAP) { atomicAdd(&(bar)[XB_TMO], 1u); break; } } } } while (0)

struct XcdBarrier {
    unsigned* bar; unsigned x;
    volatile LAS unsigned* st;
};

__device__ __forceinline__ XcdBarrier xcd_barrier_post(unsigned* bar, volatile LAS unsigned* st) {
    XcdBarrier b; b.bar = bar; b.x = xb_xcc_id(); b.st = st;
    if (threadIdx.x == 0) (void)xb_add(&bar[XB_XCNT(b.x)], 1u);
    return b;
}
__device__ __forceinline__ void xcd_barrier_complete(unsigned* bar, unsigned x, unsigned& nloc, unsigned& nx) {
    const unsigned G = gridDim.x * gridDim.y * gridDim.z;
    unsigned sum, cnt, mine, sp = 0u;
    for (;;) {
        sum = 0u; cnt = 0u; mine = 0u;
#pragma unroll
        for (unsigned j = 0; j < 16; ++j) { const unsigned c = xb_ld(&bar[XB_XCNT(j)]); sum += c; cnt += (c > 0u) ? 1u : 0u; mine = (j == x) ? c : mine; }
        if (sum == G) break;
        __builtin_amdgcn_s_sleep(1);
        if ((++sp & 255u) == 0u) { if (xb_ld(&bar[XB_TMO])) break; if (sp > XB_SPIN_CAP) { atomicAdd(&bar[XB_TMO], 1u); break; } }
    }
    nloc = mine > 0u ? mine : 1u; nx = cnt > 0u ? cnt : 1u;
}

__device__ __forceinline__ void xcd_barrier(const XcdBarrier& b) {
    asm volatile("s_waitcnt vmcnt(0)" ::: "memory");
    __syncthreads();
    if (threadIdx.x == 0) {
        unsigned* bar = b.bar;
        __builtin_amdgcn_s_waitcnt(0);
        unsigned nloc = b.st[0], nx = b.st[1];
        if (nloc == 0u) { xcd_barrier_complete(bar, b.x, nloc, nx); b.st[0] = nloc; b.st[1] = nx; }
        const unsigned old = xb_add(&bar[XB_XSUB(b.x)], 1u);
        const unsigned gen = old / nloc;
        if (old + 1u == (gen + 1u) * nloc) {
            __builtin_amdgcn_fence(__ATOMIC_RELEASE, "agent");
            asm volatile("s_waitcnt vmcnt(0)" ::: "memory");
            const unsigned og = xb_add(&bar[XB_TOP], 1u);
            const unsigned tg = og / nx;
            if (og + 1u == (tg + 1u) * nx) xb_add(&bar[XB_TOPGEN], 1u);
            else XB_SPIN(xb_ld(&bar[XB_TOPGEN]) == tg, bar);
            __builtin_amdgcn_fence(__ATOMIC_ACQUIRE, "agent");
            xb_add(&bar[XB_XGEN(b.x)], 1u);
            asm volatile("s_waitcnt vmcnt(0)" ::: "memory");
        } else {
            XB_SPIN(xb_ld(&bar[XB_XGEN(b.x)]) == gen, bar);
            __builtin_amdgcn_fence(__ATOMIC_ACQUIRE, "agent");
            asm volatile("s_waitcnt vmcnt(0)" ::: "memory");
        }
    }
    __syncthreads();
}
constexpr int NWAVES = 8, NTHREADS = NWAVES * 64;
constexpr int DM = 1024, NB = 4, SEQ = 4096, MP = NB * SEQ;
constexpr int DBATCH = 128;
constexpr int MT = MP + 256;
constexpr int PAST = 2048, PAGE = 128, NPAGES = PAST / PAGE, NPHYS = 2560, WBUF = 512;
constexpr int HD = 64, NG = 2;
constexpr int C_QKV = 0, C_Z = 1536, C_B = 2048, C_A = 2056, C_NQ = 2064, C_NKV = 2576, C_WIN = 3088, C_G = 3344, NPROJ = 3368, NPROJ_PAD = 3584;
constexpr int DFF = 4096, MEMLEN = 256, MEMH = 4, MEMD = 256;
constexpr int NCHUNK = SEQ / 64;
constexpr float RMS_EPS = 1e-6f;

enum { I_XP = 0, I_XS, I_MEMP, I_CNSA, I_CWIN, I_CMEM, I_SCONV, I_SREC, I_PT, I_LNMIX, I_WIN, I_CONVW, I_ALOG, I_DTB, I_DNNORM, I_PE, I_W1, I_B1, I_W2,
       I_WOUT, I_LNMEM, I_LNMEMKV, I_WMQ, I_WMKV, I_WMO, I_LNFFN, I_WUP, I_WDN, I_LNF, N_IN };
constexpr size_t O_YP = 0, O_YS = O_YP + (size_t)MP * DM, O_PNSA = O_YS + (size_t)DBATCH * DM, O_PWIN = O_PNSA + (size_t)MP * 512,
                 O_PMEM = O_PWIN + (size_t)NB * 512 * 256, O_PCONV = O_PMEM + (size_t)NB * MEMLEN * 2048, O_PREC = O_PCONV + (size_t)NB * 3 * 1536,
                 O_SNSA = O_PREC + (size_t)NB * 8 * 4096, O_SWIN = O_SNSA + (size_t)DBATCH * 512, O_SCONV = O_SWIN + (size_t)DBATCH * 512 * 256,
                 O_SREC = O_SCONV + (size_t)DBATCH * 3 * 1536, O_END = O_SREC + (size_t)DBATCH * 8 * 4096;
static_assert(O_END == 49694720, "output map");

constexpr size_t MiB = 1u << 20;
constexpr size_t WS_CTL = 0, CTL_ZERO_BYTES = 1 * MiB;
constexpr size_t WS_WIN_T = 2 * MiB;
constexpr size_t WS_WOUT_T = 10 * MiB;
constexpr size_t WS_WMQ_T = 12 * MiB;
constexpr size_t WS_WMKV_T = 14 * MiB;
constexpr size_t WS_WMO_T = 18 * MiB;
constexpr size_t WS_WUP_T = 20 * MiB;
constexpr size_t WS_WDN_T = 28 * MiB;
constexpr size_t WS_W1_T = 36 * MiB;
constexpr size_t WS_SSQ0 = 38 * MiB;
constexpr size_t WS_SSQM = WS_SSQ0 + 128 * 1024;
constexpr size_t WS_PEB = WS_SSQM + 64 * 1024;
constexpr size_t WS_SSQ1 = 40 * MiB, WS_SSQ2 = 42 * MiB, WS_SSQ3 = 44 * MiB;
constexpr size_t WS_BA = 46 * MiB;
constexpr size_t WS_GL = 48 * MiB;
constexpr size_t WS_KCMP_P = 50 * MiB;
constexpr size_t WS_KCMP_S = 52 * MiB;
constexpr size_t WS_XB = 64 * MiB;
constexpr size_t WS_MB = 98 * MiB;
constexpr size_t WS_MEMKV = 100 * MiB;
constexpr size_t WS_PROJ = 104 * MiB;
constexpr size_t WS_MIX = 220 * MiB;
constexpr size_t WS_X1 = 256 * MiB;
constexpr size_t WS_X1B = 322 * MiB;
constexpr size_t WS_QM = 356 * MiB;
constexpr size_t WS_OM = 390 * MiB;
constexpr size_t WS_X2 = 424 * MiB;
constexpr size_t WS_X2B = 490 * MiB;
constexpr size_t WS_UP = 524 * MiB;
constexpr size_t WS_DN = 656 * MiB;
constexpr size_t WS_GLAST = 740 * MiB;
constexpr size_t WS_ODN = 744 * MiB;
constexpr size_t WS_QKVN = 768 * MiB;
constexpr size_t WS_BG = 872 * MiB;
constexpr size_t WS_WINF = 876 * MiB;
constexpr size_t WS_END = 896 * MiB;
static_assert(WS_XB + (size_t)MT * DM * 2 <= WS_MB && WS_PROJ + (size_t)MT * NPROJ_PAD * 2 <= WS_MIX && WS_MIX + (size_t)MT * DM * 2 <= WS_X1 &&
              WS_X1 + (size_t)MT * DM * 4 <= WS_X1B && WS_X2 + (size_t)MT * DM * 4 <= WS_X2B && WS_UP + (size_t)MT * DFF * 2 <= WS_DN &&
              WS_DN + (size_t)2048 * 5 * 4096 * 2 <= WS_GLAST && WS_ODN + (size_t)MP * 512 * 2 <= WS_QKVN && WS_QKVN + (size_t)MT * 1536 * 4 <= WS_BG && WS_BG + (size_t)MT * 64 <= WS_WINF && WS_WINF + (size_t)MP * 1024 <= WS_END, "ws map");
constexpr int CW_BAR = 4096;

constexpr int RING_BYTES = 131072;
constexpr int MISC_OFF = RING_BYTES + 320;
constexpr int LDS_BYTES = 147456;

typedef unsigned short bf16;
typedef unsigned v4u __attribute__((ext_vector_type(4)));
typedef unsigned v2u __attribute__((ext_vector_type(2)));
typedef float f32x2 __attribute__((ext_vector_type(2)));
typedef float f32x4 __attribute__((ext_vector_type(4)));
typedef float f32x16 __attribute__((ext_vector_type(16)));
typedef short bf16x8 __attribute__((ext_vector_type(8)));
typedef short bf16x4 __attribute__((ext_vector_type(4)));
typedef __bf16 hbf2 __attribute__((ext_vector_type(2)));
#define LDS_WAIT() asm volatile("s_waitcnt lgkmcnt(0)" ::: "memory")
#define VM_WAIT() asm volatile("s_waitcnt vmcnt(0)" ::: "memory")
__device__ __forceinline__ unsigned pk2(float lo, float hi) { return __builtin_bit_cast(unsigned, __builtin_convertvector((f32x2){lo, hi}, hbf2)); }
__device__ __forceinline__ float bflo(unsigned u) { return __uint_as_float(u << 16); }
__device__ __forceinline__ float bfhi(unsigned u) { return __uint_as_float(u & 0xffff0000u); }
__device__ __forceinline__ float bf2f(bf16 b) { return __uint_as_float((unsigned)b << 16); }
__device__ __forceinline__ float wave_sum(float v) {
#pragma unroll
    for (int o = 1; o < 64; o <<= 1) v += __shfl_xor(v, o);
    return v;
}
__device__ __forceinline__ float fast_exp2(float x) { return __builtin_amdgcn_exp2f(x); }
__device__ __forceinline__ float fast_rcp(float x) { return __builtin_amdgcn_rcpf(x); }
#define MFMA32(a, b, c) __builtin_amdgcn_mfma_f32_32x32x16_bf16((a), (b), (c), 0, 0, 0)
#define MFMA16(a, b, c) __builtin_amdgcn_mfma_f32_16x16x32_bf16((a), (b), (c), 0, 0, 0)

struct Args { const float* in[N_IN]; float* out; unsigned char* ws; int ph_lo, ph_hi; };
struct Frame {
    LAS unsigned char* lds;
    int tid, lane, wave;
    int G, bid;
};
__device__ __forceinline__ void p0_transpose_item(const float* W, int K, int N, const float* gain, bf16* WT, LAS float* scr, int nblk, int item, int lane) {
    const int kb = item / nblk, nb = item % nblk, k0 = 64 * kb, n0 = 32 * nb;
    const int n = n0 + (lane & 31);
#pragma unroll 8
    for (int i = 0; i < 32; ++i) { const int kk = 2 * i + (lane >> 5);
        float v = (n < N) ? W[(size_t)(k0 + kk) * N + n] : 0.f;
        if (gain) v *= gain[k0 + kk];
        scr[kk * 33 + (lane & 31)] = v; }
    LDS_WAIT(); asm volatile("" ::: "memory");
    const int c = lane & 7;
#pragma unroll
    for (int j = 0; j < 4; ++j) { const int nn = (lane >> 3) + 8 * j; const LAS float* s = scr + (8 * c) * 33 + nn;
        v4u o; o.x = pk2(s[0 * 33], s[1 * 33]); o.y = pk2(s[2 * 33], s[3 * 33]); o.z = pk2(s[4 * 33], s[5 * 33]); o.w = pk2(s[6 * 33], s[7 * 33]);
        *(GAS v4u*)(WT + (size_t)(n0 + nn) * K + k0 + 8 * c) = o; }
    LDS_WAIT(); asm volatile("" ::: "memory");
}
__device__ __forceinline__ void p0_row(const float* src, bf16* dst, float* ssq, int lane) {
    f32x4 v[4]; float s = 0.f;
#pragma unroll
    for (int j = 0; j < 4; ++j) { v[j] = src ? ((const GAS f32x4*)src)[lane + 64 * j] : (f32x4){0.f, 0.f, 0.f, 0.f}; s += (v[j].x * v[j].x + v[j].y * v[j].y) + (v[j].z * v[j].z + v[j].w * v[j].w); }
    s = wave_sum(s);
    GAS v2u* o8 = (GAS v2u*)dst + lane;
#pragma unroll
    for (int j = 0; j < 4; ++j) { v2u w; w.x = pk2(v[j].x, v[j].y); w.y = pk2(v[j].z, v[j].w); o8[64 * j] = w; }
    if (lane == 0) *ssq = s;
}
__device__ __forceinline__ void p0_prologue(const Frame& F, const Args& a) {
    LAS float* scr = (LAS float*)(F.lds + F.wave * 16384);
    const int gw = F.bid * NWAVES + F.wave, NGW = F.G * NWAVES;
    unsigned char* ws = a.ws;
    constexpr int I0 = 16 * 112, I1 = 16 * 32, I2 = 16 * 32, I3 = 16 * 64, I4 = 16 * 32, I5 = 16 * 128, I6 = 64 * 32, I7 = 64 * 4, I8 = 64 * 4;
    constexpr int NITEMS = I0 + I1 + I2 + I3 + I4 + I5 + I6 + I7 + I8;
    for (int it = gw; it < NITEMS; it += NGW) {
        int r = it;
        if (r < I0) { p0_transpose_item(a.in[I_WIN], 1024, NPROJ, a.in[I_LNMIX], (bf16*)(ws + WS_WIN_T), scr, 112, r, F.lane); continue; } r -= I0;
        if (r < I1) { p0_transpose_item(a.in[I_WOUT], 1024, 1024, nullptr, (bf16*)(ws + WS_WOUT_T), scr, 32, r, F.lane); continue; } r -= I1;
        if (r < I2) { p0_transpose_item(a.in[I_WMQ], 1024, 1024, a.in[I_LNMEM], (bf16*)(ws + WS_WMQ_T), scr, 32, r, F.lane); continue; } r -= I2;
        if (r < I3) { p0_transpose_item(a.in[I_WMKV], 1024, 2048, a.in[I_LNMEMKV], (bf16*)(ws + WS_WMKV_T), scr, 64, r, F.lane); continue; } r -= I3;
        if (r < I4) { p0_transpose_item(a.in[I_WMO], 1024, 1024, nullptr, (bf16*)(ws + WS_WMO_T), scr, 32, r, F.lane); continue; } r -= I4;
        if (r < I5) { p0_transpose_item(a.in[I_WUP], 1024, 4096, a.in[I_LNFFN], (bf16*)(ws + WS_WUP_T), scr, 128, r, F.lane); continue; } r -= I5;
        if (r < I6) { p0_transpose_item(a.in[I_WDN], 4096, 1024, nullptr, (bf16*)(ws + WS_WDN_T), scr, 32, r, F.lane); continue; } r -= I6;
        if (r < I7) { p0_transpose_item(a.in[I_W1], 4096, 128, nullptr, (bf16*)(ws + WS_W1_T), scr, 4, r, F.lane); continue; } r -= I7;
        p0_transpose_item(a.in[I_W1] + (size_t)4096 * 128, 4096, 128, nullptr, (bf16*)(ws + WS_W1_T) + (size_t)128 * 4096, scr, 4, r, F.lane);
    }
    for (int m = gw; m < MT + 1024; m += NGW) {
        if (m < MT) {
            const float* src = (m < MP) ? a.in[I_XP] + (size_t)m * DM : (m < MP + DBATCH) ? a.in[I_XS] + (size_t)(m - MP) * DM : nullptr;
            p0_row(src, (bf16*)(ws + WS_XB) + (size_t)m * DM, (float*)(ws + WS_SSQ0) + m, F.lane);
        } else { const int r = m - MT; p0_row(a.in[I_MEMP] + (size_t)r * DM, (bf16*)(ws + WS_MB) + (size_t)r * DM, (float*)(ws + WS_SSQM) + r, F.lane); }
    }
    for (int it = gw; it < 64; it += NGW) {
        const int kr = it >> 1, kind = it & 1; const float* w1 = a.in[I_W1] + (size_t)kind * 4096 * 128; const float* pe = a.in[I_PE] + (size_t)kind * 4096;
        float s0 = 0.f, s1 = 0.f;
        for (int k = kr * 128; k < kr * 128 + 128; ++k) { const float p = pe[k]; s0 += p * w1[(size_t)k * 128 + F.lane]; s1 += p * w1[(size_t)k * 128 + 64 + F.lane]; }
        float* o = (float*)(ws + WS_PEB) + kr * 256 + kind * 128; o[F.lane] = s0; o[64 + F.lane] = s1;
    }
}
template <int MODE> struct Epi {
    static constexpr bool PERM = true, AFTER_DRAIN = false;
    float* out; unsigned char* ws; const float* xp; const float* xs;
    __device__ __forceinline__ static float rstd16(const float* p) {
        const f32x4 a = ((const f32x4*)p)[0], b = ((const f32x4*)p)[1], c = ((const f32x4*)p)[2], d = ((const f32x4*)p)[3];
        const float s = ((a.x + a.y) + (a.z + a.w)) + ((b.x + b.y) + (b.z + b.w)) + ((c.x + c.y) + (c.z + c.w)) + ((d.x + d.y) + (d.z + d.w));
        return rsqrtf(s * (1.f / 1024.f) + RMS_EPS);
    }
    __device__ __forceinline__ void operator()(const pg8::f32x4 (&acc)[2][2][4][2], const pg8::Unit& u, int wr, int wc, int fr, int fq) const {
        const int rbase = u.pm * 256 + wr * 64 + fr, cbase = u.pn * 256 + wc * 32 + 8 * fq;
#pragma unroll
        for (int ai = 0; ai < 2; ++ai)
#pragma unroll
            for (int m = 0; m < 4; ++m) {
                const int row = rbase + ai * 128 + m * 16;
                const bool isP = row < MP, isS = !isP && row < MP + DBATCH; const int sidx = row - MP;
                float rs = 1.f;
                if (MODE == 0) rs = rsqrtf(((const float*)(ws + WS_SSQ0))[row] * (1.f / 1024.f) + RMS_EPS);
                if (MODE == 1) rs = rsqrtf(((const float*)(ws + WS_SSQM))[row] * (1.f / 1024.f) + RMS_EPS);
                if (MODE == 3) rs = rstd16((const float*)(ws + WS_SSQ1) + (size_t)row * 16);
                if (MODE == 5) rs = rstd16((const float*)(ws + WS_SSQ2) + (size_t)row * 16);
                float ssq = 0.f;
#pragma unroll
                for (int bj = 0; bj < 2; ++bj) {
                    const int col = cbase + bj * 128;
                    f32x4 v0 = acc[ai][bj][m][0], v1 = acc[ai][bj][m][1];
                    if (MODE == 0) {
                        v0 = v0 * rs; v1 = v1 * rs;
                        v4u w; w.x = pk2(v0.x, v0.y); w.y = pk2(v0.z, v0.w); w.z = pk2(v1.x, v1.y); w.w = pk2(v1.z, v1.w);
                        *(v4u*)((bf16*)(ws + WS_PROJ) + (size_t)row * NPROJ_PAD + col) = w;
                        float* dst = nullptr;
                        if (col < C_Z) {
                            if (isP) { const int t = row & (SEQ - 1); if (t >= SEQ - 3) dst = out + O_PCONV + (size_t)((row >> 12) * 3 + (t - (SEQ - 3))) * 1536 + col; }
                            else if (isS) dst = out + O_SCONV + (size_t)(sidx * 3 + 2) * 1536 + col;
                        } else if (col >= C_B && col < C_NQ) { dst = (float*)(ws + WS_BA) + (size_t)row * 16 + (col - C_B); }
                        else if (col >= C_NKV && col < C_WIN) {
                            if (isP) dst = out + O_PNSA + (size_t)row * 512 + (col - C_NKV);
                            else if (isS) dst = out + O_SNSA + (size_t)sidx * 512 + (col - C_NKV);
                        } else if (col >= C_WIN && col < C_G) {
                            if (isP) { float* wf = (float*)(ws + WS_WINF) + (size_t)row * 256 + (col - C_WIN); ((f32x4*)wf)[0] = v0; ((f32x4*)wf)[1] = v1; }
                            if (isP) { const int t = row & (SEQ - 1); if (t >= SEQ - 512) dst = out + O_PWIN + (size_t)((row >> 12) * 512 + (t - (SEQ - 512))) * 256 + (col - C_WIN); }
                            else if (isS) dst = out + O_SWIN + (size_t)(sidx * 512 + 511) * 256 + (col - C_WIN);
                        } else if (col >= C_G && col < NPROJ) { dst = (float*)(ws + WS_GL) + (size_t)row * 24 + (col - C_G); }
                        if (dst) { ((f32x4*)dst)[0] = v0; ((f32x4*)dst)[1] = v1; }
                    } else if (MODE == 1) {
                        v0 = v0 * rs; v1 = v1 * rs;
                        float* dst = out + O_PMEM + (size_t)row * 2048 + col; ((f32x4*)dst)[0] = v0; ((f32x4*)dst)[1] = v1;
                        v4u w; w.x = pk2(v0.x, v0.y); w.y = pk2(v0.z, v0.w); w.z = pk2(v1.x, v1.y); w.w = pk2(v1.z, v1.w);
                        *(v4u*)((bf16*)(ws + WS_MEMKV) + (size_t)row * 2048 + col) = w;
                    } else if (MODE == 2 || MODE == 4 || MODE == 6) {
                        const float* res = nullptr;
                        if (MODE == 2) res = isP ? xp + (size_t)row * DM + col : isS ? xs + (size_t)sidx * DM + col : nullptr;
                        if (MODE == 4) res = (const float*)(ws + WS_X1) + (size_t)row * DM + col;
                        if (MODE == 6) res = (const float*)(ws + WS_X2) + (size_t)row * DM + col;
                        if (res) { v0 = v0 + ((const f32x4*)res)[0]; v1 = v1 + ((const f32x4*)res)[1]; }
                        ssq += ((v0.x * v0.x + v0.y * v0.y) + (v0.z * v0.z + v0.w * v0.w)) + ((v1.x * v1.x + v1.y * v1.y) + (v1.z * v1.z + v1.w * v1.w));
                        float* dst;
                        if (MODE == 2) dst = (float*)(ws + WS_X1) + (size_t)row * DM + col;
                        else if (MODE == 4) dst = (float*)(ws + WS_X2) + (size_t)row * DM + col;
                        else dst = isP ? out + O_YP + (size_t)row * DM + col : isS ? out + O_YS + (size_t)sidx * DM + col : nullptr;
                        if (dst) { ((f32x4*)dst)[0] = v0; ((f32x4*)dst)[1] = v1; }
                        if (MODE != 6) {
                            v4u w; w.x = pk2(v0.x, v0.y); w.y = pk2(v0.z, v0.w); w.z = pk2(v1.x, v1.y); w.w = pk2(v1.z, v1.w);
                            *(v4u*)((bf16*)(ws + (MODE == 2 ? WS_X1B : WS_X2B)) + (size_t)row * DM + col) = w;
                        }
                    } else if (MODE == 3) {
                        v0 = v0 * rs; v1 = v1 * rs;
                        v4u w; w.x = pk2(v0.x, v0.y); w.y = pk2(v0.z, v0.w); w.z = pk2(v1.x, v1.y); w.w = pk2(v1.z, v1.w);
                        *(v4u*)((bf16*)(ws + WS_QM) + (size_t)row * DM + col) = w;
                    } else if (MODE == 5) {
                        v0 = v0 * rs; v1 = v1 * rs;
#pragma unroll
                        for (int e = 0; e < 4; ++e) { const float p = fmaxf(v0[e], 0.f), q = fmaxf(v1[e], 0.f); v0[e] = p * p; v1[e] = q * q; }
                        v4u w; w.x = pk2(v0.x, v0.y); w.y = pk2(v0.z, v0.w); w.z = pk2(v1.x, v1.y); w.w = pk2(v1.z, v1.w);
                        *(v4u*)((bf16*)(ws + WS_UP) + (size_t)row * DFF + col) = w;
                    }
                }
                if (MODE == 2 || MODE == 4 || MODE == 6) {
                    ssq += __shfl_xor(ssq, 16); ssq += __shfl_xor(ssq, 32);
                    if (fq == 0) ((float*)(ws + (MODE == 2 ? WS_SSQ1 : MODE == 4 ? WS_SSQ2 : WS_SSQ3)))[(size_t)row * 16 + u.pn * 4 + wc] = ssq;
                }
            }
    }
};
__device__ __forceinline__ void sample_copies(const Frame& F, const Args& a) {
    const size_t gt = (size_t)F.bid * NTHREADS + F.tid, GT = (size_t)F.G * NTHREADS;
    { const f32x4* src = (const f32x4*)a.in[I_CWIN]; f32x4* dst = (f32x4*)(a.out + O_SWIN);
      constexpr size_t PER = 511 * 64;
      for (size_t i = gt; i < (size_t)DBATCH * PER; i += GT) { const size_t s = i / PER, r = i % PER; dst[s * 512 * 64 + r] = src[s * 512 * 64 + 64 + r]; } }
    { const f32x4* src = (const f32x4*)a.in[I_SCONV]; f32x4* dst = (f32x4*)(a.out + O_SCONV);
      constexpr size_t PER = 2 * 384;
      for (size_t i = gt; i < (size_t)DBATCH * PER; i += GT) { const size_t s = i / PER, r = i % PER; dst[s * 3 * 384 + r] = src[s * 3 * 384 + 384 + r]; } }
}
__device__ __forceinline__ void temp_fill(const Frame& F, const Args& a, size_t off, size_t n) {
    const size_t gt = (size_t)F.bid * NTHREADS + F.tid, GT = (size_t)F.G * NTHREADS;
    f32x4* dst = (f32x4*)(a.out + off);
    for (size_t i = gt; i < n / 4; i += GT) dst[i] = (f32x4){0.f, 0.f, 0.f, 0.f};
}
__device__ __forceinline__ float rdl(float v, int l) { return __builtin_bit_cast(float, __builtin_amdgcn_readlane(__builtin_bit_cast(int, v), l)); }
__device__ __forceinline__ float wave_max(float v) {
#pragma unroll
    for (int o = 1; o < 64; o <<= 1) v = fmaxf(v, __shfl_xor(v, o));
    return v;
}
__device__ __forceinline__ float sigmoidf_(float x) { return 1.f / (1.f + expf(-x)); }

__device__ __forceinline__ void nv_conv_row(const Args& a, int row, int lane) {
    unsigned char* ws = a.ws;
    const bf16* PROJ = (const bf16*)(ws + WS_PROJ);
    const bool isP = row < MP; const int s = row - MP, t = row & (SEQ - 1);
    const float* cw = a.in[I_CONVW];
    float* outp = (float*)(ws + WS_QKVN) + (size_t)row * 1536;
    for (int j = 0; j < 24; ++j) {
        const int ch = j * 64 + lane;
        float acc = 0.f;
#pragma unroll
        for (int jj = 0; jj < 4; ++jj) {
            float x;
            if (isP) { const int tt = t - 3 + jj; x = (tt >= 0) ? bf2f(PROJ[(size_t)(row - 3 + jj) * NPROJ_PAD + ch]) : 0.f; }
            else { x = (jj < 3) ? a.in[I_SCONV][((size_t)s * 3 + jj) * 1536 + ch] : bf2f(PROJ[(size_t)row * NPROJ_PAD + ch]); }
            acc += cw[jj * 1536 + ch] * x;
        }
        float c = acc / (1.f + expf(-acc));
        if (j < 16) { const float ss = wave_sum(c * c); c *= rsqrtf(ss + 1e-6f); if (j < 8) c *= 0.125f; }
        outp[ch] = c;
    }
    if (lane < 8) {
        const float* BA = (const float*)(ws + WS_BA) + (size_t)row * 16;
        const float beta = sigmoidf_(BA[lane]); const float x = BA[8 + lane] + a.in[I_DTB][lane];
        const float sp = x > 20.f ? x : log1pf(expf(x));
        float* BG = (float*)(ws + WS_BG) + (size_t)row * 16;
        BG[lane] = beta; BG[8 + lane] = -expf(a.in[I_ALOG][lane]) * sp;
    }
}

__device__ __forceinline__ void nv_dn_seq(const Args& a, int seq, int h, int lane) {
    unsigned char* ws = a.ws;
    const bool isP = seq < NB; const int s = seq - NB;
    const int row0 = isP ? seq * SEQ : MP + s, nsteps = isP ? SEQ : 1;
    float S[64];
#pragma unroll
    for (int k = 0; k < 64; ++k) S[k] = isP ? 0.f : a.in[I_SREC][((size_t)(s * 8 + h) * 64 + k) * 64 + lane];
    const float gain = a.in[I_DNNORM][lane];
    for (int st = 0; st < nsteps; ++st) {
        const int row = row0 + st;
        const float* qkv = (const float*)(ws + WS_QKVN) + (size_t)row * 1536 + h * 64 + lane;
        const float qv = qkv[0], kv = qkv[512], vv = qkv[1024];
        const float* BG = (const float*)(ws + WS_BG) + (size_t)row * 16;
        const float beta = BG[h], ag = expf(BG[8 + h]);
        const float z = bf2f(((const bf16*)(ws + WS_PROJ))[(size_t)row * NPROJ_PAD + C_Z + h * 64 + lane]);
        float kS = 0.f;
#pragma unroll
        for (int k = 0; k < 64; ++k) kS += rdl(kv, k) * S[k];
        const float vn = beta * (vv - ag * kS);
        float o = 0.f;
#pragma unroll
        for (int k = 0; k < 64; ++k) { S[k] = ag * S[k] + rdl(kv, k) * vn; o += rdl(qv, k) * S[k]; }
        const float ss = wave_sum(o * o);
        const float y = o * rsqrtf(ss * (1.f / 64.f) + RMS_EPS) * gain * (z / (1.f + expf(-z)));
        ((bf16*)(ws + WS_MIX))[(size_t)row * DM + h * 64 + lane] = (bf16)(pk2(y, 0.f) & 0xffffu);
    }
    float* dst = isP ? a.out + O_PREC + (size_t)(seq * 8 + h) * 4096 : a.out + O_SREC + (size_t)(s * 8 + h) * 4096;
#pragma unroll
    for (int k = 0; k < 64; ++k) dst[k * 64 + lane] = S[k];
}

__device__ __forceinline__ void nv_compress(const Args& a, int item, int lane) {
    unsigned char* ws = a.ws;
    int kind, idx, n, g; bool isP;
    if (item < 1024) { isP = true; kind = item >> 9; const int r = item & 511; idx = r >> 7; n = (r >> 1) & 63; g = r & 1; }
    else { isP = false; const int it = item - 1024; kind = it >> 13; const int r = it & 8191; idx = r >> 6; n = (r >> 1) & 31; g = r & 1; }
    const float* w1 = a.in[I_W1] + (size_t)kind * 4096 * 128; const float* pe = a.in[I_PE] + (size_t)kind * 4096;
    const int* pt = (const int*)a.in[I_PT];
    float h0 = 0.f, h1 = 0.f;
    for (int c = 0; c < 64; ++c) {
        const float* kvrow;
        if (isP) kvrow = a.out + O_PNSA + ((size_t)(idx * SEQ + n * 64 + c) * 512 + (kind * 2 + g) * 64);
        else { const int page = pt[idx * NPAGES + (n >> 1)]; kvrow = a.in[I_CNSA] + (((size_t)page * PAGE + (n & 1) * 64 + c) * 512 + (kind * 2 + g) * 64); }
        const float x = kvrow[lane] + pe[c * 64 + lane];
        const float* wr = w1 + (size_t)c * 64 * 128 + lane;
#pragma unroll 16
        for (int d = 0; d < 64; ++d) { const float xd = __shfl(x, d); h0 += xd * wr[d * 128]; h1 += xd * wr[d * 128 + 64]; }
    }
    h0 = fmaxf(h0 + a.in[I_B1][kind * 128 + lane], 0.f); h1 = fmaxf(h1 + a.in[I_B1][kind * 128 + 64 + lane], 0.f);
    const float* w2 = a.in[I_W2] + (size_t)kind * 128 * 64 + lane;
    float o = 0.f;
#pragma unroll 16
    for (int hd = 0; hd < 64; ++hd) { o += __shfl(h0, hd) * w2[hd * 64]; o += __shfl(h1, hd) * w2[(64 + hd) * 64]; }
    float* dst = isP ? (float*)(ws + WS_KCMP_P) + (size_t)kind * (NB * 64 * 2 * 64) + ((size_t)(idx * 64 + n) * 2 + g) * 64
                     : (float*)(ws + WS_KCMP_S) + (size_t)kind * (DBATCH * 32 * 2 * 64) + ((size_t)(idx * 32 + n) * 2 + g) * 64;
    dst[lane] = o;
}

__device__ __forceinline__ void nv_attend(LAS float* scr, const float* kf, bool ok, const float* vf, size_t vstride, int nkeys, int lane,
                                          f32x4& m, f32x4& l, f32x4& O) {
    f32x4 sc = {0.f, 0.f, 0.f, 0.f};
#pragma unroll 8
    for (int d = 0; d < 64; ++d) sc += *(const LAS f32x4*)(scr + 4 * d) * kf[d];
    f32x4 pr;
#pragma unroll
    for (int r = 0; r < 4; ++r) {
        const float s = ok ? sc[r] * 0.125f : -1e30f; const float mx = wave_max(s), mn = fmaxf(m[r], mx), alpha = expf(m[r] - mn);
        const float e = ok ? expf(s - mn) : 0.f; l[r] = l[r] * alpha + wave_sum(e); O[r] *= alpha; m[r] = mn; pr[r] = e;
    }
    *(LAS f32x4*)(scr + 256 + 4 * lane) = pr;
    LDS_WAIT(); asm volatile("" ::: "memory");
#pragma unroll 4
    for (int key = 0; key < nkeys; ++key) {
        O += *(const LAS f32x4*)(scr + 256 + 4 * key) * vf[(size_t)key * vstride + lane];
    }
    LDS_WAIT(); asm volatile("" ::: "memory");
}

__device__ __forceinline__ void nv_nsa_token(const Args& a, LAS float* scr, bool isP, int idx, int g, int t, int row, int lane) {
    unsigned char* ws = a.ws;
    const bf16* PROJ = (const bf16*)(ws + WS_PROJ);
    const int* pt = (const int*)a.in[I_PT];
    {   f32x4 q4;
#pragma unroll
        for (int r = 0; r < 4; ++r) q4[r] = bf2f(PROJ[(size_t)row * NPROJ_PAD + C_NQ + (g * 4 + r) * 64 + lane]);
        *(LAS f32x4*)(scr + 4 * lane) = q4; LDS_WAIT(); asm volatile("" ::: "memory"); }
    const int ncmp = isP ? 64 : 32, nvis = isP ? (t + 1) / 64 : 32;
    const float* kcb = isP ? (const float*)(ws + WS_KCMP_P) + ((size_t)idx * 64 * 2 + g) * 64 : (const float*)(ws + WS_KCMP_S) + ((size_t)idx * 32 * 2 + g) * 64;
    const float* vcb = kcb + (isP ? (size_t)NB * 64 * 2 * 64 : (size_t)DBATCH * 32 * 2 * 64);
    const bool vis = lane < nvis;
    f32x4 p; float imp = 0.f;
    {
        const float* kc = kcb + (size_t)(lane < ncmp ? lane : 0) * 128;
        f32x4 sc = {0.f, 0.f, 0.f, 0.f};
#pragma unroll 8
        for (int d = 0; d < 64; ++d) sc += *(const LAS f32x4*)(scr + 4 * d) * kc[d];
#pragma unroll
        for (int r = 0; r < 4; ++r) { const float s = vis ? sc[r] * 0.125f : -1e30f; const float mx = wave_max(s); const float e = vis ? expf(s - mx) : 0.f;
            const float sum = wave_sum(e); p[r] = e / fmaxf(sum, 1e-30f); imp += p[r]; }
    }
    f32x4 oc = {0.f, 0.f, 0.f, 0.f};
    *(LAS f32x4*)(scr + 256 + 4 * lane) = p; LDS_WAIT(); asm volatile("" ::: "memory");
    for (int n = 0; n < nvis; ++n) oc += *(const LAS f32x4*)(scr + 256 + 4 * n) * vcb[(size_t)n * 128 + lane];
    LDS_WAIT(); asm volatile("" ::: "memory");
    const int cur = t / 64, nsel = isP ? 64 : 33;
    const bool inarr = lane < nsel, valid = inarr && lane <= cur, forced = valid && (lane == 0 || cur - lane < 2);
    const float score = !inarr ? -2.f : (valid ? imp + (forced ? 1000.f : 0.f) : -1.f);
    int rank = 0;
    for (int j = 0; j < 64; ++j) { const float sj = __shfl(score, j); rank += (sj > score || (sj == score && j < lane)) ? 1 : 0; }
    const unsigned long long selmask = __ballot(valid && rank < 16);
    f32x4 ob[2];
#pragma unroll 1
    for (int br = 0; br < 2; ++br) {
        f32x4 m = {-1e30f, -1e30f, -1e30f, -1e30f}, l = {0.f, 0.f, 0.f, 0.f}, O = {0.f, 0.f, 0.f, 0.f};
        const int nblk = br == 0 ? cur + 1 : (isP ? 8 : 9);
#pragma unroll 1
        for (int j = 0; j < nblk; ++j) {
            const float* kf = nullptr; const float* vf = nullptr; size_t vstride = 0; int nkeys = 0; bool ok = false;
            if (br == 0) {
                if (!((selmask >> j) & 1ull)) continue;
                const int kpos = 64 * j + lane; ok = kpos <= t; const int kc = ok ? kpos : t;
                nkeys = (t - 64 * j + 1) < 64 ? (t - 64 * j + 1) : 64; vstride = 512;
                if (isP) { kf = a.out + O_PNSA + ((size_t)(idx * SEQ + kc) * 512 + (4 + g) * 64); vf = a.out + O_PNSA + ((size_t)(idx * SEQ + 64 * j) * 512 + (6 + g) * 64); }
                else if (j < 32) { const int page = pt[idx * NPAGES + (j >> 1)]; const float* base = a.in[I_CNSA] + ((size_t)page * PAGE + (j & 1) * 64) * 512;
                    kf = base + (size_t)lane * 512 + (4 + g) * 64; vf = base + (6 + g) * 64; }
                else { const float* base = a.out + O_SNSA + (size_t)idx * 512; kf = base + (4 + g) * 64; vf = base + (6 + g) * 64; nkeys = 1; }
            } else if (isP) {
                const int k0 = t - 511 + 64 * j;
                if (k0 + 63 < 0) continue;
                const int kb = k0 < 0 ? 0 : k0;
                nkeys = k0 < 0 ? k0 + 64 : 64; ok = lane < nkeys; const int kc = ok ? kb + lane : kb;
                const float* WF = (const float*)(ws + WS_WINF);
                kf = WF + (size_t)(idx * SEQ + kc) * 256 + g * 64; vf = WF + (size_t)(idx * SEQ + kb) * 256 + (2 + g) * 64; vstride = 256;
            } else {
                vstride = 256;
                if (j < 8) { const int c0 = 1 + 64 * j; nkeys = j < 7 ? 64 : 63; ok = lane < nkeys; const int ci = ok ? c0 + lane : c0;
                    kf = a.in[I_CWIN] + ((size_t)idx * 512 + ci) * 256 + g * 64; vf = a.in[I_CWIN] + ((size_t)idx * 512 + c0) * 256 + (2 + g) * 64; }
                else { const float* nb_ = a.out + O_SWIN + ((size_t)idx * 512 + 511) * 256; kf = nb_ + g * 64; vf = nb_ + (2 + g) * 64; nkeys = 1; ok = lane == 0; }
            }
            nv_attend(scr, kf, ok, vf, vstride, nkeys, lane, m, l, O);
        }
#pragma unroll
        for (int r = 0; r < 4; ++r) O[r] = O[r] / fmaxf(l[r], 1e-30f);
        ob[br] = O;
    }
    const float* GL = (const float*)(ws + WS_GL) + (size_t)row * 24;
#pragma unroll
    for (int r = 0; r < 4; ++r) {
        const float gc = sigmoidf_(GL[(g * 4 + r) * 3 + 0]), gs = sigmoidf_(GL[(g * 4 + r) * 3 + 1]), gw = sigmoidf_(GL[(g * 4 + r) * 3 + 2]);
        const float y = gc * oc[r] + gs * ob[0][r] + gw * ob[1][r];
        ((bf16*)(ws + WS_MIX))[(size_t)row * DM + 512 + (g * 4 + r) * 64 + lane] = (bf16)(pk2(y, 0.f) & 0xffffu);
    }
}

__device__ __forceinline__ void nv_mem_attn(const Args& a, LAS float* scr, int row, int head, int lane) {
    unsigned char* ws = a.ws;
    const bool isP = row < MP; const int s = row - MP, b = row >> 12;
    const bf16* qm = (const bf16*)(ws + WS_QM) + (size_t)row * DM + head * 256;
#pragma unroll
    for (int j = 0; j < 4; ++j) scr[lane + 64 * j] = bf2f(qm[lane + 64 * j]);
    LDS_WAIT(); asm volatile("" ::: "memory");
    float sc[4];
#pragma unroll
    for (int j = 0; j < 4; ++j) {
        const int mkey = lane + 64 * j; float acc = 0.f;
        if (isP) { const bf16* kr = (const bf16*)(ws + WS_MEMKV) + (size_t)(b * MEMLEN + mkey) * 2048 + head * 256;
            for (int d = 0; d < 256; ++d) acc += scr[d] * bf2f(kr[d]); }
        else { const float* kr = a.in[I_CMEM] + ((size_t)(s * MEMLEN + mkey) * 2 + 0) * 1024 + head * 256;
            for (int d = 0; d < 256; ++d) acc += scr[d] * kr[d]; }
        sc[j] = acc * 0.0625f;
    }
    float mx = fmaxf(fmaxf(sc[0], sc[1]), fmaxf(sc[2], sc[3])); mx = wave_max(mx);
    float sum = 0.f;
#pragma unroll
    for (int j = 0; j < 4; ++j) { sc[j] = expf(sc[j] - mx); sum += sc[j]; }
    sum = wave_sum(sum); const float inv = 1.f / sum;
    LDS_WAIT(); asm volatile("" ::: "memory");
#pragma unroll
    for (int j = 0; j < 4; ++j) scr[256 + lane + 64 * j] = sc[j] * inv;
    LDS_WAIT(); asm volatile("" ::: "memory");
    float o[4] = {0.f, 0.f, 0.f, 0.f};
    for (int mkey = 0; mkey < MEMLEN; ++mkey) {
        const float pm = scr[256 + mkey];
        if (isP) { const bf16* vr = (const bf16*)(ws + WS_MEMKV) + (size_t)(b * MEMLEN + mkey) * 2048 + 1024 + head * 256;
#pragma unroll
            for (int j = 0; j < 4; ++j) o[j] += pm * bf2f(vr[lane + 64 * j]); }
        else { const float* vr = a.in[I_CMEM] + ((size_t)(s * MEMLEN + mkey) * 2 + 1) * 1024 + head * 256;
#pragma unroll
            for (int j = 0; j < 4; ++j) o[j] += pm * vr[lane + 64 * j]; }
    }
    bf16* om = (bf16*)(ws + WS_OM) + (size_t)row * DM + head * 256;
#pragma unroll
    for (int j = 0; j < 4; ++j) om[lane + 64 * j] = (bf16)(pk2(o[j], 0.f) & 0xffffu);
    LDS_WAIT(); asm volatile("" ::: "memory");
}

__device__ __forceinline__ void final_norm_row(const Args& a, int row, int lane) {
    float* y = (row < MP) ? a.out + O_YP + (size_t)row * DM : a.out + O_YS + (size_t)(row - MP) * DM;
    const float* sp = (const float*)(a.ws + WS_SSQ3) + (size_t)row * 16;
    float s = 0.f;
#pragma unroll
    for (int i = 0; i < 16; ++i) s += sp[i];
    const float rs = rsqrtf(s * (1.f / 1024.f) + RMS_EPS);
#pragma unroll
    for (int j = 0; j < 4; ++j) { f32x4 v = ((f32x4*)y)[lane + 64 * j]; const f32x4 gq = ((const f32x4*)a.in[I_LNF])[lane + 64 * j]; v = v * rs * gq; ((f32x4*)y)[lane + 64 * j] = v; }
}
constexpr int N_PHASES = 12;
template <int LO, int HI> __global__ void __launch_bounds__(NTHREADS, 2) fwd(Args a) {
    extern __shared__ __attribute__((aligned(16))) unsigned char lds_raw[];
    Frame F; F.lds = (LAS unsigned char*)lds_raw; F.tid = threadIdx.x; F.lane = F.tid & 63; F.wave = __builtin_amdgcn_readfirstlane(F.tid >> 6); F.G = gridDim.x; F.bid = blockIdx.x;
    volatile LAS unsigned* MISC = (volatile LAS unsigned*)(F.lds + MISC_OFF);
    for (int u = F.tid; u < (LDS_BYTES - RING_BYTES) / 4; u += NTHREADS) ((LAS unsigned*)(F.lds + RING_BYTES))[u] = 0u;
    __syncthreads();
    constexpr int lo = LO, hi = HI;
    unsigned* barw = (unsigned*)(a.ws + WS_CTL) + CW_BAR;
    XcdBarrier bar; bar.bar = barw; bar.x = 0; bar.st = nullptr;
    if (hi - lo > 1) bar = xcd_barrier_post(barw, MISC + 8);
#define IN(k) (lo <= (k) && (k) < hi)
#define SEAM(k) do { if (IN(k) && IN((k) + 1)) xcd_barrier(bar); } while (0)
    unsigned char* ws = a.ws;

    if (IN(0)) { p0_prologue(F, a); }
    SEAM(0);
    if (IN(1)) {
        { pg8::Gemm g{(const bf16*)(ws + WS_XB), (const bf16*)(ws + WS_WIN_T), MT, NPROJ_PAD, DM}; pg8::StaticOrder S; S.init(MT, NPROJ_PAD, F.G, F.bid);
          Epi<0> E{a.out, ws, a.in[I_XP], a.in[I_XS]};
          pg8::gemm_phase<Epi<0>, pg8::StaticOrder, false, true>(F.lds, g, S, E); }
        __syncthreads();
        { pg8::Gemm g{(const bf16*)(ws + WS_MB), (const bf16*)(ws + WS_WMKV_T), 1024, 2048, DM}; pg8::StaticOrder S; S.init(1024, 2048, F.G, (F.bid + 32) % F.G);
          Epi<1> E{a.out, ws, a.in[I_XP], a.in[I_XS]};
          pg8::gemm_phase<Epi<1>, pg8::StaticOrder, false, true>(F.lds, g, S, E); }
    }
    SEAM(1);
    if (IN(2)) {
        sample_copies(F, a);
        {
          const size_t gt = (size_t)F.bid * NTHREADS + F.tid, GT = (size_t)F.G * NTHREADS;
          v4u* m0 = (v4u*)((bf16*)(ws + WS_MIX) + (size_t)(MP + DBATCH) * DM); v4u* m1 = (v4u*)((bf16*)(ws + WS_OM) + (size_t)(MP + DBATCH) * DM);
          for (size_t i = gt; i < (size_t)128 * DM / 8; i += GT) { m0[i] = (v4u){0u, 0u, 0u, 0u}; m1[i] = (v4u){0u, 0u, 0u, 0u}; } }
        const int gw = F.bid * NWAVES + F.wave, NGW = F.G * NWAVES;
        for (int r = gw; r < MP + DBATCH; r += NGW) nv_conv_row(a, r, F.lane);
        for (int it = gw; it < 1024 + 16384; it += NGW) nv_compress(a, it, F.lane);
    }
    SEAM(2);
    if (IN(3)) {
        const int gw = F.bid * NWAVES + F.wave, NGW = F.G * NWAVES;
        for (int it = gw; it < (NB + DBATCH) * 8; it += NGW) nv_dn_seq(a, it >> 3, it & 7, F.lane);
    }
    if (IN(4)) {
        const int gw = F.bid * NWAVES + F.wave, NGW = F.G * NWAVES;
        LAS float* scr = (LAS float*)(F.lds + F.wave * 16384);
        for (int r = gw; r < (MP + DBATCH) * 2; r += NGW) { const int tok = r >> 1, g = r & 1;
            const bool isP = tok < MP;
            nv_nsa_token(a, scr, isP, isP ? tok >> 12 : tok - MP, g, isP ? (tok & (SEQ - 1)) : PAST, tok, F.lane); }
    }
    SEAM(4);
    if (IN(5)) { pg8::Gemm g{(const bf16*)(ws + WS_MIX), (const bf16*)(ws + WS_WOUT_T), MT, DM, DM}; pg8::StaticOrder S; S.init(MT, DM, F.G, F.bid);
        Epi<2> E{a.out, ws, a.in[I_XP], a.in[I_XS]}; pg8::gemm_phase<Epi<2>, pg8::StaticOrder, false, true>(F.lds, g, S, E); }
    SEAM(5);
    if (IN(6)) { pg8::Gemm g{(const bf16*)(ws + WS_X1B), (const bf16*)(ws + WS_WMQ_T), MT, DM, DM}; pg8::StaticOrder S; S.init(MT, DM, F.G, F.bid);
        Epi<3> E{a.out, ws, a.in[I_XP], a.in[I_XS]}; pg8::gemm_phase<Epi<3>, pg8::StaticOrder, false, true>(F.lds, g, S, E); }
    SEAM(6);
    if (IN(7)) {
        const int gw = F.bid * NWAVES + F.wave, NGW = F.G * NWAVES;
        LAS float* scr = (LAS float*)(F.lds + F.wave * 16384);
        for (int it = gw; it < (MP + DBATCH) * 4; it += NGW) nv_mem_attn(a, scr, it >> 2, it & 3, F.lane);
    }
    SEAM(7);
    if (IN(8)) { pg8::Gemm g{(const bf16*)(ws + WS_OM), (const bf16*)(ws + WS_WMO_T), MT, DM, DM}; pg8::StaticOrder S; S.init(MT, DM, F.G, F.bid);
        Epi<4> E{a.out, ws, a.in[I_XP], a.in[I_XS]}; pg8::gemm_phase<Epi<4>, pg8::StaticOrder, false, true>(F.lds, g, S, E); }
    SEAM(8);
    if (IN(9)) { pg8::Gemm g{(const bf16*)(ws + WS_X2B), (const bf16*)(ws + WS_WUP_T), MT, DFF, DM}; pg8::StaticOrder S; S.init(MT, DFF, F.G, F.bid);
        Epi<5> E{a.out, ws, a.in[I_XP], a.in[I_XS]}; pg8::gemm_phase<Epi<5>, pg8::StaticOrder, false, true>(F.lds, g, S, E); }
    SEAM(9);
    if (IN(10)) { pg8::Gemm g{(const bf16*)(ws + WS_UP), (const bf16*)(ws + WS_WDN_T), MT, DM, DFF}; pg8::StaticOrder S; S.init(MT, DM, F.G, F.bid);
        Epi<6> E{a.out, ws, a.in[I_XP], a.in[I_XS]}; pg8::gemm_phase<Epi<6>, pg8::StaticOrder, false, true>(F.lds, g, S, E); }
    SEAM(10);
    if (IN(11)) {
        const int gw = F.bid * NWAVES + F.wave, NGW = F.G * NWAVES;
        for (int r = gw; r < MP + DBATCH; r += NGW) final_norm_row(a, r, F.lane);
    }
#undef IN
#undef SEAM
}

template <int LO, int HI> static bool launch_range(int& grid, const Args& a, hipStream_t stream) {
    static bool prepared = false;
    if (!prepared) { if (hipFuncSetAttribute((const void*)fwd<LO, HI>, hipFuncAttributeMaxDynamicSharedMemorySize, LDS_BYTES) != hipSuccess) { fprintf(stderr, "kernel_launch: hipFuncSetAttribute failed\n"); return false; } prepared = true; }
    hipLaunchKernelGGL((fwd<LO, HI>), dim3(grid), dim3(NTHREADS), LDS_BYTES, stream, a);
    return hipPeekAtLastError() == hipSuccess;
}
extern "C" void kernel_launch(void* const* d_in, const int* in_sizes, int n_in, void* d_out, int out_size, void* d_ws, size_t ws_size, hipStream_t stream) {
    static int grid = 0;
    if (grid == 0) {
        if (n_in != N_IN || (size_t)out_size != O_END || ws_size < WS_END) { fprintf(stderr, "kernel_launch: unexpected shapes n_in %d out %d ws %zu\n", n_in, out_size, ws_size); grid = -1; return; }
        int dev = 0, cus = 0;
        if (hipGetDevice(&dev) != hipSuccess || hipDeviceGetAttribute(&cus, hipDeviceAttributeMultiprocessorCount, dev) != hipSuccess) { grid = -1; return; }
        grid = cus;
    }
    if (grid < 0) return;
    (void)hipMemsetAsync((char*)d_ws + WS_CTL, 0, CTL_ZERO_BYTES, stream);
    Args a{};
    for (int i = 0; i < N_IN; ++i) a.in[i] = (const float*)d_in[i];
    a.out = (float*)d_out; a.ws = (unsigned char*)d_ws;
#ifndef MK_ONE_LAUNCH
#define MK_ONE_LAUNCH 1
#endif
#if MK_ONE_LAUNCH
    launch_range<0, 12>(grid, a, stream);
#else
    launch_range<0, 1>(grid, a, stream); launch_range<1, 2>(grid, a, stream); launch_range<2, 3>(grid, a, stream); launch_range<3, 4>(grid, a, stream);
    launch_range<4, 5>(grid, a, stream); launch_range<5, 6>(grid, a, stream); launch_range<6, 7>(grid, a, stream); launch_range<7, 8>(grid, a, stream);
    launch_range<8, 9>(grid, a, stream); launch_range<9, 10>(grid, a, stream); launch_range<10, 11>(grid, a, stream); launch_range<11, 12>(grid, a, stream);
#endif
}
```

```cpp
#include <hip/hip_runtime.h>
#include <cstdio>
#include <cstdint>
#define LAS __attribute__((address_space(3)))
#define GAS __attribute__((address_space(1)))
namespace pg8 {
#define PG8_LAS __attribute__((address_space(3)))
typedef unsigned short bf16_t;
typedef short bf16x8 __attribute__((ext_vector_type(8)));
typedef float f32x4 __attribute__((ext_vector_type(4)));
typedef unsigned u32x4 __attribute__((ext_vector_type(4)));
constexpr int BM = 256, BK = 64, HALF = 128, HTB = HALF * BK * 2  , STAGE_BYTES = 8 * HTB, NXCD = 8, WGM = 8;

__host__ __device__ __forceinline__ int lds_byte(int r, int c) { const int st = (r >> 4) * 2 + (c >> 5), rr = r & 15, cc = c & 31, ob = rr * 64 + cc * 2; return st * 1024 + (ob ^ (((ob >> 9) & 1) << 5)); }
__host__ __device__ __forceinline__ void stage_rc(int b, int& R, int& C) { const int st = b / 1024, sb = b % 1024, swz = sb ^ (((sb >> 9) & 1) << 5); R = (st >> 1) * 16 + swz / 64; C = (st & 1) * 32 + (swz % 64) / 2; }
__host__ __device__ __forceinline__ int perm32(int rho) { const int n = rho >> 4, i = rho & 15; return 8 * (i >> 2) + 4 * n + (i & 3); }

struct Unit { int pm, pn; };
struct Gemm { const bf16_t* A; const bf16_t* Bt; int M, N, K; };

struct StaticOrder {
    int nM, nN, nwg, G, c;
    __host__ __device__ void init(int M, int N, int G_, int c_) { nM = M / BM; nN = N / BM; nwg = nM * nN; G = G_; c = c_; }
    __host__ __device__ bool next(int i, Unit& u) const {
        const long L = (long)i * G + c; if (L >= nwg) return false;
        int wgid = (int)L; { const int q = nwg / NXCD, r = nwg % NXCD, xcd = wgid % NXCD, off = wgid / NXCD; wgid = (xcd < r ? xcd * (q + 1) : r * (q + 1) + (xcd - r) * q) + off; }
        const int nig = WGM * nN, gid = wgid / nig, fm = gid * WGM, gsz = (nM - fm) < WGM ? (nM - fm) : WGM;
        u.pm = fm + ((wgid % nig) % gsz); u.pn = (wgid % nig) / gsz; return true;
    }
    __device__ __forceinline__ void a_ready(const Unit&) const {}
    __device__ __forceinline__ void done(const Unit&) const {}
};

template <class Epi, class Sched, bool ALIGN_EPI = false, bool SP2 = false>
__device__ __forceinline__ void gemm_phase(PG8_LAS unsigned char* lds, const Gemm g, const Sched& S, const Epi& E) {
    int tid_o = threadIdx.x; asm volatile("" : "+v"(tid_o));
    const int tid = tid_o, wid = __builtin_amdgcn_readfirstlane(tid >> 6), lane = tid & 63, wr = wid >> 2, wc = wid & 3, fr = lane & 15, fq = lane >> 4;
    const int K = g.K, nt = K / BK;
    unsigned voffA[2], voffB[2];
#pragma unroll
    for (int i = 0; i < 2; ++i) { int R, C; stage_rc(tid * 16 + i * 8192, R, C); const int Rb = Epi::PERM ? ((R & ~31) + perm32(R & 31)) : R;
        voffA[i] = (unsigned)(R * K + C) * 2u; voffB[i] = (unsigned)(Rb * K + C) * 2u; }
    const size_t kstep = (size_t)(BK * 2);
    const size_t hstep = (size_t)HALF * K * 2;
    const size_t tstep = 2 * hstep;
    const unsigned ldsw = (unsigned)wid * 1024u;
    const int aoff = lds_byte(wr * 64 + fr, fq * 8), boff = lds_byte(wc * 32 + fr, fq * 8);
#define PG8_SA(b, h) (((b) * 2 + (h)) * HTB)
#define PG8_SB(b, h) ((4 + (b) * 2 + (h)) * HTB)
#define PG8_STAGE(bufoff, gbase, voff) do { _Pragma("unroll") for (int _i = 0; _i < 2; ++_i) \
        __builtin_amdgcn_global_load_lds((const unsigned*)((const char*)(gbase) + (voff)[_i]), (PG8_LAS unsigned*)(lds + (bufoff) + ldsw + _i * 8192), 16, 0, 0); } while (0)
#define PG8_LDA(dst, b, h) do { _Pragma("unroll") for (int m = 0; m < 4; ++m) _Pragma("unroll") for (int k = 0; k < 2; ++k) dst[m][k] = *(const PG8_LAS bf16x8*)(lds + PG8_SA(b, h) + aoff + m * 2048 + k * 1024); } while (0)
#define PG8_LDB(dst, b, h) do { _Pragma("unroll") for (int n = 0; n < 2; ++n) _Pragma("unroll") for (int k = 0; k < 2; ++k) dst[n][k] = *(const PG8_LAS bf16x8*)(lds + PG8_SB(b, h) + boff + n * 2048 + k * 1024); } while (0)
#define PG8_MMA(ai, bj, At, Bt) do { __builtin_amdgcn_s_setprio(1); _Pragma("unroll") for (int m = 0; m < 4; ++m) _Pragma("unroll") for (int n = 0; n < 2; ++n) _Pragma("unroll") for (int k = 0; k < 2; ++k) \
        acc[ai][bj][m][n] = __builtin_amdgcn_mfma_f32_16x16x32_bf16(Bt[n][k], At[m][k], acc[ai][bj][m][n], 0, 0, 0); __builtin_amdgcn_s_setprio(0); } while (0)
#define PG8_WAIT_V(n) asm volatile("s_waitcnt vmcnt(" #n ")" ::: "memory")
#define PG8_WAIT_L(n) asm volatile("s_waitcnt lgkmcnt(" #n ")" ::: "memory")
#define PG8_BAR __builtin_amdgcn_s_barrier()
#define PG8_SCHED __builtin_amdgcn_sched_barrier(0)
    Unit cur, nxt; int ui = 0;
    if (!S.next(0, cur)) return;
    f32x4 acc[2][2][4][2];
#pragma unroll
    for (int a = 0; a < 2; ++a)
#pragma unroll
        for (int b = 0; b < 2; ++b)
#pragma unroll
            for (int m = 0; m < 4; ++m)
#pragma unroll
                for (int n = 0; n < 2; ++n) acc[a][b][m][n] = (f32x4){0.f, 0.f, 0.f, 0.f};
    bf16x8 At[4][2], B0[2][2], B1[2][2];
    const char* cA = (const char*)g.A + (size_t)cur.pm * tstep; const char* cB = (const char*)g.Bt + (size_t)cur.pn * tstep;
    S.a_ready(cur);
    if constexpr (SP2) {
        PG8_STAGE(PG8_SB(0, 0), cB, voffB); PG8_STAGE(PG8_SB(0, 1), cB + hstep, voffB); PG8_STAGE(PG8_SA(0, 0), cA, voffA); PG8_STAGE(PG8_SA(0, 1), cA + hstep, voffA);
        if (wr == 1) PG8_BAR;
        PG8_WAIT_V(2); PG8_BAR;
        PG8_STAGE(PG8_SB(1, 0), cB + kstep, voffB); PG8_STAGE(PG8_SA(1, 0), cA + kstep, voffA); PG8_STAGE(PG8_SB(1, 1), cB + hstep + kstep, voffB);
        PG8_WAIT_V(6); PG8_BAR;
    } else {
        PG8_STAGE(PG8_SB(0, 0), cB, voffB); PG8_STAGE(PG8_SA(0, 0), cA, voffA); PG8_STAGE(PG8_SB(0, 1), cB + hstep, voffB); PG8_STAGE(PG8_SA(0, 1), cA + hstep, voffA);
        if (wr == 1) PG8_BAR;
        PG8_WAIT_V(4); PG8_BAR;
        PG8_STAGE(PG8_SB(1, 0), cB + kstep, voffB); PG8_STAGE(PG8_SA(1, 0), cA + kstep, voffA); PG8_STAGE(PG8_SB(1, 1), cB + hstep + kstep, voffB);
        PG8_WAIT_V(6); PG8_BAR;
    }
    for (;;) {
        const bool has_next = S.next(ui + 1, nxt);
        const char* nA = has_next ? (const char*)g.A + (size_t)nxt.pm * tstep : cA; const char* nB = has_next ? (const char*)g.Bt + (size_t)nxt.pn * tstep : cB;
        for (int t = 0; t < nt; t += 2) {
            const bool last = (t == nt - 2);
            const char* a1 = cA + (size_t)(t + 1) * kstep;
            const char* a2 = last ? nA : cA + (size_t)(t + 2) * kstep; const char* b2 = last ? nB : cB + (size_t)(t + 2) * kstep;
            const char* a3 = a2 + kstep; const char* b3 = b2 + kstep;
            if (last && has_next) S.a_ready(nxt);
            if constexpr (SP2) {
            PG8_LDB(B0, 0, 0); PG8_LDB(B1, 0, 1); PG8_SCHED; PG8_LDA(At, 0, 0); PG8_STAGE(PG8_SA(1, 1), a1 + hstep, voffA);
            PG8_WAIT_V(8); PG8_WAIT_L(0); PG8_BAR; PG8_MMA(0, 0, At, B0); PG8_MMA(0, 1, At, B1); PG8_BAR; PG8_SCHED;
            PG8_LDA(At, 0, 1); PG8_STAGE(PG8_SB(0, 0), b2, voffB); PG8_STAGE(PG8_SB(0, 1), b2 + hstep, voffB); PG8_STAGE(PG8_SA(0, 0), a2, voffA);
            PG8_WAIT_V(8); PG8_WAIT_L(0); PG8_BAR; PG8_MMA(1, 0, At, B0); PG8_MMA(1, 1, At, B1); PG8_BAR; PG8_SCHED;
            PG8_LDB(B0, 1, 0); PG8_LDB(B1, 1, 1); PG8_SCHED; PG8_LDA(At, 1, 0); PG8_STAGE(PG8_SA(0, 1), a2 + hstep, voffA);
            PG8_WAIT_V(8); PG8_WAIT_L(0); PG8_BAR; PG8_MMA(0, 0, At, B0); PG8_MMA(0, 1, At, B1); PG8_BAR; PG8_SCHED;
            PG8_LDA(At, 1, 1); PG8_STAGE(PG8_SB(1, 0), b3, voffB); PG8_STAGE(PG8_SB(1, 1), b3 + hstep, voffB); PG8_STAGE(PG8_SA(1, 0), a3, voffA);
            PG8_WAIT_V(8); PG8_WAIT_L(0); PG8_BAR; PG8_MMA(1, 0, At, B0); PG8_MMA(1, 1, At, B1); PG8_BAR; PG8_SCHED;
            } else {
            PG8_LDB(B0, 0, 0); PG8_SCHED; PG8_LDA(At, 0, 0); PG8_STAGE(PG8_SA(1, 1), a1 + hstep, voffA);
            PG8_WAIT_L(8); PG8_BAR; PG8_WAIT_L(0); PG8_MMA(0, 0, At, B0); PG8_BAR; PG8_SCHED;
            PG8_LDB(B1, 0, 1); PG8_STAGE(PG8_SB(0, 0), b2, voffB);
            PG8_BAR; PG8_WAIT_L(0); PG8_MMA(0, 1, At, B1); PG8_BAR;
            PG8_LDA(At, 0, 1); PG8_STAGE(PG8_SA(0, 0), a2, voffA);
            PG8_BAR; PG8_WAIT_L(0); PG8_MMA(1, 0, At, B0); PG8_BAR; PG8_SCHED;
            PG8_STAGE(PG8_SB(0, 1), b2 + hstep, voffB);
            PG8_WAIT_V(6); PG8_BAR; PG8_MMA(1, 1, At, B1); PG8_BAR;
            PG8_LDB(B0, 1, 0); PG8_SCHED; PG8_LDA(At, 1, 0); PG8_STAGE(PG8_SA(0, 1), a2 + hstep, voffA);
            PG8_WAIT_L(8); PG8_BAR; PG8_WAIT_L(0); PG8_MMA(0, 0, At, B0); PG8_BAR; PG8_SCHED;
            PG8_LDB(B1, 1, 1); PG8_STAGE(PG8_SB(1, 0), b3, voffB);
            PG8_BAR; PG8_WAIT_L(0); PG8_MMA(0, 1, At, B1); PG8_BAR;
            PG8_LDA(At, 1, 1); PG8_STAGE(PG8_SA(1, 0), a3, voffA);
            PG8_BAR; PG8_WAIT_L(0); PG8_MMA(1, 0, At, B0); PG8_BAR; PG8_SCHED;
            PG8_STAGE(PG8_SB(1, 1), b3 + hstep, voffB);
            PG8_WAIT_V(6); PG8_BAR; PG8_MMA(1, 1, At, B1); PG8_BAR;
            }
        }
        if constexpr (ALIGN_EPI) { if (wr == 0) PG8_BAR; }
        if constexpr (!Epi::AFTER_DRAIN) { E(acc, cur, wr, wc, fr, fq); S.done(cur); }
        if (!has_next) break;
#pragma unroll
        for (int a = 0; a < 2; ++a)
#pragma unroll
            for (int b = 0; b < 2; ++b)
#pragma unroll
                for (int m = 0; m < 4; ++m)
#pragma unroll
                    for (int n = 0; n < 2; ++n) acc[a][b][m][n] = (f32x4){0.f, 0.f, 0.f, 0.f};
        cur = nxt; cA = nA; cB = nB; ++ui;
        if constexpr (ALIGN_EPI) { if (wr == 1) PG8_BAR; }
    }
    PG8_WAIT_V(0);
    if constexpr (!ALIGN_EPI) { if (wr == 0) PG8_BAR; }
    PG8_BAR;
    if constexpr (Epi::AFTER_DRAIN) { E.fused(acc, cur, wr, wc, fr, fq, lds, wid, lane); S.done(cur); }
#undef PG8_SA
#undef PG8_SB
#undef PG8_STAGE
#undef PG8_LDA
#undef PG8_LDB
#undef PG8_MMA
#undef PG8_WAIT_V
#undef PG8_WAIT_L
#undef PG8_BAR
#undef PG8_SCHED
}
}
#define XB_TMO      128
#define XB_XCNT(j)  (256  + 64 * (j))
#define XB_XSUB(j)  (1280 + 64 * (j))
#define XB_XGEN(j)  (2304 + 64 * (j))
#define XB_TOP      3328
#define XB_TOPGEN   3392
#define XCD_BAR_WORDS 3456
#define XB_SPIN_CAP (1u << 18)

__device__ __forceinline__ unsigned xb_ld(unsigned* p)              { return __hip_atomic_load(p, __ATOMIC_RELAXED, __HIP_MEMORY_SCOPE_AGENT); }
__device__ __forceinline__ unsigned xb_add(unsigned* p, unsigned v) { return __hip_atomic_fetch_add(p, v, __ATOMIC_RELAXED, __HIP_MEMORY_SCOPE_AGENT); }
__device__ __forceinline__ unsigned xb_xcc_id() { return (unsigned)__builtin_amdgcn_s_getreg((3 << 11) | 20) & 0xFu; }
#define XB_SPIN(cond, bar) do { unsigned _sp = 0; while (cond) { __builtin_amdgcn_s_sleep(1); \
    if ((++_sp & 255u) == 0u) { if (xb_ld(&(bar)[XB_TMO])) break; if (_sp > XB_SPIN_CAP) { atomicAdd(&(bar)[XB_TMO], 1u); break; } } } } while (0)

struct XcdBarrier {
    unsigned* bar; unsigned x;
    volatile LAS unsigned* st;
};

__device__ __forceinline__ XcdBarrier xcd_barrier_post(unsigned* bar, volatile LAS unsigned* st) {
    XcdBarrier b; b.bar = bar; b.x = xb_xcc_id(); b.st = st;
    if (threadIdx.x == 0) (void)xb_add(&bar[XB_XCNT(b.x)], 1u);
    return b;
}
__device__ __forceinline__ void xcd_barrier_complete(unsigned* bar, unsigned x, unsigned& nloc, unsigned& nx) {
    const unsigned G = gridDim.x * gridDim.y * gridDim.z;
    unsigned sum, cnt, mine, sp = 0u;
    for (;;) {
        sum = 0u; cnt = 0u; mine = 0u;
#pragma unroll
        for (unsigned j = 0; j < 16; ++j) { const unsigned c = xb_ld(&bar[XB_XCNT(j)]); sum += c; cnt += (c > 0u) ? 1u : 0u; mine = (j == x) ? c : mine; }
        if (sum == G) break;
        __builtin_amdgcn_s_sleep(1);
        if ((++sp & 255u) == 0u) { if (xb_ld(&bar[XB_TMO])) break; if (sp > XB_SPIN_CAP) { atomicAdd(&bar[XB_TMO], 1u); break; } }
    }
    nloc = mine > 0u ? mine : 1u; nx = cnt > 0u ? cnt : 1u;
}

__device__ __forceinline__ void xcd_barrier(const XcdBarrier& b) {
    asm volatile("s_waitcnt vmcnt(0)" ::: "memory");
    __syncthreads();
    if (threadIdx.x == 0) {
        unsigned* bar = b.bar;
        __builtin_amdgcn_s_waitcnt(0);
        unsigned nloc = b.st[0], nx = b.st[1];
        if (nloc == 0u) { xcd_barrier_complete(bar, b.x, nloc, nx); b.st[0] = nloc; b.st[1] = nx; }
        const unsigned old = xb_add(&bar[XB_XSUB(b.x)], 1u);
        const unsigned gen = old / nloc;
        if (old + 1u == (gen + 1u) * nloc) {
            __builtin_amdgcn_fence(__ATOMIC_RELEASE, "agent");
            asm volatile("s_waitcnt vmcnt(0)" ::: "memory");
            const unsigned og = xb_add(&bar[XB_TOP], 1u);
            const unsigned tg = og / nx;
            if (og + 1u == (tg + 1u) * nx) xb_add(&bar[XB_TOPGEN], 1u);
            else XB_SPIN(xb_ld(&bar[XB_TOPGEN]) == tg, bar);
            __builtin_amdgcn_fence(__ATOMIC_ACQUIRE, "agent");
            xb_add(&bar[XB_XGEN(b.x)], 1u);
            asm volatile("s_waitcnt vmcnt(0)" ::: "memory");
        } else {
            XB_SPIN(xb_ld(&bar[XB_XGEN(b.x)]) == gen, bar);
            __builtin_amdgcn_fence(__ATOMIC_ACQUIRE, "agent");
            asm volatile("s_waitcnt vmcnt(0)" ::: "memory");
        }
    }
    __syncthreads();
}
constexpr int NWAVES = 8, NTHREADS = NWAVES * 64;
constexpr int DM = 1024, NB = 4, SEQ = 4096, MP = NB * SEQ;
constexpr int DBATCH = 128;
constexpr int MT = MP + 256;
constexpr int PAST = 2048, PAGE = 128, NPAGES = PAST / PAGE, NPHYS = 2560, WBUF = 512;
constexpr int HD = 64, NG = 2;
constexpr int C_QKV = 0, C_Z = 1536, C_B = 2048, C_A = 2056, C_NQ = 2064, C_NKV = 2576, C_WIN = 3088, C_G = 3344, NPROJ = 3368, NPROJ_PAD = 3584;
constexpr int DFF = 4096, MEMLEN = 256, MEMH = 4, MEMD = 256;
constexpr int NCHUNK = SEQ / 64;
constexpr float RMS_EPS = 1e-6f;

enum { I_XP = 0, I_XS, I_MEMP, I_CNSA, I_CWIN, I_CMEM, I_SCONV, I_SREC, I_PT, I_LNMIX, I_WIN, I_CONVW, I_ALOG, I_DTB, I_DNNORM, I_PE, I_W1, I_B1, I_W2,
       I_WOUT, I_LNMEM, I_LNMEMKV, I_WMQ, I_WMKV, I_WMO, I_LNFFN, I_WUP, I_WDN, I_LNF, N_IN };
constexpr size_t O_YP = 0, O_YS = O_YP + (size_t)MP * DM, O_PNSA = O_YS + (size_t)DBATCH * DM, O_PWIN = O_PNSA + (size_t)MP * 512,
                 O_PMEM = O_PWIN + (size_t)NB * 512 * 256, O_PCONV = O_PMEM + (size_t)NB * MEMLEN * 2048, O_PREC = O_PCONV + (size_t)NB * 3 * 1536,
                 O_SNSA = O_PREC + (size_t)NB * 8 * 4096, O_SWIN = O_SNSA + (size_t)DBATCH * 512, O_SCONV = O_SWIN + (size_t)DBATCH * 512 * 256,
                 O_SREC = O_SCONV + (size_t)DBATCH * 3 * 1536, O_END = O_SREC + (size_t)DBATCH * 8 * 4096;
static_assert(O_END == 49694720, "output map");

constexpr size_t MiB = 1u << 20;
constexpr size_t WS_CTL = 0, CTL_ZERO_BYTES = 160 * 1024;
constexpr size_t WS_WIN_T = 2 * MiB;
constexpr size_t WS_WOUT_T = 10 * MiB;
constexpr size_t WS_WMQ_T = 12 * MiB;
constexpr size_t WS_WMKV_T = 14 * MiB;
constexpr size_t WS_WMO_T = 18 * MiB;
constexpr size_t WS_WUP_T = 20 * MiB;
constexpr size_t WS_WDN_T = 28 * MiB;
constexpr size_t WS_W1_T = 36 * MiB;
constexpr size_t WS_SSQ0 = 38 * MiB;
constexpr size_t WS_SSQM = WS_SSQ0 + 128 * 1024;
constexpr size_t WS_PEB = WS_SSQM + 64 * 1024;
constexpr size_t WS_SSQ1 = 40 * MiB, WS_SSQ2 = 42 * MiB, WS_SSQ3 = 44 * MiB;
constexpr size_t WS_SSQS1 = 45 * MiB, WS_SSQS2 = WS_SSQS1 + 65536, WS_SSQS3 = WS_SSQS2 + 65536;
constexpr size_t WS_BA = 46 * MiB;
constexpr size_t WS_GL = 48 * MiB;
constexpr size_t WS_KCMP_P = 50 * MiB;
constexpr size_t WS_KCMP_S = 52 * MiB;
constexpr size_t WS_XB = 64 * MiB;
constexpr size_t WS_MB = 98 * MiB;
constexpr size_t WS_MEMKV = 100 * MiB;
constexpr size_t WS_PROJ = 104 * MiB;
constexpr size_t WS_MIX = 220 * MiB;
constexpr size_t WS_X1 = 256 * MiB;
constexpr size_t WS_YB = WS_X1;
constexpr size_t WS_X1B = 322 * MiB;
constexpr size_t WS_QM = 356 * MiB;
constexpr size_t WS_OM = 390 * MiB;
constexpr size_t WS_X2 = 424 * MiB;
constexpr size_t WS_X2B = 490 * MiB;
constexpr size_t WS_UP = 524 * MiB;
constexpr size_t WS_DN = 656 * MiB;
constexpr size_t WS_GLAST = 740 * MiB;
constexpr size_t WS_ODN = 744 * MiB;
constexpr size_t WS_QKVN = 768 * MiB;
constexpr size_t WS_BG = 872 * MiB;
constexpr size_t WS_WINF = 876 * MiB;
constexpr size_t WS_DBG = 896 * MiB;
constexpr size_t WS_QKVB = 932 * MiB;
constexpr size_t WS_DBG2 = 984 * MiB;
constexpr size_t WS_VTG = 992 * MiB;
constexpr size_t WS_MVT = 1002 * MiB;
constexpr size_t WS_END = 1006 * MiB;
static_assert(WS_XB + (size_t)MT * DM * 2 <= WS_MB && WS_PROJ + (size_t)MT * NPROJ_PAD * 2 <= WS_MIX && WS_MIX + (size_t)MT * DM * 2 <= WS_X1 &&
              WS_X1 + (size_t)MT * DM * 4 <= WS_X1B && WS_X2 + (size_t)MT * DM * 4 <= WS_X2B && WS_UP + (size_t)MT * DFF * 2 <= WS_DN &&
              WS_DN + (size_t)2048 * 5 * 4096 * 2 <= WS_GLAST && WS_ODN + (size_t)MP * 512 * 2 <= WS_QKVN && WS_QKVN + (size_t)MT * 1536 * 4 <= WS_BG && WS_BG + (size_t)MT * 64 <= WS_WINF && WS_WINF + (size_t)MP * 1024 <= WS_END, "ws map");
constexpr int CW_WQ = 12288;
constexpr int CW_PANEL = 32768;
constexpr int CW_BAR = 4096;
static_assert((size_t)(CW_PANEL + 64 * 65) * 4 <= CTL_ZERO_BYTES, "every control word lies inside the per-call memset");

constexpr int RING_BYTES = 131072;
constexpr int MISC_OFF = 147456;
constexpr int LDS_BYTES = 147456 + 1024;

typedef unsigned short bf16;
typedef unsigned v4u __attribute__((ext_vector_type(4)));
typedef unsigned v2u __attribute__((ext_vector_type(2)));
typedef float f32x2 __attribute__((ext_vector_type(2)));
typedef float f32x4 __attribute__((ext_vector_type(4)));
typedef float f32x16 __attribute__((ext_vector_type(16)));
typedef short bf16x8 __attribute__((ext_vector_type(8)));
typedef short bf16x4 __attribute__((ext_vector_type(4)));
typedef __bf16 hbf2 __attribute__((ext_vector_type(2)));
#define LDS_WAIT() asm volatile("s_waitcnt lgkmcnt(0)" ::: "memory")
#define VM_WAIT() asm volatile("s_waitcnt vmcnt(0)" ::: "memory")
#define BAR_LDS() do { asm volatile("s_waitcnt lgkmcnt(0)" ::: "memory"); __builtin_amdgcn_s_barrier(); asm volatile("" ::: "memory"); } while (0)
__device__ __forceinline__ unsigned pk2(float lo, float hi) { return __builtin_bit_cast(unsigned, __builtin_convertvector((f32x2){lo, hi}, hbf2)); }
__device__ __forceinline__ float bflo(unsigned u) { return __uint_as_float(u << 16); }
__device__ __forceinline__ float bfhi(unsigned u) { return __uint_as_float(u & 0xffff0000u); }
__device__ __forceinline__ float bf2f(bf16 b) { return __uint_as_float((unsigned)b << 16); }
template <int CTRL, int ROWMASK = 0xF> __device__ __forceinline__ float dpp_add(float v) {
    return v + __builtin_bit_cast(float, __builtin_amdgcn_update_dpp(0, __builtin_bit_cast(int, v), CTRL, ROWMASK, 0xF, true));
}
__device__ __forceinline__ float row16_sum(float v) {
    v = dpp_add<0xB1>(v); v = dpp_add<0x4E>(v); v = dpp_add<0x124>(v); v = dpp_add<0x128>(v); return v;
}
__device__ __forceinline__ float wave_sum(float v) {
    v = row16_sum(v);
    v = dpp_add<0x142, 0xA>(v);
    v = dpp_add<0x143, 0xC>(v);
    return __builtin_bit_cast(float, __builtin_amdgcn_readlane(__builtin_bit_cast(int, v), 63));
}
__device__ __forceinline__ float fast_exp2(float x) { return __builtin_amdgcn_exp2f(x); }
__device__ __forceinline__ float fast_rcp(float x) { return __builtin_amdgcn_rcpf(x); }
__device__ __forceinline__ f32x4 ld_nt(const float* p) { return __builtin_nontemporal_load((const f32x4*)p); }
__device__ __forceinline__ void st_nt(float* p, f32x4 v) { __builtin_nontemporal_store(v, (f32x4*)p); }
#define MFMA32(a, b, c) __builtin_amdgcn_mfma_f32_32x32x16_bf16((a), (b), (c), 0, 0, 0)
#define MFMA16(a, b, c) __builtin_amdgcn_mfma_f32_16x16x32_bf16((a), (b), (c), 0, 0, 0)

struct Args { const float* in[N_IN]; float* out; unsigned char* ws; int ph_lo, ph_hi; };
struct Frame {
    LAS unsigned char* lds;
    int tid, lane, wave;
    int G, bid;
};
__device__ __forceinline__ void p0_transpose_item(const float* W, int K, int N, const float* gain, bf16* WT, LAS float* scr, int nblk, int item, int lane) {
    const int kb = item / nblk, nb = item % nblk, k0 = 64 * kb, n0 = 32 * nb;
    const int n4 = n0 + 4 * (lane & 7);
#pragma unroll
    for (int i = 0; i < 8; ++i) { const int kk = 8 * i + (lane >> 3);
        f32x4 v = (n4 < N) ? ld_nt(W + (size_t)(k0 + kk) * N + n4) : (f32x4){0.f, 0.f, 0.f, 0.f};
        if (gain) v = v * gain[k0 + kk];
        LAS float* d = scr + kk * 33 + 4 * (lane & 7); d[0] = v.x; d[1] = v.y; d[2] = v.z; d[3] = v.w; }
    LDS_WAIT(); asm volatile("" ::: "memory");
    const int c = lane & 7;
#pragma unroll
    for (int j = 0; j < 4; ++j) { const int nn = (lane >> 3) + 8 * j; const LAS float* s = scr + (8 * c) * 33 + nn;
        v4u o; o.x = pk2(s[0 * 33], s[1 * 33]); o.y = pk2(s[2 * 33], s[3 * 33]); o.z = pk2(s[4 * 33], s[5 * 33]); o.w = pk2(s[6 * 33], s[7 * 33]);
        *(GAS v4u*)(WT + (size_t)(n0 + nn) * K + k0 + 8 * c) = o; }
    LDS_WAIT(); asm volatile("" ::: "memory");
}
__device__ __forceinline__ void p0_row(const float* src, bf16* dst, float* ssq, int lane) {
    f32x4 v[4]; float s = 0.f;
#pragma unroll
    for (int j = 0; j < 4; ++j) { v[j] = src ? ld_nt(src + 4 * (lane + 64 * j)) : (f32x4){0.f, 0.f, 0.f, 0.f}; s += (v[j].x * v[j].x + v[j].y * v[j].y) + (v[j].z * v[j].z + v[j].w * v[j].w); }
    s = wave_sum(s);
    GAS v2u* o8 = (GAS v2u*)dst + lane;
#pragma unroll
    for (int j = 0; j < 4; ++j) { v2u w; w.x = pk2(v[j].x, v[j].y); w.y = pk2(v[j].z, v[j].w); o8[64 * j] = w; }
    if (lane == 0) *ssq = s;
}
__device__ __forceinline__ void p0_prologue(const Frame& F, const Args& a) {
    LAS float* scr = (LAS float*)(F.lds + F.wave * 16384);
    const int gw = F.bid * NWAVES + F.wave, NGW = F.G * NWAVES;
    unsigned char* ws = a.ws;
    constexpr int I0 = 16 * 112, I3 = 16 * 64, I7 = 64 * 4, I8 = 64 * 4;
    constexpr int NITEMS = I0 + I3 + I7 + I8;
    for (int it = gw; it < NITEMS; it += NGW) {
        int r = it;
        if (r < I0) { p0_transpose_item(a.in[I_WIN], 1024, NPROJ, a.in[I_LNMIX], (bf16*)(ws + WS_WIN_T), scr, 112, r, F.lane); continue; } r -= I0;
        if (r < I3) { p0_transpose_item(a.in[I_WMKV], 1024, 2048, a.in[I_LNMEMKV], (bf16*)(ws + WS_WMKV_T), scr, 64, r, F.lane); continue; } r -= I3;
        if (r < I7) { p0_transpose_item(a.in[I_W1], 4096, 128, nullptr, (bf16*)(ws + WS_W1_T), scr, 4, r, F.lane); continue; } r -= I7;
        p0_transpose_item(a.in[I_W1] + (size_t)4096 * 128, 4096, 128, nullptr, (bf16*)(ws + WS_W1_T) + (size_t)128 * 4096, scr, 4, r, F.lane);
    }
    {
        auto rowsrc = [&](int m) -> const float* { return (m < MP) ? a.in[I_XP] + (size_t)m * DM : (m < MP + DBATCH) ? a.in[I_XS] + (size_t)(m - MP) * DM : (m < MT) ? nullptr : a.in[I_MEMP] + (size_t)(m - MT) * DM; };
        f32x4 cur[4], nxt[4];
        int m = gw;
        if (m < MT + 1024) { const float* src = rowsrc(m);
#pragma unroll
            for (int j = 0; j < 4; ++j) cur[j] = src ? ld_nt(src + 4 * (F.lane + 64 * j)) : (f32x4){0.f, 0.f, 0.f, 0.f}; }
        for (; m < MT + 1024; m += NGW) {
            const int mn = m + NGW;
            if (mn < MT + 1024) { const float* src = rowsrc(mn);
#pragma unroll
                for (int j = 0; j < 4; ++j) nxt[j] = src ? ld_nt(src + 4 * (F.lane + 64 * j)) : (f32x4){0.f, 0.f, 0.f, 0.f}; }
            float s = 0.f;
#pragma unroll
            for (int j = 0; j < 4; ++j) s += (cur[j].x * cur[j].x + cur[j].y * cur[j].y) + (cur[j].z * cur[j].z + cur[j].w * cur[j].w);
            s = wave_sum(s);
            bf16* dst = (m < MT) ? (bf16*)(ws + WS_XB) + (size_t)m * DM : (bf16*)(ws + WS_MB) + (size_t)(m - MT) * DM;
            GAS v2u* o8 = (GAS v2u*)dst + F.lane;
#pragma unroll
            for (int j = 0; j < 4; ++j) { v2u w; w.x = pk2(cur[j].x, cur[j].y); w.y = pk2(cur[j].z, cur[j].w); o8[64 * j] = w; }
            if (F.lane == 0) { if (m < MT) ((float*)(ws + WS_SSQ0))[m] = s; else ((float*)(ws + WS_SSQM))[m - MT] = s; }
#pragma unroll
            for (int j = 0; j < 4; ++j) cur[j] = nxt[j];
        }
    }
    if (F.wave == 7) for (int it = F.bid; it < 64; it += F.G) {
        const int kr = it >> 1, kind = it & 1; const float* w1 = a.in[I_W1] + (size_t)kind * 4096 * 128; const float* pe = a.in[I_PE] + (size_t)kind * 4096;
        float s0 = 0.f, s1 = 0.f;
#pragma unroll 32
        for (int k = kr * 128; k < kr * 128 + 128; ++k) { const float p = pe[k]; s0 += p * w1[(size_t)k * 128 + F.lane]; s1 += p * w1[(size_t)k * 128 + 64 + F.lane]; }
        float* o = (float*)(ws + WS_PEB) + kr * 256 + kind * 128; o[F.lane] = s0; o[64 + F.lane] = s1;
    }
}
__device__ __forceinline__ void p1_late_transposes(const Frame& F, const Args& a, int gw, int NGW) {
    LAS float* scr = (LAS float*)(F.lds + F.wave * 16384);
    unsigned char* ws = a.ws;
    constexpr int I1 = 16 * 32, I2 = 16 * 32, I4 = 16 * 32, I5 = 16 * 128, I6 = 64 * 32;
    constexpr int NITEMS = I1 + I2 + I4 + I5 + I6;
    for (int it = gw; it < NITEMS; it += NGW) {
        int r = it;
        if (r < I1) { p0_transpose_item(a.in[I_WOUT], 1024, 1024, nullptr, (bf16*)(ws + WS_WOUT_T), scr, 32, r, F.lane); continue; } r -= I1;
        if (r < I2) { p0_transpose_item(a.in[I_WMQ], 1024, 1024, a.in[I_LNMEM], (bf16*)(ws + WS_WMQ_T), scr, 32, r, F.lane); continue; } r -= I2;
        if (r < I4) { p0_transpose_item(a.in[I_WMO], 1024, 1024, nullptr, (bf16*)(ws + WS_WMO_T), scr, 32, r, F.lane); continue; } r -= I4;
        if (r < I5) { p0_transpose_item(a.in[I_WUP], 1024, 4096, a.in[I_LNFFN], (bf16*)(ws + WS_WUP_T), scr, 128, r, F.lane); continue; } r -= I5;
        p0_transpose_item(a.in[I_WDN], 4096, 1024, nullptr, (bf16*)(ws + WS_WDN_T), scr, 32, r, F.lane);
    }
}
template <int MODE> struct Epi {
    static constexpr bool PERM = true, AFTER_DRAIN = false;
    float* out; unsigned char* ws; const float* xp; const float* xs;
    __device__ __forceinline__ static float rstd16(const float* p) {
        const f32x4 a = ((const f32x4*)p)[0], b = ((const f32x4*)p)[1], c = ((const f32x4*)p)[2], d = ((const f32x4*)p)[3];
        const float s = ((a.x + a.y) + (a.z + a.w)) + ((b.x + b.y) + (b.z + b.w)) + ((c.x + c.y) + (c.z + c.w)) + ((d.x + d.y) + (d.z + d.w));
        return rsqrtf(s * (1.f / 1024.f) + RMS_EPS);
    }
    __device__ __forceinline__ void operator()(const pg8::f32x4 (&acc)[2][2][4][2], const pg8::Unit& u, int wr, int wc, int fr, int fq) const {
        const int rbase = u.pm * 256 + wr * 64 + fr, cbase = u.pn * 256 + wc * 32 + 8 * fq;
#pragma unroll
        for (int ai = 0; ai < 2; ++ai)
#pragma unroll
            for (int m = 0; m < 4; ++m) {
                const int row = rbase + ai * 128 + m * 16;
                const bool isP = row < MP, isS = !isP && row < MP + DBATCH; const int sidx = row - MP;
                float rs = 1.f;
                if (MODE == 0) rs = rsqrtf(((const float*)(ws + WS_SSQ0))[row] * (1.f / 1024.f) + RMS_EPS);
                if (MODE == 1) rs = rsqrtf(((const float*)(ws + WS_SSQM))[row] * (1.f / 1024.f) + RMS_EPS);
                if (MODE == 3) rs = rstd16((const float*)(ws + WS_SSQ1) + (size_t)row * 16);
                if (MODE == 5) rs = rstd16((const float*)(ws + WS_SSQ2) + (size_t)row * 16);
                float ssq = 0.f;
#pragma unroll
                for (int bj = 0; bj < 2; ++bj) {
                    const int col = cbase + bj * 128;
                    f32x4 v0 = acc[ai][bj][m][0], v1 = acc[ai][bj][m][1];
                    if (MODE == 0) {
                        v0 = v0 * rs; v1 = v1 * rs;
                        if (col < C_B || (col >= C_NQ && col < C_G)) {
                            v4u w; w.x = pk2(v0.x, v0.y); w.y = pk2(v0.z, v0.w); w.z = pk2(v1.x, v1.y); w.w = pk2(v1.z, v1.w);
                            *(v4u*)((bf16*)(ws + WS_PROJ) + (size_t)row * NPROJ_PAD + col) = w; }
                        float* dst = nullptr;
                        if (col < C_Z) {
                            if (isP) { const int t = row & (SEQ - 1); if (t >= SEQ - 3) dst = out + O_PCONV + (size_t)((row >> 12) * 3 + (t - (SEQ - 3))) * 1536 + col; }
                            else if (isS) dst = out + O_SCONV + (size_t)(sidx * 3 + 2) * 1536 + col;
                        } else if (col >= C_B && col < C_NQ) { dst = (float*)(ws + WS_BA) + (size_t)row * 16 + (col - C_B); }
                        else if (col >= C_NKV && col < C_WIN) {
                            if (isP) dst = out + O_PNSA + (size_t)row * 512 + (col - C_NKV);
                            else if (isS) dst = out + O_SNSA + (size_t)sidx * 512 + (col - C_NKV);
                        } else if (col >= C_WIN && col < C_G) {
                            if (isP) { const int t = row & (SEQ - 1); if (t >= SEQ - 512) dst = out + O_PWIN + (size_t)((row >> 12) * 512 + (t - (SEQ - 512))) * 256 + (col - C_WIN); }
                            else if (isS) dst = out + O_SWIN + (size_t)(sidx * 512 + 511) * 256 + (col - C_WIN);
                        } else if (col >= C_G && col < NPROJ) { dst = (float*)(ws + WS_GL) + (size_t)row * 24 + (col - C_G); }
                        if (dst) { st_nt(dst, v0); st_nt(dst + 4, v1); }
                    } else if (MODE == 1) {
                        v0 = v0 * rs; v1 = v1 * rs;
                        float* dst = out + O_PMEM + (size_t)row * 2048 + col; st_nt(dst, v0); st_nt(dst + 4, v1);
                        v4u w; w.x = pk2(v0.x, v0.y); w.y = pk2(v0.z, v0.w); w.z = pk2(v1.x, v1.y); w.w = pk2(v1.z, v1.w);
                        *(v4u*)((bf16*)(ws + WS_MEMKV) + (size_t)row * 2048 + col) = w;
                    } else if (MODE == 2 || MODE == 4 || MODE == 6) {
                        const bf16* res = (const bf16*)(ws + (MODE == 2 ? WS_XB : MODE == 4 ? WS_X1B : WS_X2B)) + (size_t)row * DM + col;
                        const v4u rw = *(const v4u*)res;
                        v0 = v0 + (f32x4){bflo(rw.x), bfhi(rw.x), bflo(rw.y), bfhi(rw.y)}; v1 = v1 + (f32x4){bflo(rw.z), bfhi(rw.z), bflo(rw.w), bfhi(rw.w)};
                        ssq += ((v0.x * v0.x + v0.y * v0.y) + (v0.z * v0.z + v0.w * v0.w)) + ((v1.x * v1.x + v1.y * v1.y) + (v1.z * v1.z + v1.w * v1.w));
                        v4u w; w.x = pk2(v0.x, v0.y); w.y = pk2(v0.z, v0.w); w.z = pk2(v1.x, v1.y); w.w = pk2(v1.z, v1.w);
                        *(v4u*)((bf16*)(ws + (MODE == 2 ? WS_X1B : MODE == 4 ? WS_X2B : WS_YB)) + (size_t)row * DM + col) = w;
                    } else if (MODE == 3) {
                        v0 = v0 * rs; v1 = v1 * rs;
                        v4u w; w.x = pk2(v0.x, v0.y); w.y = pk2(v0.z, v0.w); w.z = pk2(v1.x, v1.y); w.w = pk2(v1.z, v1.w);
                        *(v4u*)((bf16*)(ws + WS_QM) + (size_t)row * DM + col) = w;
                    } else if (MODE == 5) {
                        v0 = v0 * rs; v1 = v1 * rs;
#pragma unroll
                        for (int e = 0; e < 4; ++e) { const float p = fmaxf(v0[e], 0.f), q = fmaxf(v1[e], 0.f); v0[e] = p * p; v1[e] = q * q; }
                        v4u w; w.x = pk2(v0.x, v0.y); w.y = pk2(v0.z, v0.w); w.z = pk2(v1.x, v1.y); w.w = pk2(v1.z, v1.w);
                        *(v4u*)((bf16*)(ws + WS_UP) + (size_t)row * DFF + col) = w;
                    }
                }
                if (MODE == 2 || MODE == 4 || MODE == 6) {
                    ssq += __shfl_xor(ssq, 16); ssq += __shfl_xor(ssq, 32);
                    if (fq == 0) ((float*)(ws + (MODE == 2 ? WS_SSQ1 : MODE == 4 ? WS_SSQ2 : WS_SSQ3)))[(size_t)row * 16 + u.pn * 4 + wc] = ssq;
                }
            }
    }
};

struct EpiFinal {
    static constexpr bool PERM = true, AFTER_DRAIN = true;
    float* out; unsigned char* ws; const float* lnf;
    __device__ __forceinline__ void fused(pg8::f32x4 (&acc)[2][2][4][2], const pg8::Unit& u, int wr, int wc, int fr, int fq, PG8_LAS unsigned char* lds, int wid, int lane) const {
        const int rbase = u.pm * 256 + wr * 64 + fr, cbase = u.pn * 256 + wc * 32 + 8 * fq;
        float* SSQ = (float*)(ws + WS_SSQ3);
#pragma unroll
        for (int ai = 0; ai < 2; ++ai)
#pragma unroll
            for (int m = 0; m < 4; ++m) {
                const int row = rbase + ai * 128 + m * 16; float ssq = 0.f;
#pragma unroll
                for (int bj = 0; bj < 2; ++bj) {
                    const v4u rw = *(const v4u*)((const bf16*)(ws + WS_X2B) + (size_t)row * DM + cbase + bj * 128);
                    f32x4& v0 = acc[ai][bj][m][0]; f32x4& v1 = acc[ai][bj][m][1];
                    v0 = v0 + (f32x4){bflo(rw.x), bfhi(rw.x), bflo(rw.y), bfhi(rw.y)}; v1 = v1 + (f32x4){bflo(rw.z), bfhi(rw.z), bflo(rw.w), bfhi(rw.w)};
                    ssq += ((v0.x * v0.x + v0.y * v0.y) + (v0.z * v0.z + v0.w * v0.w)) + ((v1.x * v1.x + v1.y * v1.y) + (v1.z * v1.z + v1.w * v1.w));
                }
                ssq += __shfl_xor(ssq, 16); ssq += __shfl_xor(ssq, 32);
                if (fq == 0) __hip_atomic_store(SSQ + (size_t)row * 16 + u.pn * 4 + wc, ssq, __ATOMIC_RELAXED, __HIP_MEMORY_SCOPE_AGENT);
            }
        asm volatile("s_waitcnt vmcnt(0)" ::: "memory");
        __syncthreads();
        unsigned* cnt = (unsigned*)(ws + WS_CTL) + CW_PANEL + 64 * u.pm;
        if (threadIdx.x == 0) {
            __hip_atomic_fetch_add(cnt, 1u, __ATOMIC_RELAXED, __HIP_MEMORY_SCOPE_AGENT);
            unsigned sp = 0;
            while (__hip_atomic_load(cnt, __ATOMIC_RELAXED, __HIP_MEMORY_SCOPE_AGENT) < 4u && ++sp < (1u << 21)) __builtin_amdgcn_s_sleep(2);
        }
        __syncthreads();
        __builtin_amdgcn_fence(__ATOMIC_ACQUIRE, "agent");
        asm volatile("s_waitcnt vmcnt(0)" ::: "memory");
#pragma unroll
        for (int ai = 0; ai < 2; ++ai)
#pragma unroll
            for (int m = 0; m < 4; ++m) {
                const int row = rbase + ai * 128 + m * 16;
                const float rs = Epi<3>::rstd16(SSQ + (size_t)row * 16);
#pragma unroll
                for (int bj = 0; bj < 2; ++bj) {
                    const int col = cbase + bj * 128;
                    const f32x4 g0 = ((const f32x4*)(lnf + col))[0], g1 = ((const f32x4*)(lnf + col))[1];
                    float* dst = out + O_YP + (size_t)row * DM + col;
                    st_nt(dst, acc[ai][bj][m][0] * rs * g0); st_nt(dst + 4, acc[ai][bj][m][1] * rs * g1);
                }
            }
    }
};
namespace sg {
template <int MODE, int NMT  > __device__ __forceinline__ void unit(const Args& a, LAS unsigned char* lds, const bf16* A, const bf16* Bt, int K, int uidx, int tid) {
    const int ct = NMT == 8 ? uidx : uidx >> 2, qr = NMT == 8 ? 0 : uidx & 3;
    unsigned char* ws = a.ws; float* out = a.out;
    asm volatile("" : "+v"(tid));
    const int lane = tid & 63, wave = __builtin_amdgcn_readfirstlane(tid >> 6), fr = lane & 15, fq = lane >> 4;
    const int kw = K >> 3;
    const bf16* ap = A + (size_t)(MP + 32 * qr + fr) * K + wave * kw + 8 * fq;
    const bf16* bp = Bt + (size_t)(16 * ct + fr) * K + wave * kw + 8 * fq;
    f32x4 acc[NMT];
#pragma unroll
    for (int i = 0; i < NMT; ++i) acc[i] = (f32x4){0.f, 0.f, 0.f, 0.f};
#pragma unroll 4
    for (int k = 0; k < kw; k += 32) {
        const bf16x8 bf = *(const GAS bf16x8*)(bp + k);
#pragma unroll
        for (int mi = 0; mi < NMT; ++mi) acc[mi] = MFMA16(*(const GAS bf16x8*)(ap + (size_t)mi * 16 * K + k), bf, acc[mi]);
    }
    LAS float* RED = (LAS float*)lds;
#pragma unroll
    for (int mi = 0; mi < NMT; ++mi)
#pragma unroll
        for (int r = 0; r < 4; ++r) RED[wave * (NMT * 256) + (16 * mi + 4 * fq + r) * 16 + fr] = acc[mi][r];
    LAS float* RS = (LAS float*)(lds + 65536 + 1024);
    if (MODE == 3 || MODE == 5) {
        constexpr int R = 16 * NMT, TPR = 512 / R, PPT = 64 / TPR;
        const int r = tid / TPR, part = tid % TPR;
        const float* p = (const float*)(ws + (MODE == 3 ? WS_SSQS1 : WS_SSQS2)) + (32 * qr + r) * 64 + part * PPT; float t = 0.f;
#pragma unroll
        for (int j = 0; j < PPT; ++j) t += p[j];
        t = dpp_add<0xB1>(t); t = dpp_add<0x4E>(t);
        if (TPR == 16) { t = dpp_add<0x124>(t); t = dpp_add<0x128>(t); }
        if (part == 0) RS[r] = rsqrtf(t * (1.f / 1024.f) + RMS_EPS);
    }
    BAR_LDS();
#pragma unroll
    for (int i = 0; i < NMT / 2; ++i) {
        const int e = tid + 512 * i, s = 32 * qr + (e >> 4), col = 16 * ct + (e & 15); const size_t row = (size_t)MP + s;
        float v = 0.f;
#pragma unroll
        for (int w = 0; w < 8; ++w) v += RED[w * (NMT * 256) + e];
        if (MODE == 0) {
            v *= rsqrtf(((const float*)(ws + WS_SSQ0))[row] * (1.f / 1024.f) + RMS_EPS);
            ((bf16*)(ws + WS_PROJ))[row * NPROJ_PAD + col] = (bf16)(pk2(v, 0.f) & 0xffffu);
            if (col < C_Z) out[O_SCONV + (size_t)(s * 3 + 2) * 1536 + col] = v;
            else if (col >= C_B && col < C_NQ) ((float*)(ws + WS_BA))[row * 16 + (col - C_B)] = v;
            else if (col >= C_NKV && col < C_WIN) out[O_SNSA + (size_t)s * 512 + (col - C_NKV)] = v;
            else if (col >= C_WIN && col < C_G) out[O_SWIN + (size_t)(s * 512 + 511) * 256 + (col - C_WIN)] = v;
            else if (col >= C_G && col < NPROJ) ((float*)(ws + WS_GL))[row * 24 + (col - C_G)] = v;
        } else if (MODE == 2 || MODE == 4 || MODE == 6) {
            if (MODE == 2) v += a.in[I_XS][(size_t)s * DM + col];
            if (MODE == 4) v += ((const float*)(ws + WS_X1))[row * DM + col];
            if (MODE == 6) v += ((const float*)(ws + WS_X2))[row * DM + col];
            float ssq = v * v;
            ssq += __shfl_xor(ssq, 1); ssq += __shfl_xor(ssq, 2); ssq += __shfl_xor(ssq, 4); ssq += __shfl_xor(ssq, 8);
            if ((e & 15) == 0) { float* sp = (float*)(ws + (MODE == 2 ? WS_SSQS1 : MODE == 4 ? WS_SSQS2 : WS_SSQS3)) + s * 64 + ct;
                if (MODE == 6) __hip_atomic_store(sp, ssq, __ATOMIC_RELAXED, __HIP_MEMORY_SCOPE_AGENT); else *sp = ssq; }
            if (MODE == 2) { ((float*)(ws + WS_X1))[row * DM + col] = v; ((bf16*)(ws + WS_X1B))[row * DM + col] = (bf16)(pk2(v, 0.f) & 0xffffu); }
            if (MODE == 4) { ((float*)(ws + WS_X2))[row * DM + col] = v; ((bf16*)(ws + WS_X2B))[row * DM + col] = (bf16)(pk2(v, 0.f) & 0xffffu); }
            if (MODE == 6) __hip_atomic_store(out + O_YS + (size_t)s * DM + col, v, __ATOMIC_RELAXED, __HIP_MEMORY_SCOPE_AGENT);
        } else {
            const float rs = RS[s - 32 * qr];
            if (MODE == 3) ((bf16*)(ws + WS_QM))[row * DM + col] = (bf16)(pk2(v * rs, 0.f) & 0xffffu);
            else { const float q = fmaxf(v * rs, 0.f); ((bf16*)(ws + WS_UP))[row * DFF + col] = (bf16)(pk2(q * q, 0.f) & 0xffffu); }
        }
    }
    if (MODE == 6) {
        asm volatile("s_waitcnt vmcnt(0)" ::: "memory");
        __syncthreads();
        LAS unsigned* flag = (LAS unsigned*)(lds + 8 * 8192);
        if (tid == 0) *flag = __hip_atomic_fetch_add((unsigned*)(ws + WS_CTL) + CW_PANEL + 64 * 64, 1u, __ATOMIC_RELAXED, __HIP_MEMORY_SCOPE_AGENT);
        __syncthreads();
        if (*flag == (NMT == 8 ? 63u : 255u)) {
            __builtin_amdgcn_fence(__ATOMIC_ACQUIRE, "agent");
            asm volatile("s_waitcnt vmcnt(0)" ::: "memory");
            for (int r = wave; r < DBATCH; r += NWAVES) {
                const float* sp = (const float*)(ws + WS_SSQS3) + r * 64;
                float t = sp[lane]; t = wave_sum(t);
                const float rs = rsqrtf(t * (1.f / 1024.f) + RMS_EPS);
                float* y = out + O_YS + (size_t)r * DM;
#pragma unroll
                for (int j = 0; j < 4; ++j) { f32x4 v = ((f32x4*)y)[lane + 64 * j]; const f32x4 gq = ((const f32x4*)a.in[I_LNF])[lane + 64 * j]; ((f32x4*)y)[lane + 64 * j] = v * rs * gq; }
            }
        }
    }
    __syncthreads();
}
}
__device__ __forceinline__ void sample_copies(const Frame& F, const Args& a) {
    const size_t gt = (size_t)F.bid * NTHREADS + F.tid, GT = (size_t)F.G * NTHREADS;
    { const f32x4* src = (const f32x4*)a.in[I_SCONV]; f32x4* dst = (f32x4*)(a.out + O_SCONV);
      constexpr size_t PER = 2 * 384;
      for (size_t i = gt; i < (size_t)DBATCH * PER; i += GT) { const size_t s = i / PER, r = i % PER; dst[s * 3 * 384 + r] = src[s * 3 * 384 + 384 + r]; } }
}
__device__ __forceinline__ void temp_fill(const Frame& F, const Args& a, size_t off, size_t n) {
    const size_t gt = (size_t)F.bid * NTHREADS + F.tid, GT = (size_t)F.G * NTHREADS;
    f32x4* dst = (f32x4*)(a.out + off);
    for (size_t i = gt; i < n / 4; i += GT) dst[i] = (f32x4){0.f, 0.f, 0.f, 0.f};
}

__device__ __forceinline__ void conv_rows(const Frame& F, const Args& a, int row0, int nrows) {
    unsigned char* ws = a.ws;
    const bf16* PROJ = (const bf16*)(ws + WS_PROJ);
    const float* cw = a.in[I_CONVW];
    const int total = nrows * 192;
    for (int it = F.tid; it < total; it += NTHREADS) {
        const int rl = it / 192, row = row0 + rl, g8 = it - rl * 192, ch0 = g8 * 8;
        const bool isP = row < MP; const int s = row - MP, t = row & (SEQ - 1);
        float x[4][8];
        if (isP) {
#pragma unroll
            for (int jj = 0; jj < 4; ++jj) { const int tt = t - 3 + jj;
                v4u w = {0u, 0u, 0u, 0u};
                if (tt >= 0) w = *(const GAS v4u*)(PROJ + (size_t)(row - 3 + jj) * NPROJ_PAD + ch0);
                x[jj][0] = bflo(w.x); x[jj][1] = bfhi(w.x); x[jj][2] = bflo(w.y); x[jj][3] = bfhi(w.y); x[jj][4] = bflo(w.z); x[jj][5] = bfhi(w.z); x[jj][6] = bflo(w.w); x[jj][7] = bfhi(w.w); }
        } else {
#pragma unroll
            for (int jj = 0; jj < 3; ++jj) { const f32x4* p = (const f32x4*)(a.in[I_SCONV] + ((size_t)s * 3 + jj) * 1536 + ch0); const f32x4 u = p[0], v = p[1];
                x[jj][0] = u.x; x[jj][1] = u.y; x[jj][2] = u.z; x[jj][3] = u.w; x[jj][4] = v.x; x[jj][5] = v.y; x[jj][6] = v.z; x[jj][7] = v.w; }
            const v4u w = *(const GAS v4u*)(PROJ + (size_t)row * NPROJ_PAD + ch0);
            x[3][0] = bflo(w.x); x[3][1] = bfhi(w.x); x[3][2] = bflo(w.y); x[3][3] = bfhi(w.y); x[3][4] = bflo(w.z); x[3][5] = bfhi(w.z); x[3][6] = bflo(w.w); x[3][7] = bfhi(w.w);
        }
        float c[8];
#pragma unroll
        for (int e = 0; e < 8; ++e) c[e] = 0.f;
#pragma unroll
        for (int jj = 0; jj < 4; ++jj) { const f32x4* wp = (const f32x4*)(cw + jj * 1536 + ch0); const f32x4 u = wp[0], v = wp[1];
            const float wv[8] = {u.x, u.y, u.z, u.w, v.x, v.y, v.z, v.w};
#pragma unroll
            for (int e = 0; e < 8; ++e) c[e] += wv[e] * x[jj][e]; }
        float ss = 0.f;
#pragma unroll
        for (int e = 0; e < 8; ++e) { c[e] = c[e] / (1.f + __expf(-c[e])); ss += c[e] * c[e]; }
        ss += __shfl_xor(ss, 1); ss += __shfl_xor(ss, 2); ss += __shfl_xor(ss, 4);
        if (g8 < 128) { const float sc = rsqrtf(ss + 1e-6f) * (g8 < 64 ? 0.125f : 1.f);
#pragma unroll
            for (int e = 0; e < 8; ++e) c[e] *= sc; }
        v4u o; o.x = pk2(c[0], c[1]); o.y = pk2(c[2], c[3]); o.z = pk2(c[4], c[5]); o.w = pk2(c[6], c[7]);
        *(GAS v4u*)((bf16*)(ws + WS_QKVB) + (size_t)row * 1536 + ch0) = o;
        if (!isP) { f32x4* q = (f32x4*)((float*)(ws + WS_QKVN) + (size_t)row * 1536 + ch0); q[0] = (f32x4){c[0], c[1], c[2], c[3]}; q[1] = (f32x4){c[4], c[5], c[6], c[7]}; }
        if (g8 < 8) {
            const float* BA = (const float*)(ws + WS_BA) + (size_t)row * 16;
            const float beta = 1.f / (1.f + expf(-BA[g8])); const float xx = BA[8 + g8] + a.in[I_DTB][g8];
            const float sp = xx > 20.f ? xx : log1pf(expf(xx));
            float* BG = (float*)(ws + WS_BG) + (size_t)row * 16;
            BG[g8] = beta; BG[8 + g8] = -expf(a.in[I_ALOG][g8]) * sp;
        }
    }
}

__device__ __forceinline__ void vt_phase(const Frame& F, const Args& a) {
    unsigned char* ws = a.ws;
    const bf16* PROJ = (const bf16*)(ws + WS_PROJ); bf16* VTG = (bf16*)(ws + WS_VTG);
    LAS unsigned char* T = F.lds + F.wave * 16384;
    const int lane = F.lane;
    if (F.bid >= F.G - 16) return;
    for (int u = F.bid * NWAVES + F.wave; u < NB * 2 * 2 * 64; u += (F.G - 16) * NWAVES) {
        const int blk = u & 63, g = (u >> 6) & 1, which = (u >> 7) & 1, b = u >> 8;
        const int col = which ? C_WIN + (2 + g) * 64 : C_NKV + (6 + g) * 64;
#pragma unroll
        for (int i = 0; i < 8; ++i) { const int pc = i * 64 + lane, tok = pc >> 3, ch = pc & 7;
            const v4u w = *(const GAS v4u*)(PROJ + (size_t)(b * SEQ + blk * 64 + tok) * NPROJ_PAD + col + ch * 8);
            const unsigned ww[4] = {w.x, w.y, w.z, w.w};
#pragma unroll
            for (int e = 0; e < 4; ++e) { *(LAS bf16*)(T + (8 * ch + 2 * e) * 144 + tok * 2) = (bf16)(ww[e] & 0xffffu); *(LAS bf16*)(T + (8 * ch + 2 * e + 1) * 144 + tok * 2) = (bf16)(ww[e] >> 16); } }
        LDS_WAIT(); asm volatile("" ::: "memory");
        bf16* dst = VTG + ((size_t)((b * 2 + which) * 2 + g) * 64) * SEQ + blk * 64;
#pragma unroll
        for (int i = 0; i < 8; ++i) { const int pc = i * 64 + lane, d = pc >> 3, ch = pc & 7;
            *(GAS v4u*)(dst + (size_t)d * SEQ + ch * 8) = *(const LAS v4u*)(T + d * 144 + ch * 16); }
        LDS_WAIT(); asm volatile("" ::: "memory");
    }
}

__device__ __forceinline__ void conv_chunk(const Frame& F, const Args& a, int row0) {
    unsigned char* ws = a.ws;
    const bf16* PROJ = (const bf16*)(ws + WS_PROJ);
    const float* cw = a.in[I_CONVW];
#pragma unroll 1
    for (int j0 = 0; j0 < 24; j0 += 4) {
        v4u raw[4][4];
#pragma unroll
        for (int u = 0; u < 4; ++u) { const int it = F.tid + NTHREADS * (j0 + u), rl = it / 192, row = row0 + rl, ch0 = (it - rl * 192) * 8, t = row & (SEQ - 1);
#pragma unroll
            for (int jj = 0; jj < 4; ++jj) { raw[u][jj] = (v4u){0u, 0u, 0u, 0u}; if (t - 3 + jj >= 0) raw[u][jj] = *(const GAS v4u*)(PROJ + (size_t)(row - 3 + jj) * NPROJ_PAD + ch0); } }
#pragma unroll
        for (int u = 0; u < 4; ++u) { const int it = F.tid + NTHREADS * (j0 + u), rl = it / 192, row = row0 + rl, g8 = it - rl * 192, ch0 = g8 * 8;
            float c[8];
#pragma unroll
            for (int e = 0; e < 8; ++e) c[e] = 0.f;
#pragma unroll
            for (int jj = 0; jj < 4; ++jj) { const f32x4* wp = (const f32x4*)(cw + jj * 1536 + ch0); const f32x4 wu = wp[0], wv = wp[1]; const v4u w = raw[u][jj];
                c[0] += wu.x * bflo(w.x); c[1] += wu.y * bfhi(w.x); c[2] += wu.z * bflo(w.y); c[3] += wu.w * bfhi(w.y);
                c[4] += wv.x * bflo(w.z); c[5] += wv.y * bfhi(w.z); c[6] += wv.z * bflo(w.w); c[7] += wv.w * bfhi(w.w); }
            float ss = 0.f;
#pragma unroll
            for (int e = 0; e < 8; ++e) { c[e] = c[e] / (1.f + __expf(-c[e])); ss += c[e] * c[e]; }
            ss = dpp_add<0xB1>(ss); ss = dpp_add<0x4E>(ss); ss += __shfl_xor(ss, 4);
            if (g8 < 128) { const float sc = rsqrtf(ss + 1e-6f) * (g8 < 64 ? 0.125f : 1.f);
#pragma unroll
                for (int e = 0; e < 8; ++e) c[e] *= sc; }
            v4u o; o.x = pk2(c[0], c[1]); o.y = pk2(c[2], c[3]); o.z = pk2(c[4], c[5]); o.w = pk2(c[6], c[7]);
            *(GAS v4u*)((bf16*)(ws + WS_QKVB) + (size_t)row * 1536 + ch0) = o;
            if (g8 < 8) {
                const float* BA = (const float*)(ws + WS_BA) + (size_t)row * 16;
                const float beta = 1.f / (1.f + expf(-BA[g8])); const float xx = BA[8 + g8] + a.in[I_DTB][g8];
                const float sp = xx > 20.f ? xx : log1pf(expf(xx));
                float* BG = (float*)(ws + WS_BG) + (size_t)row * 16;
                BG[g8] = beta; BG[8 + g8] = -expf(a.in[I_ALOG][g8]) * sp;
            }
        }
    }
}

__device__ __forceinline__ void memvt_phase(const Frame& F, const Args& a) {
    unsigned char* ws = a.ws;
    const bf16* KV = (const bf16*)(ws + WS_MEMKV); bf16* MVT = (bf16*)(ws + WS_MVT);
    LAS unsigned char* T = F.lds + F.wave * 16384;
    const int lane = F.lane;
    for (int u = F.bid * NWAVES + F.wave; u < NB * 4 * 16; u += F.G * NWAVES) {
        const int mb = u & 3, db = (u >> 2) & 3, head = (u >> 4) & 3, b = u >> 6;
#pragma unroll
        for (int i = 0; i < 8; ++i) { const int pc = i * 64 + lane, m = pc >> 3, ch = pc & 7;
            const v4u w = *(const GAS v4u*)(KV + (size_t)(b * MEMLEN + mb * 64 + m) * 2048 + 1024 + head * 256 + db * 64 + ch * 8);
            const unsigned ww[4] = {w.x, w.y, w.z, w.w};
#pragma unroll
            for (int e = 0; e < 4; ++e) { *(LAS bf16*)(T + (8 * ch + 2 * e) * 144 + m * 2) = (bf16)(ww[e] & 0xffffu); *(LAS bf16*)(T + (8 * ch + 2 * e + 1) * 144 + m * 2) = (bf16)(ww[e] >> 16); } }
        LDS_WAIT(); asm volatile("" ::: "memory");
        bf16* dst = MVT + ((size_t)(b * 4 + head) * 256 + db * 64) * 256 + mb * 64;
#pragma unroll
        for (int i = 0; i < 8; ++i) { const int pc = i * 64 + lane, d = pc >> 3, ch = pc & 7;
            *(GAS v4u*)(dst + (size_t)d * 256 + ch * 8) = *(const LAS v4u*)(T + d * 144 + ch * 16); }
        LDS_WAIT(); asm volatile("" ::: "memory");
    }
}
__device__ __forceinline__ float rdl(float v, int l) { return __builtin_bit_cast(float, __builtin_amdgcn_readlane(__builtin_bit_cast(int, v), l)); }
__device__ __forceinline__ float wave_max(float v) {
#pragma unroll
    for (int o = 1; o < 64; o <<= 1) v = fmaxf(v, __shfl_xor(v, o));
    return v;
}
__device__ __forceinline__ float sigmoidf_(float x) { return 1.f / (1.f + expf(-x)); }

__device__ __forceinline__ void nv_conv_row(const Args& a, int row, int lane) {
    unsigned char* ws = a.ws;
    const bf16* PROJ = (const bf16*)(ws + WS_PROJ);
    const bool isP = row < MP; const int s = row - MP, t = row & (SEQ - 1);
    const float* cw = a.in[I_CONVW];
    float* outp = (float*)(ws + WS_QKVN) + (size_t)row * 1536;
    for (int j = 0; j < 24; ++j) {
        const int ch = j * 64 + lane;
        float acc = 0.f;
#pragma unroll
        for (int jj = 0; jj < 4; ++jj) {
            float x;
            if (isP) { const int tt = t - 3 + jj; x = (tt >= 0) ? bf2f(PROJ[(size_t)(row - 3 + jj) * NPROJ_PAD + ch]) : 0.f; }
            else { x = (jj < 3) ? a.in[I_SCONV][((size_t)s * 3 + jj) * 1536 + ch] : bf2f(PROJ[(size_t)row * NPROJ_PAD + ch]); }
            acc += cw[jj * 1536 + ch] * x;
        }
        float c = acc / (1.f + expf(-acc));
        if (j < 16) { const float ss = wave_sum(c * c); c *= rsqrtf(ss + 1e-6f); if (j < 8) c *= 0.125f; }
        outp[ch] = c;
        ((bf16*)(ws + WS_QKVB))[(size_t)row * 1536 + ch] = (bf16)(pk2(c, 0.f) & 0xffffu);
    }
    if (lane < 8) {
        const float* BA = (const float*)(ws + WS_BA) + (size_t)row * 16;
        const float beta = sigmoidf_(BA[lane]); const float x = BA[8 + lane] + a.in[I_DTB][lane];
        const float sp = x > 20.f ? x : log1pf(expf(x));
        float* BG = (float*)(ws + WS_BG) + (size_t)row * 16;
        BG[lane] = beta; BG[8 + lane] = -expf(a.in[I_ALOG][lane]) * sp;
    }
}

__device__ __forceinline__ void nv_dn_seq(const Args& a, int seq, int h, int lane) {
    unsigned char* ws = a.ws;
    const bool isP = seq < NB; const int s = seq - NB;
    const int row0 = isP ? seq * SEQ : MP + s, nsteps = isP ? SEQ : 1;
    float S[64];
#pragma unroll
    for (int k = 0; k < 64; ++k) S[k] = isP ? 0.f : __builtin_nontemporal_load(a.in[I_SREC] + ((size_t)(s * 8 + h) * 64 + k) * 64 + lane);
    const float gain = a.in[I_DNNORM][lane];
    for (int st = 0; st < nsteps; ++st) {
        const int row = row0 + st;
        const float* qkv = (const float*)(ws + WS_QKVN) + (size_t)row * 1536 + h * 64 + lane;
        const float qv = qkv[0], kv = qkv[512], vv = qkv[1024];
        const float* BG = (const float*)(ws + WS_BG) + (size_t)row * 16;
        const float beta = BG[h], ag = expf(BG[8 + h]);
        const float z = bf2f(((const bf16*)(ws + WS_PROJ))[(size_t)row * NPROJ_PAD + C_Z + h * 64 + lane]);
        float kS = 0.f;
#pragma unroll
        for (int k = 0; k < 64; ++k) kS += rdl(kv, k) * S[k];
        const float vn = beta * (vv - ag * kS);
        float o = 0.f;
#pragma unroll
        for (int k = 0; k < 64; ++k) { S[k] = ag * S[k] + rdl(kv, k) * vn; o += rdl(qv, k) * S[k]; }
        const float ss = wave_sum(o * o);
        const float y = o * rsqrtf(ss * (1.f / 64.f) + RMS_EPS) * gain * (z / (1.f + expf(-z)));
        ((bf16*)(ws + WS_MIX))[(size_t)row * DM + h * 64 + lane] = (bf16)(pk2(y, 0.f) & 0xffffu);
    }
    float* dst = isP ? a.out + O_PREC + (size_t)(seq * 8 + h) * 4096 : a.out + O_SREC + (size_t)(s * 8 + h) * 4096;
#pragma unroll
    for (int k = 0; k < 64; ++k) __builtin_nontemporal_store(S[k], dst + k * 64 + lane);
}

__device__ __forceinline__ void nv_compress(const Args& a, int item, int lane) {
    unsigned char* ws = a.ws;
    int kind, idx, n, g; bool isP;
    if (item < 1024) { isP = true; kind = item >> 9; const int r = item & 511; idx = r >> 7; n = (r >> 1) & 63; g = r & 1; }
    else { isP = false; const int it = item - 1024; kind = it >> 13; const int r = it & 8191; idx = r >> 6; n = (r >> 1) & 31; g = r & 1; }
    const float* w1 = a.in[I_W1] + (size_t)kind * 4096 * 128; const float* pe = a.in[I_PE] + (size_t)kind * 4096;
    const int* pt = (const int*)a.in[I_PT];
    float h0 = 0.f, h1 = 0.f;
    for (int c = 0; c < 64; ++c) {
        const float* kvrow;
        if (isP) kvrow = a.out + O_PNSA + ((size_t)(idx * SEQ + n * 64 + c) * 512 + (kind * 2 + g) * 64);
        else { const int page = pt[idx * NPAGES + (n >> 1)]; kvrow = a.in[I_CNSA] + (((size_t)page * PAGE + (n & 1) * 64 + c) * 512 + (kind * 2 + g) * 64); }
        const float x = kvrow[lane] + pe[c * 64 + lane];
        const float* wr = w1 + (size_t)c * 64 * 128 + lane;
#pragma unroll 16
        for (int d = 0; d < 64; ++d) { const float xd = __shfl(x, d); h0 += xd * wr[d * 128]; h1 += xd * wr[d * 128 + 64]; }
    }
    h0 = fmaxf(h0 + a.in[I_B1][kind * 128 + lane], 0.f); h1 = fmaxf(h1 + a.in[I_B1][kind * 128 + 64 + lane], 0.f);
    const float* w2 = a.in[I_W2] + (size_t)kind * 128 * 64 + lane;
    float o = 0.f;
#pragma unroll 16
    for (int hd = 0; hd < 64; ++hd) { o += __shfl(h0, hd) * w2[hd * 64]; o += __shfl(h1, hd) * w2[(64 + hd) * 64]; }
    float* dst = isP ? (float*)(ws + WS_KCMP_P) + (size_t)kind * (NB * 64 * 2 * 64) + ((size_t)(idx * 64 + n) * 2 + g) * 64
                     : (float*)(ws + WS_KCMP_S) + (size_t)kind * (DBATCH * 32 * 2 * 64) + ((size_t)(idx * 32 + n) * 2 + g) * 64;
    dst[lane] = o;
}

__device__ __forceinline__ void nv_attend(LAS float* scr, const float* kf, bool ok, const float* vf, size_t vstride, int nkeys, int lane,
                                          f32x4& m, f32x4& l, f32x4& O) {
    f32x4 sc = {0.f, 0.f, 0.f, 0.f};
#pragma unroll 8
    for (int d = 0; d < 64; ++d) sc += *(const LAS f32x4*)(scr + 4 * d) * kf[d];
    f32x4 pr;
#pragma unroll
    for (int r = 0; r < 4; ++r) {
        const float s = ok ? sc[r] * 0.125f : -1e30f; const float mx = wave_max(s), mn = fmaxf(m[r], mx), alpha = expf(m[r] - mn);
        const float e = ok ? expf(s - mn) : 0.f; l[r] = l[r] * alpha + wave_sum(e); O[r] *= alpha; m[r] = mn; pr[r] = e;
    }
    *(LAS f32x4*)(scr + 256 + 4 * lane) = pr;
    LDS_WAIT(); asm volatile("" ::: "memory");
#pragma unroll 4
    for (int key = 0; key < nkeys; ++key) {
        O += *(const LAS f32x4*)(scr + 256 + 4 * key) * vf[(size_t)key * vstride + lane];
    }
    LDS_WAIT(); asm volatile("" ::: "memory");
}

__device__ __forceinline__ void nv_nsa_token(const Args& a, LAS float* scr, bool isP, int idx, int g, int t, int row, int lane, bf16* MIXp) {
    unsigned char* ws = a.ws;
    const bf16* PROJ = (const bf16*)(ws + WS_PROJ);
    const int* pt = (const int*)a.in[I_PT];
    {   f32x4 q4;
#pragma unroll
        for (int r = 0; r < 4; ++r) q4[r] = bf2f(PROJ[(size_t)row * NPROJ_PAD + C_NQ + (g * 4 + r) * 64 + lane]);
        *(LAS f32x4*)(scr + 4 * lane) = q4; LDS_WAIT(); asm volatile("" ::: "memory"); }
    const int ncmp = isP ? 64 : 32, nvis = isP ? (t + 1) / 64 : 32;
    const float* kcb = isP ? (const float*)(ws + WS_KCMP_P) + ((size_t)idx * 64 * 2 + g) * 64 : (const float*)(ws + WS_KCMP_S) + ((size_t)idx * 32 * 2 + g) * 64;
    const float* vcb = kcb + (isP ? (size_t)NB * 64 * 2 * 64 : (size_t)DBATCH * 32 * 2 * 64);
    const bool vis = lane < nvis;
    f32x4 p; float imp = 0.f;
    {
        const float* kc = kcb + (size_t)(lane < ncmp ? lane : 0) * 128;
        f32x4 sc = {0.f, 0.f, 0.f, 0.f};
#pragma unroll 8
        for (int d = 0; d < 64; ++d) sc += *(const LAS f32x4*)(scr + 4 * d) * kc[d];
#pragma unroll
        for (int r = 0; r < 4; ++r) { const float s = vis ? sc[r] * 0.125f : -1e30f; const float mx = wave_max(s); const float e = vis ? expf(s - mx) : 0.f;
            const float sum = wave_sum(e); p[r] = e / fmaxf(sum, 1e-30f); imp += p[r]; }
    }
    f32x4 oc = {0.f, 0.f, 0.f, 0.f};
    *(LAS f32x4*)(scr + 256 + 4 * lane) = p; LDS_WAIT(); asm volatile("" ::: "memory");
    for (int n = 0; n < nvis; ++n) oc += *(const LAS f32x4*)(scr + 256 + 4 * n) * vcb[(size_t)n * 128 + lane];
    LDS_WAIT(); asm volatile("" ::: "memory");
    const int cur = t / 64, nsel = isP ? 64 : 33;
    const bool inarr = lane < nsel, valid = inarr && lane <= cur, forced = valid && (lane == 0 || cur - lane < 2);
    const float score = !inarr ? -2.f : (valid ? imp + (forced ? 1000.f : 0.f) : -1.f);
    int rank = 0;
    for (int j = 0; j < 64; ++j) { const float sj = __shfl(score, j); rank += (sj > score || (sj == score && j < lane)) ? 1 : 0; }
    const unsigned long long selmask = __ballot(valid && rank < 16);
    f32x4 ob[2];
#pragma unroll 1
    for (int br = 0; br < 2; ++br) {
        f32x4 m = {-1e30f, -1e30f, -1e30f, -1e30f}, l = {0.f, 0.f, 0.f, 0.f}, O = {0.f, 0.f, 0.f, 0.f};
        const int nblk = br == 0 ? cur + 1 : (isP ? 8 : 9);
#pragma unroll 1
        for (int j = 0; j < nblk; ++j) {
            const float* kf = nullptr; const float* vf = nullptr; size_t vstride = 0; int nkeys = 0; bool ok = false;
            if (br == 0) {
                if (!((selmask >> j) & 1ull)) continue;
                const int kpos = 64 * j + lane; ok = kpos <= t; const int kc = ok ? kpos : t;
                nkeys = (t - 64 * j + 1) < 64 ? (t - 64 * j + 1) : 64; vstride = 512;
                if (isP) { kf = a.out + O_PNSA + ((size_t)(idx * SEQ + kc) * 512 + (4 + g) * 64); vf = a.out + O_PNSA + ((size_t)(idx * SEQ + 64 * j) * 512 + (6 + g) * 64); }
                else if (j < 32) { const int page = pt[idx * NPAGES + (j >> 1)]; const float* base = a.in[I_CNSA] + ((size_t)page * PAGE + (j & 1) * 64) * 512;
                    kf = base + (size_t)lane * 512 + (4 + g) * 64; vf = base + (6 + g) * 64; }
                else { const float* base = a.out + O_SNSA + (size_t)idx * 512; kf = base + (4 + g) * 64; vf = base + (6 + g) * 64; nkeys = 1; }
            } else if (isP) {
                const int k0 = t - 511 + 64 * j;
                if (k0 + 63 < 0) continue;
                const int kb = k0 < 0 ? 0 : k0;
                nkeys = k0 < 0 ? k0 + 64 : 64; ok = lane < nkeys; const int kc = ok ? kb + lane : kb;
                const float* WF = (const float*)(ws + WS_WINF);
                kf = WF + (size_t)(idx * SEQ + kc) * 256 + g * 64; vf = WF + (size_t)(idx * SEQ + kb) * 256 + (2 + g) * 64; vstride = 256;
            } else {
                vstride = 256;
                if (j < 8) { const int c0 = 1 + 64 * j; nkeys = j < 7 ? 64 : 63; ok = lane < nkeys; const int ci = ok ? c0 + lane : c0;
                    kf = a.in[I_CWIN] + ((size_t)idx * 512 + ci) * 256 + g * 64; vf = a.in[I_CWIN] + ((size_t)idx * 512 + c0) * 256 + (2 + g) * 64; }
                else { const float* nb_ = a.out + O_SWIN + ((size_t)idx * 512 + 511) * 256; kf = nb_ + g * 64; vf = nb_ + (2 + g) * 64; nkeys = 1; ok = lane == 0; }
            }
            nv_attend(scr, kf, ok, vf, vstride, nkeys, lane, m, l, O);
        }
#pragma unroll
        for (int r = 0; r < 4; ++r) O[r] = O[r] / fmaxf(l[r], 1e-30f);
        ob[br] = O;
    }
    const float* GL = (const float*)(ws + WS_GL) + (size_t)row * 24;
#pragma unroll
    for (int r = 0; r < 4; ++r) {
        const float gc = sigmoidf_(GL[(g * 4 + r) * 3 + 0]), gs = sigmoidf_(GL[(g * 4 + r) * 3 + 1]), gw = sigmoidf_(GL[(g * 4 + r) * 3 + 2]);
        const float y = gc * oc[r] + gs * ob[0][r] + gw * ob[1][r];
        MIXp[(size_t)row * DM + 512 + (g * 4 + r) * 64 + lane] = (bf16)(pk2(y, 0.f) & 0xffffu);
    }
}

__device__ __forceinline__ void nv_mem_attn(const Args& a, LAS float* scr, int row, int head, int lane) {
    unsigned char* ws = a.ws;
    const bool isP = row < MP; const int s = row - MP, b = row >> 12;
    const bf16* qm = (const bf16*)(ws + WS_QM) + (size_t)row * DM + head * 256;
#pragma unroll
    for (int j = 0; j < 4; ++j) scr[lane + 64 * j] = bf2f(qm[lane + 64 * j]);
    LDS_WAIT(); asm volatile("" ::: "memory");
    float sc[4];
#pragma unroll
    for (int j = 0; j < 4; ++j) {
        const int mkey = lane + 64 * j; float acc = 0.f;
        if (isP) { const bf16* kr = (const bf16*)(ws + WS_MEMKV) + (size_t)(b * MEMLEN + mkey) * 2048 + head * 256;
            for (int d = 0; d < 256; ++d) acc += scr[d] * bf2f(kr[d]); }
        else { const float* kr = a.in[I_CMEM] + ((size_t)(s * MEMLEN + mkey) * 2 + 0) * 1024 + head * 256;
            for (int d = 0; d < 256; ++d) acc += scr[d] * kr[d]; }
        sc[j] = acc * 0.0625f;
    }
    float mx = fmaxf(fmaxf(sc[0], sc[1]), fmaxf(sc[2], sc[3])); mx = wave_max(mx);
    float sum = 0.f;
#pragma unroll
    for (int j = 0; j < 4; ++j) { sc[j] = expf(sc[j] - mx); sum += sc[j]; }
    sum = wave_sum(sum); const float inv = 1.f / sum;
    LDS_WAIT(); asm volatile("" ::: "memory");
#pragma unroll
    for (int j = 0; j < 4; ++j) scr[256 + lane + 64 * j] = sc[j] * inv;
    LDS_WAIT(); asm volatile("" ::: "memory");
    float o[4] = {0.f, 0.f, 0.f, 0.f};
    for (int mkey = 0; mkey < MEMLEN; ++mkey) {
        const float pm = scr[256 + mkey];
        if (isP) { const bf16* vr = (const bf16*)(ws + WS_MEMKV) + (size_t)(b * MEMLEN + mkey) * 2048 + 1024 + head * 256;
#pragma unroll
            for (int j = 0; j < 4; ++j) o[j] += pm * bf2f(vr[lane + 64 * j]); }
        else { const float* vr = a.in[I_CMEM] + ((size_t)(s * MEMLEN + mkey) * 2 + 1) * 1024 + head * 256;
#pragma unroll
            for (int j = 0; j < 4; ++j) o[j] += pm * vr[lane + 64 * j]; }
    }
    bf16* om = (bf16*)(ws + WS_OM) + (size_t)row * DM + head * 256;
#pragma unroll
    for (int j = 0; j < 4; ++j) om[lane + 64 * j] = (bf16)(pk2(o[j], 0.f) & 0xffffu);
    LDS_WAIT(); asm volatile("" ::: "memory");
}

__device__ __forceinline__ void final_norm_row(const Args& a, int row, int lane) {
    float s = 0.f;
    if (row < MP) { const float* sp = (const float*)(a.ws + WS_SSQ3) + (size_t)row * 16;
#pragma unroll
        for (int i = 0; i < 16; ++i) s += sp[i]; }
    else { const float* sp = (const float*)(a.ws + WS_SSQS3) + (size_t)(row - MP) * 64;
#pragma unroll 16
        for (int i = 0; i < 64; ++i) s += sp[i]; }
    const float rs = rsqrtf(s * (1.f / 1024.f) + RMS_EPS);
    if (row < MP) {
        float* y = a.out + O_YP + (size_t)row * DM; const v2u* yb = (const v2u*)((const bf16*)(a.ws + WS_YB) + (size_t)row * DM);
#pragma unroll
        for (int j = 0; j < 4; ++j) { const v2u w = yb[lane + 64 * j]; const f32x4 gq = ((const f32x4*)a.in[I_LNF])[lane + 64 * j];
            ((f32x4*)y)[lane + 64 * j] = (f32x4){bflo(w.x), bfhi(w.x), bflo(w.y), bfhi(w.y)} * rs * gq; }
    } else {
        float* y = a.out + O_YS + (size_t)(row - MP) * DM;
#pragma unroll
        for (int j = 0; j < 4; ++j) { f32x4 v = ((f32x4*)y)[lane + 64 * j]; const f32x4 gq = ((const f32x4*)a.in[I_LNF])[lane + 64 * j]; ((f32x4*)y)[lane + 64 * j] = v * rs * gq; }
    }
}

__device__ __forceinline__ void sample_dn_wave(const Args& a, int s, int h, int lane) {
    unsigned char* ws = a.ws;
    const size_t row = (size_t)MP + s;
    const bf16* PROJ = (const bf16*)(ws + WS_PROJ);
    const float* cw = a.in[I_CONVW];
    float c3[3];
#pragma unroll
    for (int which = 0; which < 3; ++which) {
        const int ch = which * 512 + h * 64 + lane;
        float acc = cw[3 * 1536 + ch] * bf2f(PROJ[row * NPROJ_PAD + ch]);
#pragma unroll
        for (int jj = 0; jj < 3; ++jj) acc += cw[jj * 1536 + ch] * a.in[I_SCONV][((size_t)s * 3 + jj) * 1536 + ch];
        float c = acc / (1.f + expf(-acc));
        if (which < 2) { const float ss = wave_sum(c * c); c *= rsqrtf(ss + 1e-6f) * (which == 0 ? 0.125f : 1.f); }
        c3[which] = c;
    }
    const float qv = c3[0], kv = c3[1], vv = c3[2];
    const float* BA = (const float*)(ws + WS_BA) + row * 16;
    const float beta = 1.f / (1.f + expf(-BA[h])); const float xx = BA[8 + h] + a.in[I_DTB][h];
    const float ag = expf(-expf(a.in[I_ALOG][h]) * (xx > 20.f ? xx : log1pf(expf(xx))));
    float S[64];
#pragma unroll
    for (int k = 0; k < 64; ++k) S[k] = __builtin_nontemporal_load(a.in[I_SREC] + ((size_t)(s * 8 + h) * 64 + k) * 64 + lane);
    const float z = bf2f(PROJ[row * NPROJ_PAD + C_Z + h * 64 + lane]);
    float kS = 0.f;
#pragma unroll
    for (int k = 0; k < 64; ++k) kS += rdl(kv, k) * S[k];
    const float vn = beta * (vv - ag * kS);
    float o = 0.f;
#pragma unroll
    for (int k = 0; k < 64; ++k) { S[k] = ag * S[k] + rdl(kv, k) * vn; o += rdl(qv, k) * S[k]; }
    const float ss = wave_sum(o * o);
    const float y = o * rsqrtf(ss * (1.f / 64.f) + RMS_EPS) * a.in[I_DNNORM][lane] * (z / (1.f + expf(-z)));
    ((bf16*)(ws + WS_MIX))[row * DM + h * 64 + lane] = (bf16)(pk2(y, 0.f) & 0xffffu);
    float* dst = a.out + O_SREC + (size_t)(s * 8 + h) * 4096;
#pragma unroll
    for (int k = 0; k < 64; ++k) __builtin_nontemporal_store(S[k], dst + k * 64 + lane);
}
namespace nsa {
constexpr int TS = 144;
constexpr int L_KT = 0, L_VT = 2 * 64 * TS, L_IMP = 4 * 64 * TS, IMP_STRIDE = 65, L_SEL = L_IMP + 4 * 64 * IMP_STRIDE * 4, L_END = L_SEL + 64 * 8;
static_assert(L_END <= RING_BYTES, "nsa lds");
constexpr float CEXP = 0.125f * 1.44269504088896f;
struct State { float m, l; f32x16 o0, o1; };
__device__ __forceinline__ int crow(int reg, int h) { return (reg & 3) + 8 * (reg >> 2) + 4 * h; }
__device__ __forceinline__ void st_init(State& s) { s.m = -1e30f; s.l = 0.f;
#pragma unroll
    for (int i = 0; i < 16; ++i) { s.o0[i] = 0.f; s.o1[i] = 0.f; } }

__device__ __forceinline__ void scores64(const LAS unsigned char* Kt, const bf16x8 (&Qf)[4], int lane, f32x16& s0, f32x16& s1) {
    const int kr = lane & 31, h = lane >> 5;
#pragma unroll
    for (int i = 0; i < 16; ++i) { s0[i] = 0.f; s1[i] = 0.f; }
#pragma unroll
    for (int ks = 0; ks < 4; ++ks) {
        const bf16x8 a0 = *(const LAS bf16x8*)(Kt + kr * TS + (16 * ks + 8 * h) * 2);
        const bf16x8 a1 = *(const LAS bf16x8*)(Kt + (kr + 32) * TS + (16 * ks + 8 * h) * 2);
        s0 = MFMA32(a0, Qf[ks], s0); s1 = MFMA32(a1, Qf[ks], s1);
    }
}
__device__ __forceinline__ void mask64(f32x16& s0, f32x16& s1, unsigned long long vm, int lane) {
    const int h = lane >> 5; const unsigned lo = (unsigned)vm >> (4 * h), hi = (unsigned)(vm >> 32) >> (4 * h);
#pragma unroll
    for (int i = 0; i < 16; ++i) { const int k = (i & 3) + 8 * (i >> 2);
        s0[i] = ((lo >> k) & 1u) ? s0[i] : -1e30f; s1[i] = ((hi >> k) & 1u) ? s1[i] : -1e30f; }
}
__device__ __forceinline__ void pv64(const LAS unsigned char* Vt, const f32x16& p0, const f32x16& p1, int lane, f32x16& o0, f32x16& o1) {
    const int kr = lane & 31, h = lane >> 5;
#pragma unroll
    for (int st = 0; st < 4; ++st) {
        const f32x16& p = (st >> 1) ? p1 : p0; const int r0 = 8 * (st & 1), base = 32 * (st >> 1) + 16 * (st & 1);
        v4u pw; pw.x = pk2(p[r0 + 0], p[r0 + 1]); pw.y = pk2(p[r0 + 2], p[r0 + 3]); pw.z = pk2(p[r0 + 4], p[r0 + 5]); pw.w = pk2(p[r0 + 6], p[r0 + 7]);
        const bf16x8 pb = __builtin_bit_cast(bf16x8, pw);
#pragma unroll
        for (int dt = 0; dt < 2; ++dt) {
            const LAS unsigned char* vr = Vt + (32 * dt + kr) * TS + (base + 4 * h) * 2;
            const v2u lo = *(const LAS v2u*)vr, hi = *(const LAS v2u*)(vr + 16);
            v4u aw; aw.x = lo.x; aw.y = lo.y; aw.z = hi.x; aw.w = hi.y;
            const bf16x8 av = __builtin_bit_cast(bf16x8, aw);
            if (dt == 0) o0 = MFMA32(av, pb, o0); else o1 = MFMA32(av, pb, o1);
        }
    }
}
__device__ __forceinline__ void softmax_pv(const LAS unsigned char* Vt, f32x16 s0, f32x16 s1, unsigned long long vm, bool permask, int lane, State& st) {
    if (permask) mask64(s0, s1, vm, lane);
    const bool none = vm == 0ull;
    float mx = s0[0];
#pragma unroll
    for (int i = 1; i < 16; ++i) mx = fmaxf(mx, s0[i]);
#pragma unroll
    for (int i = 0; i < 16; ++i) mx = fmaxf(mx, s1[i]);
    mx = fmaxf(mx, __shfl_xor(mx, 32));
    const float mn = none ? st.m : fmaxf(st.m, mx), mref = (mn <= -1e30f) ? 0.f : mn;
    const float alpha = fast_exp2((st.m - mref) * CEXP);
    const float nb = none ? -1e30f : -mref * CEXP;
    float ps = 0.f;
#pragma unroll
    for (int i = 0; i < 16; ++i) { s0[i] = fast_exp2(__builtin_fmaf(s0[i], CEXP, nb)); s1[i] = fast_exp2(__builtin_fmaf(s1[i], CEXP, nb)); ps += s0[i] + s1[i]; }
    ps += __shfl_xor(ps, 32);
    st.l = st.l * alpha + ps; st.m = mn;
    st.o0 = st.o0 * alpha; st.o1 = st.o1 * alpha;
    pv64(Vt, s0, s1, lane, st.o0, st.o1);
}

struct TileRegs { v4u k, v; };
__device__ __forceinline__ void tile_load(TileRegs& t, const bf16* kb, const bf16* vt, int tid) {
    t.k = *(const GAS v4u*)(kb + (size_t)(tid >> 3) * NPROJ_PAD + (tid & 7) * 8);
    t.v = *(const GAS v4u*)(vt + (size_t)(tid >> 3) * SEQ + (tid & 7) * 8);
}
__device__ __forceinline__ void tile_load2(TileRegs& t, const bf16* kb, const bf16* vb, int kt, int vt, int tid) {
    t.k = *(const GAS v4u*)(kb + ((size_t)kt * 64 + (tid >> 3)) * NPROJ_PAD + (tid & 7) * 8);
    t.v = *(const GAS v4u*)(vb + (size_t)(tid >> 3) * SEQ + vt * 64 + (tid & 7) * 8);
}
__device__ __forceinline__ void tile_store_t(const TileRegs& t, LAS unsigned char* Kt, LAS unsigned char* Vt, int tid) {
    *(LAS v4u*)(Kt + (tid >> 3) * TS + (tid & 7) * 16) = t.k;
    *(LAS v4u*)(Vt + (tid >> 3) * TS + (tid & 7) * 16) = t.v;
}
__device__ __forceinline__ void tile_load_f32(TileRegs& t, const float* kb, const float* vb, int tid) {
    const f32x4* kp = (const f32x4*)(kb + (size_t)(tid >> 3) * 128 + (tid & 7) * 8); const f32x4 a = kp[0], b = kp[1];
    t.k.x = pk2(a.x, a.y); t.k.y = pk2(a.z, a.w); t.k.z = pk2(b.x, b.y); t.k.w = pk2(b.z, b.w);
    const f32x4* vp = (const f32x4*)(vb + (size_t)(tid & 63) * 128 + (tid >> 6) * 8); const f32x4 c = vp[0], d = vp[1];
    t.v.x = pk2(c.x, c.y); t.v.y = pk2(c.z, c.w); t.v.z = pk2(d.x, d.y); t.v.w = pk2(d.z, d.w);
}
__device__ __forceinline__ void tile_store(const TileRegs& t, LAS unsigned char* Kt, LAS unsigned char* Vt, int tid) {
    *(LAS v4u*)(Kt + (tid >> 3) * TS + (tid & 7) * 16) = t.k;
    LAS unsigned char* vp = Vt + (8 * (tid >> 6)) * TS + (tid & 63) * 2;
    const unsigned w[4] = {t.v.x, t.v.y, t.v.z, t.v.w};
#pragma unroll
    for (int e = 0; e < 4; ++e) { *(LAS bf16*)(vp + (2 * e) * TS) = (bf16)(w[e] & 0xffffu); *(LAS bf16*)(vp + (2 * e + 1) * TS) = (bf16)(w[e] >> 16); }
}

__device__ __forceinline__ void unit(const Args& a, LAS unsigned char* lds, int b, int g, int qt, bf16* dst, int tid) {
    unsigned char* ws = a.ws; asm volatile("" : "+s"(ws));
    asm volatile("" : "+v"(tid));
    const int lane = tid & 63, wave = __builtin_amdgcn_readfirstlane(tid >> 6), r = wave >> 1, hh = wave & 1, h = lane >> 5;
    const int t0 = 64 * qt, tl = 32 * hh + (lane & 31), tq = t0 + tl;
    const size_t row = (size_t)b * SEQ + tq;
    const bf16* PROJ = (const bf16*)(ws + WS_PROJ);
    bf16x8 Qf[4];
#pragma unroll
    for (int ks = 0; ks < 4; ++ks) Qf[ks] = *(const GAS bf16x8*)(PROJ + row * NPROJ_PAD + C_NQ + (g * 4 + r) * 64 + 16 * ks + 8 * h);
    const float* GL = (const float*)(ws + WS_GL) + row * 24 + (g * 4 + r) * 3;
    const float gc = 1.f / (1.f + __expf(-GL[0])), gs = 1.f / (1.f + __expf(-GL[1])), gw = 1.f / (1.f + __expf(-GL[2]));
    LAS float* IMP = (LAS float*)(lds + L_IMP);
    LAS unsigned long long* SEL = (LAS unsigned long long*)(lds + L_SEL);
    int par = 0;
    TileRegs tr;
    f32x16 acc0, acc1;
    {
        const float* kc = (const float*)(ws + WS_KCMP_P) + ((size_t)b * 64 * 2 + g) * 64;
        tile_load_f32(tr, kc, kc + (size_t)NB * 64 * 2 * 64, tid);
        tile_store(tr, lds + L_KT + par * 64 * TS, lds + L_VT + par * 64 * TS, tid);
        BAR_LDS();
        f32x16 s0, s1; scores64(lds + L_KT + par * 64 * TS, Qf, lane, s0, s1);
        const int nvis = (tq + 1) >> 6;
        const unsigned long long vm = nvis >= 64 ? ~0ull : ((1ull << nvis) - 1ull);
        mask64(s0, s1, vm, lane);
        float mx = s0[0];
#pragma unroll
        for (int i = 1; i < 16; ++i) mx = fmaxf(mx, s0[i]);
#pragma unroll
        for (int i = 0; i < 16; ++i) mx = fmaxf(mx, s1[i]);
        mx = fmaxf(mx, __shfl_xor(mx, 32));
        const float mref = (mx <= -1e30f) ? 0.f : mx;
        float ps = 0.f;
#pragma unroll
        for (int i = 0; i < 16; ++i) { s0[i] = fast_exp2((s0[i] - mref) * CEXP); s1[i] = fast_exp2((s1[i] - mref) * CEXP); ps += s0[i] + s1[i]; }
        ps += __shfl_xor(ps, 32);
        const float inv = 1.f / fmaxf(ps, 1e-30f);
        s0 = s0 * inv; s1 = s1 * inv;
        LAS float* ip = IMP + (r * 64 + tl) * IMP_STRIDE;
#pragma unroll
        for (int i = 0; i < 16; ++i) { ip[crow(i, h)] = s0[i]; ip[32 + crow(i, h)] = s1[i]; }
#pragma unroll
        for (int i = 0; i < 16; ++i) { acc0[i] = 0.f; acc1[i] = 0.f; }
        pv64(lds + L_VT + par * 64 * TS, s0, s1, lane, acc0, acc1);
        acc0 = acc0 * gc; acc1 = acc1 * gc;
        par ^= 1;
        BAR_LDS();
#pragma unroll 1
        for (int i = 0; i < 8; ++i) {
            const int tok = 8 * wave + i, t = t0 + tok, cur = qt;
            const float imp = (IMP[(0 * 64 + tok) * IMP_STRIDE + lane] + IMP[(1 * 64 + tok) * IMP_STRIDE + lane]) + (IMP[(2 * 64 + tok) * IMP_STRIDE + lane] + IMP[(3 * 64 + tok) * IMP_STRIDE + lane]);
            (void)t;
            const bool valid = lane <= cur, forced = valid && (lane == 0 || cur - lane < 2);
            const float score = valid ? imp + (forced ? 1000.f : 0.f) : -1.f;
            int rank = 0;
#pragma unroll 8
            for (int j = 0; j < 64; ++j) { const float sj = __shfl(score, j); rank += (sj > score || (sj == score && j < lane)) ? 1 : 0; }
            const unsigned long long m = __ballot(valid && rank < 16);
            if (lane == 0) SEL[tok] = m;
        }
        BAR_LDS();
    }
    const unsigned long long mysel = SEL[tl];
    LAS float* PARK = (LAS float*)(lds + L_IMP) + tid;
    BAR_LDS();
#pragma unroll
    for (int i = 0; i < 16; ++i) { PARK[(2 * i) * NTHREADS] = acc0[i]; PARK[(2 * i + 1) * NTHREADS] = acc1[i]; }
    const unsigned long long causal = (2ull << tl) - 1ull;
    TileRegs trA, trB;
#define NSA_ITER(TR, J, VMEXPR, PMEXPR) do { const int j_ = (J); \
        tile_store_t(TR, lds + L_KT + ((j_ + 1) & 1) * 64 * TS, lds + L_VT + (j_ & 1) * 64 * TS, tid); BAR_LDS(); \
        { const int kn = j_ + 3 < jl ? j_ + 3 : jl, vn = j_ + 2 < jl ? j_ + 2 : jl; tile_load2(TR, kb, vb, kn, vn, tid); } \
        f32x16 n0, n1; scores64(lds + L_KT + ((j_ + 1) & 1) * 64 * TS, Qf, lane, n0, n1); \
        if (j_ <= jl) { const unsigned long long vm = (VMEXPR); softmax_pv(lds + L_VT + (j_ & 1) * 64 * TS, c0, c1, vm, (PMEXPR), lane, st); } \
        c0 = n0; c1 = n1; } while (0)
#define NSA_BRANCH(J0, VMEXPR, PMEXPR) do { \
        BAR_LDS();                                             \
        { TileRegs t0; tile_load2(t0, kb, vb, (J0), (J0), tid); tile_store_t(t0, lds + L_KT + ((J0) & 1) * 64 * TS, lds + L_VT + (((J0) + 1) & 1) * 64 * TS, tid); } \
        { const int k1 = (J0) + 1 < jl ? (J0) + 1 : jl; tile_load2(trA, kb, vb, k1, (J0), tid); } \
        { const int k2 = (J0) + 2 < jl ? (J0) + 2 : jl, v1 = (J0) + 1 < jl ? (J0) + 1 : jl; tile_load2(trB, kb, vb, k2, v1, tid); } \
        BAR_LDS(); \
        f32x16 c0, c1; scores64(lds + L_KT + ((J0) & 1) * 64 * TS, Qf, lane, c0, c1); \
        _Pragma("unroll 1") for (int j = (J0); j <= jl; j += 2) { NSA_ITER(trA, j, VMEXPR, PMEXPR); NSA_ITER(trB, j + 1, VMEXPR, PMEXPR); } } while (0)
    {
        State st; st_init(st);
        const bf16* kb = PROJ + (size_t)b * SEQ * NPROJ_PAD + C_NKV + (4 + g) * 64; const bf16* vb = (const bf16*)(ws + WS_VTG) + ((size_t)((b * 2 + 0) * 2 + g) * 64) * SEQ;
        const int jl = qt;
        NSA_BRANCH(0, (((mysel >> j_) & 1ull) ? (j_ < qt ? ~0ull : causal) : 0ull), j_ == qt);
        const float sc = gs / fmaxf(st.l, 1e-30f);
#pragma unroll
        for (int i = 0; i < 16; ++i) { PARK[(2 * i) * NTHREADS] += st.o0[i] * sc; PARK[(2 * i + 1) * NTHREADS] += st.o1[i] * sc; }
    }
    {
        State st; st_init(st);
        const int j0 = qt >= 8 ? qt - 8 : 0, jl = qt;
        const bf16* kb = PROJ + (size_t)b * SEQ * NPROJ_PAD + C_WIN + g * 64; const bf16* vb = (const bf16*)(ws + WS_VTG) + ((size_t)((b * 2 + 1) * 2 + g) * 64) * SEQ;
        NSA_BRANCH(j0, ((j_ == qt) ? causal : (j_ == qt - 8 ? ~causal : ~0ull)), (j_ == qt || j_ == qt - 8));
        const float sc = gw / fmaxf(st.l, 1e-30f);
#pragma unroll
        for (int i = 0; i < 16; ++i) { acc0[i] = PARK[(2 * i) * NTHREADS] + st.o0[i] * sc; acc1[i] = PARK[(2 * i + 1) * NTHREADS] + st.o1[i] * sc; }
    }
#undef NSA_ITER
#undef NSA_BRANCH
    bf16* op = dst + row * DM + 512 + (g * 4 + r) * 64 + 4 * h;
#pragma unroll
    for (int i = 0; i < 4; ++i) {
        v2u w0; w0.x = pk2(acc0[4 * i], acc0[4 * i + 1]); w0.y = pk2(acc0[4 * i + 2], acc0[4 * i + 3]); *(GAS v2u*)(op + 8 * i) = w0;
        v2u w1; w1.x = pk2(acc1[4 * i], acc1[4 * i + 1]); w1.y = pk2(acc1[4 * i + 2], acc1[4 * i + 3]); *(GAS v2u*)(op + 32 + 8 * i) = w1;
    }
    __syncthreads();
}
}
namespace dn {
constexpr int RS = 144;
constexpr int OP_BYTES = 8192;
__device__ __forceinline__ bf16x8 ldfrag(const LAS unsigned char* img, int row, int kb) { return *(const LAS bf16x8*)(img + row * RS + kb * 2); }

template <int IB> __device__ __forceinline__ void trec_block(LAS unsigned char* AT, float (&Tc)[64], int lane) {
#pragma unroll
    for (int ii = 0; ii < 8; ++ii) {
        const int i = 8 * IB + ii;
        asm volatile("" ::: "memory");
        float acc4[4] = {(lane == i) ? 1.f : 0.f, 0.f, 0.f, 0.f};
#pragma unroll
        for (int mc = 0; mc <= IB; ++mc) {
            if (8 * mc < i) {
                const v4u w = *(const LAS v4u*)(AT + i * RS + mc * 16);
                const unsigned ww[4] = {w.x, w.y, w.z, w.w};
#pragma unroll
                for (int e = 0; e < 8; ++e) { const int m = 8 * mc + e; if (m < i) acc4[e & 3] -= ((e & 1) ? bfhi(ww[e >> 1]) : bflo(ww[e >> 1])) * Tc[m]; }
            }
        }
        const float acc = (acc4[0] + acc4[1]) + (acc4[2] + acc4[3]);
        Tc[i] = acc;
        *(LAS bf16*)(AT + i * RS + lane * 2) = (bf16)(pk2(acc, 0.f) & 0xffffu);
    }
}

__device__ __forceinline__ void prep_wave(const Args& a, LAS unsigned char* wlds, int b, int n, int h, int lane) {
    unsigned char* ws = a.ws; asm volatile("" : "+s"(ws));
    asm volatile("" : "+v"(lane));
    const int fr = lane & 15, fq = lane >> 4;
    const int row0 = b * SEQ + n * 64, ch = (b * 64 + n) * 8 + h;
    const bf16* PROJ = (const bf16*)(ws + WS_PROJ);
    bf16* OPS = (bf16*)(ws + WS_DN + (size_t)ch * 5 * OP_BYTES);
    LAS unsigned char* AT = wlds;
    LAS unsigned char* XT = wlds + 64 * RS;
    float beta_l, gcum_l;
    { const float* BA = (const float*)(ws + WS_BA) + (size_t)(row0 + lane) * 16;
      beta_l = 1.f / (1.f + expf(-BA[h])); const float xx = BA[8 + h] + a.in[I_DTB][h];
      gcum_l = -expf(a.in[I_ALOG][h]) * (xx > 20.f ? xx : log1pf(expf(xx))); }
#pragma unroll
    for (int o = 1; o < 64; o <<= 1) { const float t = __shfl_up(gcum_l, o); if (lane >= o) gcum_l += t; }
    const float glast = __shfl(gcum_l, 63);
    float beta_f[4], gc_f[4];
#pragma unroll
    for (int mt = 0; mt < 4; ++mt) { beta_f[mt] = __shfl(beta_l, 16 * mt + fr); gc_f[mt] = __shfl(gcum_l, 16 * mt + fr); }
    if (lane == 0) ((float*)(ws + WS_GLAST))[ch] = __expf(glast);
    LAS float* CW = (LAS float*)AT;
    { const float* cw = a.in[I_CONVW];
#pragma unroll
      for (int i = 0; i < 12; ++i) { const int e = i * 64 + lane, which = e >> 8, d = (e >> 2) & 63, tap = e & 3; CW[e] = cw[tap * 1536 + which * 512 + h * 64 + d]; } }
    LDS_WAIT(); asm volatile("" ::: "memory");
    bf16x8 Qf[4][2], Kf[4][2], Vf[4][2];
    auto issue_raw = [&](v4u (&raw)[2][4], int mt, int which) {
        const int c = 16 * mt + fr, t = n * 64 + c;
#pragma unroll
        for (int ks = 0; ks < 2; ++ks) {
            const bf16* src = PROJ + (size_t)(row0 + c - 3) * NPROJ_PAD + which * 512 + h * 64 + 32 * ks + 8 * fq;
#pragma unroll
            for (int tap = 0; tap < 4; ++tap) { raw[ks][tap] = (v4u){0u, 0u, 0u, 0u}; if (t - 3 + tap >= 0) raw[ks][tap] = *(const GAS v4u*)(src + (size_t)tap * NPROJ_PAD); }
        }
    };
    auto conv_step = [&](const v4u (&raw)[2][4], int mt, int which) {
        float cv[2][8];
#pragma unroll
        for (int ks = 0; ks < 2; ++ks)
#pragma unroll
            for (int e = 0; e < 8; ++e) {
                const f32x4 w4 = *(const LAS f32x4*)(CW + (which * 64 + 32 * ks + 8 * fq + e) * 4);
                float acc = 0.f;
#pragma unroll
                for (int tap = 0; tap < 4; ++tap) { const unsigned wd = (e >> 1) == 0 ? raw[ks][tap].x : (e >> 1) == 1 ? raw[ks][tap].y : (e >> 1) == 2 ? raw[ks][tap].z : raw[ks][tap].w;
                    acc += w4[tap] * ((e & 1) ? bfhi(wd) : bflo(wd)); }
                cv[ks][e] = acc / (1.f + __expf(-acc));
            }
        float sc = beta_f[mt];
        if (which < 2) { float sq = 0.f;
#pragma unroll
            for (int ks = 0; ks < 2; ++ks)
#pragma unroll
                for (int e = 0; e < 8; ++e) sq += cv[ks][e] * cv[ks][e];
            sq += __shfl_xor(sq, 16); sq += __shfl_xor(sq, 32);
            sc = rsqrtf(sq + 1e-6f) * (which == 0 ? 0.125f : 1.f); }
#pragma unroll
        for (int ks = 0; ks < 2; ++ks) {
            v4u w; w.x = pk2(cv[ks][0] * sc, cv[ks][1] * sc); w.y = pk2(cv[ks][2] * sc, cv[ks][3] * sc); w.z = pk2(cv[ks][4] * sc, cv[ks][5] * sc); w.w = pk2(cv[ks][6] * sc, cv[ks][7] * sc);
            if (which == 0) Qf[mt][ks] = __builtin_bit_cast(bf16x8, w); else if (which == 1) Kf[mt][ks] = __builtin_bit_cast(bf16x8, w); else Vf[mt][ks] = __builtin_bit_cast(bf16x8, w);
        }
    };
    v4u rawA[2][4], rawB[2][4];
    issue_raw(rawA, 0, 0);
#pragma unroll
    for (int s2 = 0; s2 < 12; s2 += 2) {
        asm volatile("" ::: "memory");
        issue_raw(rawB, (s2 + 1) / 3, (s2 + 1) % 3);
        conv_step(rawA, s2 / 3, s2 % 3);
        asm volatile("" ::: "memory");
        if (s2 + 2 < 12) issue_raw(rawA, (s2 + 2) / 3, (s2 + 2) % 3);
        conv_step(rawB, (s2 + 1) / 3, (s2 + 1) % 3);
    }
    LDS_WAIT(); asm volatile("" ::: "memory");
#pragma unroll
    for (int mt = 0; mt < 4; ++mt)
#pragma unroll
        for (int nt = 0; nt < 4; ++nt) {
            v2u wa = {0u, 0u}, wq = {0u, 0u};
            if (nt <= mt) {
                f32x4 kk = {0.f, 0.f, 0.f, 0.f}, qk = {0.f, 0.f, 0.f, 0.f};
#pragma unroll
                for (int ks = 0; ks < 2; ++ks) { kk = MFMA16(Kf[nt][ks], Kf[mt][ks], kk); qk = MFMA16(Kf[nt][ks], Qf[mt][ks], qk); }
                float av[4], qv[4];
#pragma unroll
                for (int r = 0; r < 4; ++r) {
                    const int cp = 16 * nt + 4 * fq + r, c = 16 * mt + fr;
                    const float gcp = __shfl(gcum_l, cp);
                    const float dec = __expf(fminf(gc_f[mt] - gcp, 0.f));
                    av[r] = (c > cp) ? beta_f[mt] * kk[r] * dec : 0.f;
                    qv[r] = (c >= cp) ? qk[r] * dec : 0.f;
                }
                wa.x = pk2(av[0], av[1]); wa.y = pk2(av[2], av[3]); wq.x = pk2(qv[0], qv[1]); wq.y = pk2(qv[2], qv[3]);
            }
            *(LAS v2u*)(AT + (16 * mt + fr) * RS + (16 * nt + 4 * fq) * 2) = wa;
            *(GAS v2u*)(OPS + 4 * 4096 + (16 * mt + fr) * 64 + 16 * nt + 4 * fq) = wq;
        }
#pragma unroll
    for (int mt = 0; mt < 4; ++mt) { const float e = __expf(gc_f[mt]);
#pragma unroll
        for (int ks = 0; ks < 2; ++ks) { const v4u w = __builtin_bit_cast(v4u, Qf[mt][ks]); v4u o;
            o.x = pk2(bflo(w.x) * e, bfhi(w.x) * e); o.y = pk2(bflo(w.y) * e, bfhi(w.y) * e); o.z = pk2(bflo(w.z) * e, bfhi(w.z) * e); o.w = pk2(bflo(w.w) * e, bfhi(w.w) * e);
            *(GAS v4u*)(OPS + 2 * 4096 + (16 * mt + fr) * 64 + 32 * ks + 8 * fq) = o; } }
    LDS_WAIT(); asm volatile("" ::: "memory");
    {
        float Tc[64];
        trec_block<0>(AT, Tc, lane); trec_block<1>(AT, Tc, lane); trec_block<2>(AT, Tc, lane); trec_block<3>(AT, Tc, lane);
        trec_block<4>(AT, Tc, lane); trec_block<5>(AT, Tc, lane); trec_block<6>(AT, Tc, lane); trec_block<7>(AT, Tc, lane);
    }
    LDS_WAIT(); asm volatile("" ::: "memory");
    bf16x8 Tf[4][2];
#pragma unroll
    for (int mt = 0; mt < 4; ++mt)
#pragma unroll
        for (int ks = 0; ks < 2; ++ks) Tf[mt][ks] = ldfrag(AT, 16 * mt + fr, 32 * ks + 8 * fq);
#pragma unroll
    for (int mt = 0; mt < 4; ++mt)
#pragma unroll
        for (int ks = 0; ks < 2; ++ks) {
            const v4u w = __builtin_bit_cast(v4u, Vf[mt][ks]);
            const unsigned ww[4] = {w.x, w.y, w.z, w.w};
#pragma unroll
            for (int e = 0; e < 4; ++e) { *(LAS bf16*)(XT + (32 * ks + 8 * fq + 2 * e) * RS + (16 * mt + fr) * 2) = (bf16)(ww[e] & 0xffffu);
                *(LAS bf16*)(XT + (32 * ks + 8 * fq + 2 * e + 1) * RS + (16 * mt + fr) * 2) = (bf16)(ww[e] >> 16); }
        }
    LDS_WAIT(); asm volatile("" ::: "memory");
#pragma unroll
    for (int mt = 0; mt < 4; ++mt)
#pragma unroll
        for (int nt = 0; nt < 4; ++nt) {
            f32x4 acc = {0.f, 0.f, 0.f, 0.f};
#pragma unroll
            for (int ks = 0; ks < 2; ++ks) acc = MFMA16(Tf[mt][ks], ldfrag(XT, 16 * nt + fr, 32 * ks + 8 * fq), acc);
            v2u o; o.x = pk2(acc[0], acc[1]); o.y = pk2(acc[2], acc[3]);
            *(GAS v2u*)(OPS + 0 * 4096 + ((mt * 4 + nt) * 64 + lane) * 4) = o;
        }
    LDS_WAIT(); asm volatile("" ::: "memory");
#pragma unroll
    for (int mt = 0; mt < 4; ++mt) { const float sc = beta_f[mt] * __expf(gc_f[mt]);
#pragma unroll
        for (int ks = 0; ks < 2; ++ks) { const v4u w = __builtin_bit_cast(v4u, Kf[mt][ks]); const unsigned ww[4] = {w.x, w.y, w.z, w.w};
#pragma unroll
            for (int e = 0; e < 8; ++e) { const float v = ((e & 1) ? bfhi(ww[e >> 1]) : bflo(ww[e >> 1])) * sc;
                *(LAS bf16*)(XT + (32 * ks + 8 * fq + e) * RS + (16 * mt + fr) * 2) = (bf16)(pk2(v, 0.f) & 0xffffu); } } }
    LDS_WAIT(); asm volatile("" ::: "memory");
#pragma unroll
    for (int mt = 0; mt < 4; ++mt)
#pragma unroll
        for (int nt = 0; nt < 4; ++nt) {
            f32x4 acc = {0.f, 0.f, 0.f, 0.f};
#pragma unroll
            for (int ks = 0; ks < 2; ++ks) acc = MFMA16(ldfrag(XT, 16 * nt + fr, 32 * ks + 8 * fq), Tf[mt][ks], acc);
            v2u o; o.x = pk2(acc[0], acc[1]); o.y = pk2(acc[2], acc[3]);
            *(GAS v2u*)(OPS + 1 * 4096 + (16 * mt + fr) * 64 + 16 * nt + 4 * fq) = o;
        }
    LDS_WAIT(); asm volatile("" ::: "memory");
#pragma unroll
    for (int mt = 0; mt < 4; ++mt) { const float sc = __expf(glast - gc_f[mt]);
#pragma unroll
        for (int ks = 0; ks < 2; ++ks) { const v4u w = __builtin_bit_cast(v4u, Kf[mt][ks]); const unsigned ww[4] = {w.x, w.y, w.z, w.w};
#pragma unroll
            for (int e = 0; e < 8; ++e) { const float v = ((e & 1) ? bfhi(ww[e >> 1]) : bflo(ww[e >> 1])) * sc;
                *(LAS bf16*)(XT + (32 * ks + 8 * fq + e) * RS + (16 * mt + fr) * 2) = (bf16)(pk2(v, 0.f) & 0xffffu); } } }
    LDS_WAIT(); asm volatile("" ::: "memory");
#pragma unroll
    for (int i = 0; i < 8; ++i) { const int piece = i * 64 + lane, rr = piece >> 3, cc = piece & 7;
        *(GAS v4u*)(OPS + 3 * 4096 + rr * 64 + cc * 8) = *(const LAS v4u*)(XT + rr * RS + cc * 16); }
    LDS_WAIT(); asm volatile("" ::: "memory");
}

constexpr int L_OPS = 0;
constexpr int L_ST = 2 * 4 * 64 * RS, L_VNT = L_ST + 2 * 64 * RS, L_SSQ = L_VNT + 64 * RS, L_EG = L_SSQ + 2 * 8 * 16 * 4, L_SCAN_END = L_EG + 64 * 4;
static_assert(L_SCAN_END <= RING_BYTES, "dn scan lds");
__device__ __forceinline__ void scan_finish(const f32x4 (&o)[2], const v2u (&z)[2], const f32x4 (&gn)[2], const LAS float* ssq, int wave, int fr, bf16* dst) {
    const float ss = ssq[wave * 16 + fr] + ssq[(wave ^ 1) * 16 + fr];
    const float rs = rsqrtf(ss * (1.f / 64.f) + RMS_EPS);
#pragma unroll
    for (int t = 0; t < 2; ++t) {
        const float zz[4] = {bflo(z[t].x), bfhi(z[t].x), bflo(z[t].y), bfhi(z[t].y)}; float y[4];
#pragma unroll
        for (int r = 0; r < 4; ++r) y[r] = o[t][r] * rs * gn[t][r] * (zz[r] / (1.f + __expf(-zz[r])));
        v2u w; w.x = pk2(y[0], y[1]); w.y = pk2(y[2], y[3]);
        *(GAS v2u*)(dst + 16 * t) = w;
    }
}
struct ScanPre { v4u op[4]; v2u u[2]; };
__device__ __forceinline__ void scan_unit(const Args& a, LAS unsigned char* lds, int b, int h, int tid, bf16* MIX, float* recbase) {
    unsigned char* ws = a.ws; asm volatile("" : "+s"(ws));
    asm volatile("" : "+v"(tid));
    const int lane = tid & 63, wave = __builtin_amdgcn_readfirstlane(tid >> 6), fr = lane & 15, fq = lane >> 4;
    const int mt = wave >> 1, nt0 = 2 * (wave & 1);
    for (int i = tid; i < 64 * RS / 4; i += NTHREADS) ((LAS unsigned*)(lds + L_ST))[i] = 0u;
    LAS float* EG = (LAS float*)(lds + L_EG);
    if (tid < NCHUNK) EG[tid] = ((const float*)(ws + WS_GLAST))[((size_t)b * 64 + tid) * 8 + h];
    f32x4 Sacc[2] = {{0.f, 0.f, 0.f, 0.f}, {0.f, 0.f, 0.f, 0.f}};
    const int prow = tid >> 3, pcol = tid & 7;
    const size_t chbase = ((size_t)b * 64 * 8 + h) * 5 * 4096;
    const bf16* OPS0 = (const bf16*)(ws + WS_DN) + chbase;
    const bf16* PROJ = (const bf16*)(ws + WS_PROJ);
    f32x4 gn[2];
#pragma unroll
    for (int t = 0; t < 2; ++t) gn[t] = *(const f32x4*)(a.in[I_DNNORM] + 16 * (nt0 + t) + 4 * fq);
    auto issue = [&](ScanPre& p, int n) {
        const bf16* o = OPS0 + (size_t)n * 8 * 5 * 4096;
#pragma unroll
        for (int q = 0; q < 4; ++q) p.op[q] = __builtin_nontemporal_load((const v4u*)(o + (1 + q) * 4096 + prow * 64 + pcol * 8));
#pragma unroll
        for (int t = 0; t < 2; ++t) p.u[t] = __builtin_nontemporal_load((const v2u*)(o + ((mt * 4 + nt0 + t) * 64 + lane) * 4));
    };
    auto commit = [&](const ScanPre& p, int buf) {
#pragma unroll
        for (int q = 0; q < 4; ++q) *(LAS v4u*)(lds + L_OPS + (buf * 4 + q) * 64 * RS + prow * RS + pcol * 16) = p.op[q];
    };
    f32x4 oprev[2] = {{0.f, 0.f, 0.f, 0.f}, {0.f, 0.f, 0.f, 0.f}}; v2u zprev[2] = {{0u, 0u}, {0u, 0u}};
    LAS float* SSQ = (LAS float*)(lds + L_SSQ);
    auto step = [&](int n, const v2u (&ucur)[2]) {
        const int buf = n & 1;
        const LAS unsigned char* Wl = lds + L_OPS + (buf * 4 + 0) * 64 * RS; const LAS unsigned char* QSl = Wl + 64 * RS; const LAS unsigned char* KDl = QSl + 64 * RS; const LAS unsigned char* AQl = KDl + 64 * RS;
        const LAS unsigned char* STc = lds + L_ST + buf * 64 * RS; LAS unsigned char* STn = lds + L_ST + (buf ^ 1) * 64 * RS; LAS unsigned char* VNT = lds + L_VNT;
        const float eg = EG[n];
        const size_t rowc = (size_t)b * SEQ + n * 64 + 16 * mt + fr;
        v2u zcur[2];
#pragma unroll
        for (int t = 0; t < 2; ++t) zcur[t] = *(const GAS v2u*)(PROJ + rowc * NPROJ_PAD + C_Z + h * 64 + 16 * (nt0 + t) + 4 * fq);
        if (n > 0) scan_finish(oprev, zprev, gn, SSQ + ((n - 1) & 1) * 128, wave, fr, MIX + (rowc - 64) * DM + h * 64 + 16 * nt0 + 4 * fq);
#pragma unroll
        for (int t = 0; t < 2; ++t) {
            f32x4 acc = {0.f, 0.f, 0.f, 0.f};
#pragma unroll
            for (int ks = 0; ks < 2; ++ks) acc = MFMA16(ldfrag(Wl, 16 * mt + fr, 32 * ks + 8 * fq), ldfrag(STc, 16 * (nt0 + t) + fr, 32 * ks + 8 * fq), acc);
            const float u0 = bflo(ucur[t].x), u1 = bfhi(ucur[t].x), u2 = bflo(ucur[t].y), u3 = bfhi(ucur[t].y);
            v2u o; o.x = pk2(u0 - acc[0], u1 - acc[1]); o.y = pk2(u2 - acc[2], u3 - acc[3]);
            *(LAS v2u*)(VNT + (16 * (nt0 + t) + fr) * RS + (16 * mt + 4 * fq) * 2) = o;
        }
        BAR_LDS();
        float ssp = 0.f;
#pragma unroll
        for (int t = 0; t < 2; ++t) {
            f32x4 acc = {0.f, 0.f, 0.f, 0.f};
#pragma unroll
            for (int ks = 0; ks < 2; ++ks) {
                acc = MFMA16(ldfrag(STc, 16 * (nt0 + t) + fr, 32 * ks + 8 * fq), ldfrag(QSl, 16 * mt + fr, 32 * ks + 8 * fq), acc);
                acc = MFMA16(ldfrag(VNT, 16 * (nt0 + t) + fr, 32 * ks + 8 * fq), ldfrag(AQl, 16 * mt + fr, 32 * ks + 8 * fq), acc);
            }
            oprev[t] = acc; zprev[t] = zcur[t];
            ssp += (acc[0] * acc[0] + acc[1] * acc[1]) + (acc[2] * acc[2] + acc[3] * acc[3]);
        }
        ssp += __shfl_xor(ssp, 16); ssp += __shfl_xor(ssp, 32);
        if (fq == 0) SSQ[(n & 1) * 128 + wave * 16 + fr] = ssp;
#pragma unroll
        for (int t = 0; t < 2; ++t) {
            f32x4 acc = Sacc[t] * eg;
#pragma unroll
            for (int ks = 0; ks < 2; ++ks) acc = MFMA16(ldfrag(KDl, 16 * mt + fr, 32 * ks + 8 * fq), ldfrag(VNT, 16 * (nt0 + t) + fr, 32 * ks + 8 * fq), acc);
            Sacc[t] = acc;
            v2u o; o.x = pk2(acc[0], acc[1]); o.y = pk2(acc[2], acc[3]);
            *(LAS v2u*)(STn + (16 * (nt0 + t) + fr) * RS + (16 * mt + 4 * fq) * 2) = o;
        }
    };
    ScanPre pa, pb;
    issue(pa, 0); commit(pa, 0);
    v2u u0[2] = {pa.u[0], pa.u[1]}, u1[2];
    issue(pb, 1); issue(pa, 2);
#pragma unroll 1
    for (int n = 0; n < NCHUNK; n += 2) {
        BAR_LDS();
        commit(pb, 1); u1[0] = pb.u[0]; u1[1] = pb.u[1];
        if (n + 3 < NCHUNK) issue(pb, n + 3);
        step(n, u0);
        BAR_LDS();
        if (n + 2 < NCHUNK) { commit(pa, 0); u0[0] = pa.u[0]; u0[1] = pa.u[1]; }
        if (n + 4 < NCHUNK) issue(pa, n + 4);
        step(n + 1, u1);
    }
    BAR_LDS();
    scan_finish(oprev, zprev, gn, SSQ + ((NCHUNK - 1) & 1) * 128, wave, fr, MIX + ((size_t)b * SEQ + (NCHUNK - 1) * 64 + 16 * mt + fr) * DM + h * 64 + 16 * nt0 + 4 * fq);
    float* rec = recbase + (size_t)(b * 8 + h) * 4096;
#pragma unroll
    for (int t = 0; t < 2; ++t)
#pragma unroll
        for (int r = 0; r < 4; ++r) rec[(16 * mt + 4 * fq + r) * 64 + 16 * (nt0 + t) + fr] = Sacc[t][r];
    __syncthreads();
}
}
namespace mem {
constexpr int KS = 528, VS = 80, L_K = 0, L_V = 2 * 32 * KS, L_END = L_V + 2 * 256 * VS;
static_assert(L_END <= RING_BYTES, "mem lds");
constexpr float CEXP = 0.0625f * 1.44269504088896f;
struct Pre { v4u k[2], v[2]; };
__device__ __forceinline__ void tload(Pre& p, const bf16* kv, int key0, int tid) {
#pragma unroll
    for (int r = 0; r < 2; ++r) { const int pc = tid + 512 * r;
        p.k[r] = *(const GAS v4u*)(kv + (size_t)(key0 + (pc >> 5)) * 2048 + (pc & 31) * 8);
        p.v[r] = *(const GAS v4u*)(kv + (size_t)(key0 + (pc & 31)) * 2048 + 1024 + (pc >> 5) * 8); }
}
__device__ __forceinline__ void tstore(const Pre& p, LAS unsigned char* Kt, LAS unsigned char* Vt, int tid) {
#pragma unroll
    for (int r = 0; r < 2; ++r) { const int pc = tid + 512 * r;
        *(LAS v4u*)(Kt + (pc >> 5) * KS + (pc & 31) * 16) = p.k[r];
        LAS unsigned char* vp = Vt + (8 * (pc >> 5)) * VS + (pc & 31) * 2;
        const unsigned w[4] = {p.v[r].x, p.v[r].y, p.v[r].z, p.v[r].w};
#pragma unroll
        for (int e = 0; e < 4; ++e) { *(LAS bf16*)(vp + (2 * e) * VS) = (bf16)(w[e] & 0xffffu); *(LAS bf16*)(vp + (2 * e + 1) * VS) = (bf16)(w[e] >> 16); } }
}
__device__ __forceinline__ void prompt_unit(const Args& a, LAS unsigned char* lds, int b, int head, int tt, int tid, bf16* OMp) {
    unsigned char* ws = a.ws; asm volatile("" : "+s"(ws));
    asm volatile("" : "+v"(tid));
    const int lane = tid & 63, wave = __builtin_amdgcn_readfirstlane(tid >> 6), fr = lane & 15, fq = lane >> 4;
    const size_t row = (size_t)b * SEQ + tt * 128 + wave * 16 + fr;
    const bf16* qp = (const bf16*)(ws + WS_QM) + row * DM + head * 256 + 8 * fq;
    bf16x8 Qf[8];
#pragma unroll
    for (int ks = 0; ks < 8; ++ks) Qf[ks] = __builtin_nontemporal_load((const bf16x8*)(qp + 32 * ks));
    const bf16* kv = (const bf16*)(ws + WS_MEMKV) + (size_t)(b * MEMLEN) * 2048 + head * 256;
    f32x4 O[16];
#pragma unroll
    for (int i = 0; i < 16; ++i) O[i] = (f32x4){0.f, 0.f, 0.f, 0.f};
    float m = -1e30f, l = 0.f;
    Pre pre; tload(pre, kv, 0, tid);
#pragma unroll 1
    for (int t = 0; t < 8; ++t) {
        LAS unsigned char* Kt = lds + L_K + (t & 1) * 32 * KS; LAS unsigned char* Vt = lds + L_V + (t & 1) * 256 * VS;
        tstore(pre, Kt, Vt, tid);
        BAR_LDS();
        if (t < 7) tload(pre, kv, 32 * (t + 1), tid);
        f32x4 s0 = {0.f, 0.f, 0.f, 0.f}, s1 = {0.f, 0.f, 0.f, 0.f};
#pragma unroll
        for (int ks = 0; ks < 8; ++ks) {
            s0 = MFMA16(*(const LAS bf16x8*)(Kt + fr * KS + (32 * ks + 8 * fq) * 2), Qf[ks], s0);
            s1 = MFMA16(*(const LAS bf16x8*)(Kt + (16 + fr) * KS + (32 * ks + 8 * fq) * 2), Qf[ks], s1);
        }
        float mx = fmaxf(fmaxf(fmaxf(s0[0], s0[1]), fmaxf(s0[2], s0[3])), fmaxf(fmaxf(s1[0], s1[1]), fmaxf(s1[2], s1[3])));
        mx = fmaxf(mx, __shfl_xor(mx, 16)); mx = fmaxf(mx, __shfl_xor(mx, 32));
        const float mn = fmaxf(m, mx), alpha = fast_exp2((m - mn) * CEXP);
        float ps = 0.f;
#pragma unroll
        for (int i = 0; i < 4; ++i) { s0[i] = fast_exp2((s0[i] - mn) * CEXP); s1[i] = fast_exp2((s1[i] - mn) * CEXP); ps += s0[i] + s1[i]; }
        ps += __shfl_xor(ps, 16); ps += __shfl_xor(ps, 32);
        l = l * alpha + ps; m = mn;
        v4u pw; pw.x = pk2(s0[0], s0[1]); pw.y = pk2(s0[2], s0[3]); pw.z = pk2(s1[0], s1[1]); pw.w = pk2(s1[2], s1[3]);
        const bf16x8 pb = __builtin_bit_cast(bf16x8, pw);
#pragma unroll
        for (int dt = 0; dt < 16; ++dt) {
            const LAS unsigned char* vr = Vt + (16 * dt + fr) * VS + (4 * fq) * 2;
            const v2u lo = *(const LAS v2u*)vr, hi = *(const LAS v2u*)(vr + 32);
            v4u aw; aw.x = lo.x; aw.y = lo.y; aw.z = hi.x; aw.w = hi.y;
            O[dt] = MFMA16(__builtin_bit_cast(bf16x8, aw), pb, O[dt] * alpha);
        }
    }
    const float inv = 1.f / l;
    bf16* op = OMp + row * DM + head * 256 + 4 * fq;
#pragma unroll
    for (int dt = 0; dt < 16; ++dt) { v2u w; w.x = pk2(O[dt][0] * inv, O[dt][1] * inv); w.y = pk2(O[dt][2] * inv, O[dt][3] * inv); *(GAS v2u*)(op + 16 * dt) = w; }
    __syncthreads();
}

__device__ __forceinline__ void sample_unit(const Args& a, LAS unsigned char* lds, int s, int head, int tid, bf16* OMp) {
    unsigned char* ws = a.ws; asm volatile("" : "+s"(ws));
    asm volatile("" : "+v"(tid));
    const int lane = tid & 63, wave = __builtin_amdgcn_readfirstlane(tid >> 6);
    LAS float* SC = (LAS float*)lds; LAS float* RED = SC + 256;
    const size_t row = (size_t)MP + s;
    const v2u qw = *(const GAS v2u*)((const bf16*)(ws + WS_QM) + row * DM + head * 256 + 4 * lane);
    const f32x4 q = {bflo(qw.x), bfhi(qw.x), bflo(qw.y), bfhi(qw.y)};
    const float* kb = a.in[I_CMEM] + ((size_t)(s * MEMLEN + wave * 32) * 2) * 1024 + head * 256 + 4 * lane;
    float sc_own = 0.f;
#pragma unroll 8
    for (int i = 0; i < 32; ++i) {
        const f32x4 kx = ld_nt(kb + (size_t)i * 2048);
        float d = (q.x * kx.x + q.y * kx.y) + (q.z * kx.z + q.w * kx.w);
        d = wave_sum(d);
        sc_own = (lane == i) ? d : sc_own;
    }
    if (lane < 32) SC[wave * 32 + lane] = sc_own * 0.0625f;
    BAR_LDS();
    const f32x4 all = *(const LAS f32x4*)(SC + 4 * lane);
    float mx = fmaxf(fmaxf(all.x, all.y), fmaxf(all.z, all.w));
#pragma unroll
    for (int o = 1; o < 64; o <<= 1) mx = fmaxf(mx, __shfl_xor(mx, o));
    float sum = (__expf(all.x - mx) + __expf(all.y - mx)) + (__expf(all.z - mx) + __expf(all.w - mx));
    sum = wave_sum(sum);
    const float p_own = __expf(sc_own * 0.0625f - mx) / sum;
    f32x4 o = {0.f, 0.f, 0.f, 0.f};
    const float* vb = kb + 1024;
#pragma unroll 8
    for (int i = 0; i < 32; ++i) { const f32x4 vx = ld_nt(vb + (size_t)i * 2048); const float pi = __shfl(p_own, i); o = o + vx * pi; }
    *(LAS f32x4*)(RED + wave * 256 + 4 * lane) = o;
    BAR_LDS();
    if (tid < 256) { float acc = 0.f;
#pragma unroll
        for (int w = 0; w < 8; ++w) acc += RED[w * 256 + tid];
        OMp[row * DM + head * 256 + tid] = (bf16)(pk2(acc, 0.f) & 0xffffu); }
    __syncthreads();
}
}
namespace cmp {
constexpr int RS = 144, HS = 272;
constexpr int L_A = 0, L_B = 2 * 64 * RS, L_H = L_B + 2 * 128 * RS, L_W2 = L_H + 64 * HS, L_BIAS = L_W2 + 64 * HS, L_END = L_BIAS + 512;
static_assert(L_END <= RING_BYTES, "cmp lds");
template <bool SAMPLE> __device__ __forceinline__ void unit(const Args& a, LAS unsigned char* lds, int seq, int kind, int hf, int tid, float* kcs, float* kcp, int var = 0) {
    unsigned char* ws = a.ws; asm volatile("" : "+s"(ws));
    asm volatile("" : "+v"(tid));
    const int lane = tid & 63, wave = __builtin_amdgcn_readfirstlane(tid >> 6), fr = lane & 15, fq = lane >> 4, mt = wave & 3, half = wave >> 2;
    const bf16* w1t = (const bf16*)(ws + WS_W1_T) + (size_t)kind * 128 * 4096;
    const float* arow[2]; const bf16* arowh = nullptr;
    if (SAMPLE) {
        const int* pt = (const int*)a.in[I_PT] + seq * NPAGES;
#pragma unroll
        for (int r = 0; r < 2; ++r) { const int p = tid + 512 * r, rowA = p >> 4, c4 = p & 15, n = rowA >> 1, g = rowA & 1;
            arow[r] = a.in[I_CNSA] + ((size_t)pt[n >> 1] * PAGE + (n & 1) * 64) * 512 + (kind * 2 + g) * 64 + c4 * 4; }
    } else {
        const int rowA = tid >> 3, c8 = tid & 7, n = 32 * hf + (rowA >> 1), g = rowA & 1;
        arowh = (const bf16*)(ws + WS_PROJ) + (size_t)(seq * SEQ + n * 64) * NPROJ_PAD + C_NKV + (kind * 2 + g) * 64 + c8 * 8;
        arow[0] = arow[1] = nullptr;
    }
    struct Stage { f32x4 af[2]; v4u ah; v4u bw[2]; };
    auto issue = [&](Stage& st, int c) {
        if (SAMPLE) { st.af[0] = ld_nt(arow[0] + (size_t)c * 512); st.af[1] = ld_nt(arow[1] + (size_t)c * 512); }
        else st.ah = *(const GAS v4u*)(arowh + (size_t)c * NPROJ_PAD);
#pragma unroll
        for (int r = 0; r < 2; ++r) { const int p = tid + 512 * r; st.bw[r] = *(const GAS v4u*)(w1t + (size_t)(p >> 3) * 4096 + c * 64 + (p & 7) * 8); }
    };
    auto commit = [&](const Stage& st, int buf) {
        LAS unsigned char* A = lds + L_A + buf * 64 * RS; LAS unsigned char* B = lds + L_B + buf * 128 * RS;
        if (SAMPLE) {
#pragma unroll
            for (int r = 0; r < 2; ++r) { const int p = tid + 512 * r; v2u w; w.x = pk2(st.af[r].x, st.af[r].y); w.y = pk2(st.af[r].z, st.af[r].w); *(LAS v2u*)(A + (p >> 4) * RS + (p & 15) * 8) = w; }
        } else *(LAS v4u*)(A + (tid >> 3) * RS + (tid & 7) * 16) = st.ah;
#pragma unroll
        for (int r = 0; r < 2; ++r) { const int p = tid + 512 * r; *(LAS v4u*)(B + (p >> 3) * RS + (p & 7) * 16) = st.bw[r]; }
    };
    f32x4 acc[4];
#pragma unroll
    for (int i = 0; i < 4; ++i) acc[i] = (f32x4){0.f, 0.f, 0.f, 0.f};
    auto compute = [&](int buf) {
        const LAS unsigned char* A = lds + L_A + buf * 64 * RS; const LAS unsigned char* B = lds + L_B + buf * 128 * RS;
        bf16x8 af[2], bfr[2][4];
#pragma unroll
        for (int ks = 0; ks < 2; ++ks) { af[ks] = *(const LAS bf16x8*)(A + (16 * mt + fr) * RS + (32 * ks + 8 * fq) * 2);
#pragma unroll
            for (int nt = 0; nt < 4; ++nt) bfr[ks][nt] = *(const LAS bf16x8*)(B + (64 * half + 16 * nt + fr) * RS + (32 * ks + 8 * fq) * 2); }
        asm volatile("s_waitcnt lgkmcnt(0)" ::: "memory");
#pragma unroll
        for (int ks = 0; ks < 2; ++ks)
#pragma unroll
            for (int nt = 0; nt < 4; ++nt) acc[nt] = MFMA16(af[ks], bfr[ks][nt], acc[nt]);
    };
    Stage s0, s1, s2, s3;
    issue(s0, 0); issue(s1, 1); issue(s2, 2); issue(s3, 3);
    if (tid < 128) { float s = a.in[I_B1][kind * 128 + tid]; const float* pb = (const float*)(ws + WS_PEB) + kind * 128 + tid;
#pragma unroll 8
        for (int i = 0; i < 32; ++i) s += pb[i * 256];
        ((LAS float*)(lds + L_BIAS))[tid] = s; }
    { const float* w2 = a.in[I_W2] + (size_t)kind * 128 * 64;
#pragma unroll
      for (int r = 0; r < 16; ++r) { const int e = tid + 512 * r, hid = e >> 6, o = e & 63; *(LAS bf16*)(lds + L_W2 + o * HS + hid * 2) = (bf16)(pk2(w2[e], 0.f) & 0xffffu); } }
#pragma unroll 1
    for (int c = 0; c < 64; c += 16) {
#define CMP_STEP(ST, BUF, NEXT) do { __builtin_amdgcn_sched_barrier(0); commit(ST, BUF); BAR_LDS(); issue(ST, (NEXT) < 64 ? (NEXT) : 63); __builtin_amdgcn_sched_barrier(0); compute(BUF); __builtin_amdgcn_sched_barrier(0); } while (0)
        CMP_STEP(s0, 0, c + 4); CMP_STEP(s1, 1, c + 5); CMP_STEP(s2, 0, c + 6); CMP_STEP(s3, 1, c + 7);
        CMP_STEP(s0, 0, c + 8); CMP_STEP(s1, 1, c + 9); CMP_STEP(s2, 0, c + 10); CMP_STEP(s3, 1, c + 11);
        CMP_STEP(s0, 0, c + 12); CMP_STEP(s1, 1, c + 13); CMP_STEP(s2, 0, c + 14); CMP_STEP(s3, 1, c + 15);
        CMP_STEP(s0, 0, c + 16); CMP_STEP(s1, 1, c + 17); CMP_STEP(s2, 0, c + 18); CMP_STEP(s3, 1, c + 19);
#undef CMP_STEP
    }
#pragma unroll
    for (int nt = 0; nt < 4; ++nt) { const int hid = 64 * half + 16 * nt + fr; const float bs = ((const LAS float*)(lds + L_BIAS))[hid];
#pragma unroll
        for (int r = 0; r < 4; ++r) *(LAS bf16*)(lds + L_H + (16 * mt + 4 * fq + r) * HS + hid * 2) = (bf16)(pk2(fmaxf(acc[nt][r] + bs, 0.f), 0.f) & 0xffffu); }
    BAR_LDS();
    float* dst = SAMPLE ? kcs + (size_t)kind * (DBATCH * 32 * 2 * 64) + (size_t)seq * 64 * 64
                        : kcp + (size_t)kind * (NB * 64 * 2 * 64) + ((size_t)seq * 128 + 64 * hf) * 64;
#pragma unroll
    for (int t = 0; t < 2; ++t) { const int ot = 2 * half + t;
        f32x4 o = {0.f, 0.f, 0.f, 0.f};
#pragma unroll
        for (int ks = 0; ks < 4; ++ks) o = MFMA16(*(const LAS bf16x8*)(lds + L_H + (16 * mt + fr) * HS + (32 * ks + 8 * fq) * 2), *(const LAS bf16x8*)(lds + L_W2 + (16 * ot + fr) * HS + (32 * ks + 8 * fq) * 2), o);
#pragma unroll
        for (int r = 0; r < 4; ++r) dst[(size_t)(16 * mt + 4 * fq + r) * 64 + 16 * ot + fr] = o[r]; }
    __syncthreads();
}
}
namespace snsa {
constexpr int L_Q = 0, L_KC = 1024, L_VC = L_KC + 32 * 65 * 4, L_P = L_VC + 32 * 64 * 4, L_OC = L_P + 4 * 32 * 4, L_SEL = L_OC + 4 * 64 * 4, L_PT = L_SEL + 64, L_PART = L_PT + 64,
              PART_STRIDE = 4 * 68, L_END = L_PART + 2 * 8 * PART_STRIDE * 4;
static_assert(L_END <= RING_BYTES, "snsa lds");
constexpr float C2 = 0.125f * 1.44269504088896f;
struct St { float m[4], l[4]; f32x4 o[4]; };
__device__ __forceinline__ void st_init(St& s) {
#pragma unroll
    for (int h = 0; h < 4; ++h) { s.m[h] = -1e30f; s.l[h] = 0.f; s.o[h] = (f32x4){0.f, 0.f, 0.f, 0.f}; } }
__device__ __forceinline__ void key_step(St& st, const f32x4 (&q)[4], const f32x4 k4, const f32x4 v4, bool valid) {
#pragma unroll
    for (int h = 0; h < 4; ++h) {
        float d = (q[h].x * k4.x + q[h].y * k4.y) + (q[h].z * k4.z + q[h].w * k4.w);
        d = row16_sum(d);
        const float mn = valid ? fmaxf(st.m[h], d) : st.m[h];
        const float alpha = fast_exp2((st.m[h] - mn) * C2), p = valid ? fast_exp2((d - mn) * C2) : 0.f;
        st.l[h] = st.l[h] * alpha + p; st.o[h] = st.o[h] * alpha + v4 * p; st.m[h] = mn;
    }
}
__device__ __forceinline__ void st_merge_xor(St& st, int x) {
#pragma unroll
    for (int h = 0; h < 4; ++h) {
        const float m2 = __shfl_xor(st.m[h], x), l2 = __shfl_xor(st.l[h], x);
        f32x4 o2; o2.x = __shfl_xor(st.o[h].x, x); o2.y = __shfl_xor(st.o[h].y, x); o2.z = __shfl_xor(st.o[h].z, x); o2.w = __shfl_xor(st.o[h].w, x);
        const float M = fmaxf(st.m[h], m2), a1 = fast_exp2((st.m[h] - M) * C2), a2 = fast_exp2((m2 - M) * C2);
        st.l[h] = st.l[h] * a1 + l2 * a2; st.o[h] = st.o[h] * a1 + o2 * a2; st.m[h] = M;
    }
}
__device__ __forceinline__ void unit(const Args& a, LAS unsigned char* lds, int s, int g, int tid, bf16* MIXp) {
    unsigned char* ws = a.ws; asm volatile("" : "+s"(ws));
    asm volatile("" : "+v"(tid));
    const int lane = tid & 63, wave = __builtin_amdgcn_readfirstlane(tid >> 6), sub = lane & 15, slot = lane >> 4;
    const size_t row = (size_t)MP + s;
    LAS float* Q = (LAS float*)(lds + L_Q); LAS float* KC = (LAS float*)(lds + L_KC); LAS float* VC = (LAS float*)(lds + L_VC); LAS float* P = (LAS float*)(lds + L_P);
    LAS float* OC = (LAS float*)(lds + L_OC); LAS int* SEL = (LAS int*)(lds + L_SEL); LAS int* PT = (LAS int*)(lds + L_PT); LAS float* PART = (LAS float*)(lds + L_PART);
    if (tid < 256) Q[tid] = bf2f(((const bf16*)(ws + WS_PROJ))[row * NPROJ_PAD + C_NQ + (g * 4 + (tid >> 6)) * 64 + (tid & 63)]);
    { const float* kc = (const float*)(ws + WS_KCMP_S) + ((size_t)s * 32 * 2 + g) * 64; const float* vc = kc + (size_t)DBATCH * 32 * 2 * 64;
#pragma unroll
      for (int r = 0; r < 4; ++r) { const int e = tid + 512 * r, n = e >> 6, d = e & 63; KC[n * 65 + d] = kc[(size_t)n * 128 + d]; VC[n * 64 + d] = vc[(size_t)n * 128 + d]; } }
    if (tid < NPAGES) PT[tid] = ((const int*)a.in[I_PT])[s * NPAGES + tid];
    BAR_LDS();
    const float* cw = a.in[I_CWIN] + (size_t)s * 512 * 256 + g * 64 + 4 * sub;
    float* ow = a.out + O_SWIN + (size_t)s * 512 * 256 + g * 64 + 4 * sub;
    const float* cache = a.in[I_CNSA] + (4 + g) * 64 + 4 * sub;
    f32x4 kA[4], vA[4], kB[4], vB[4];
    St ss, sw; st_init(sw);
    auto load_win = [&](f32x4 (&kk)[4], f32x4 (&vv)[4], int base) {
#pragma unroll
        for (int u = 0; u < 4; ++u) { const int kw = 4 * (wave + 8 * (base + u)) + slot;
            const float* p = kw == 511 ? (const float*)ow + (size_t)511 * 256 : cw + (size_t)(kw + 1) * 256;
            kk[u] = ld_nt(p); vv[u] = ld_nt(p + 128); } };
    auto comp_win = [&](const f32x4 (&kk)[4], const f32x4 (&vv)[4], int base) {
        f32x4 q[4];
#pragma unroll
        for (int h = 0; h < 4; ++h) q[h] = *(const LAS f32x4*)(Q + h * 64 + 4 * sub);
#pragma unroll
        for (int u = 0; u < 4; ++u) { const int kw = 4 * (wave + 8 * (base + u)) + slot;
            if (kw != 511) { st_nt(ow + (size_t)kw * 256, kk[u]); st_nt(ow + (size_t)kw * 256 + 128, vv[u]); }
            key_step(sw, q, kk[u], vv[u], true); __builtin_amdgcn_sched_barrier(0); } };
    auto load_slc = [&](f32x4 (&kk)[4], f32x4 (&vv)[4], int base) {
#pragma unroll
        for (int u = 0; u < 4; ++u) { const int it = base + u < 30 ? base + u : 29;
            const int key = 4 * (wave + 8 * it) + slot, blk = SEL[key >> 6], tok = key & 63;
            const float* p = cache + ((size_t)PT[blk >> 1] * PAGE + (blk & 1) * 64 + tok) * 512;
            kk[u] = ld_nt(p); vv[u] = ld_nt(p + 128); } };
    auto comp_slc = [&](const f32x4 (&kk)[4], const f32x4 (&vv)[4], int base) {
        f32x4 q[4];
#pragma unroll
        for (int h = 0; h < 4; ++h) q[h] = *(const LAS f32x4*)(Q + h * 64 + 4 * sub);
#pragma unroll
        for (int u = 0; u < 4; ++u) { key_step(ss, q, kk[u], vv[u], base + u < 30); __builtin_amdgcn_sched_barrier(0); } };
    load_win(kA, vA, 0);
    if (wave < 4) {
        const int n = lane & 31; const bool vis = lane < 32;
        float sc = 0.f;
#pragma unroll 8
        for (int d = 0; d < 64; ++d) sc += Q[wave * 64 + d] * KC[n * 65 + d];
        const float x = vis ? sc * 0.125f : -1e30f; float mx = x;
#pragma unroll
        for (int o = 1; o < 64; o <<= 1) mx = fmaxf(mx, __shfl_xor(mx, o));
        const float e = vis ? __expf(x - mx) : 0.f; const float sum = wave_sum(e);
        if (vis) P[wave * 32 + n] = e / fmaxf(sum, 1e-30f);
    }
    BAR_LDS();
    if (wave < 4) {
        float oc = 0.f;
#pragma unroll 8
        for (int nn = 0; nn < 32; ++nn) oc += P[wave * 32 + nn] * VC[nn * 64 + lane];
        OC[wave * 64 + lane] = oc;
        if (wave == 0) {
            const int n = lane & 31;
            const float imp = lane < 32 ? (P[n] + P[32 + n]) + (P[64 + n] + P[96 + n]) : 0.f;
            const bool inarr = lane < 33, forced = inarr && (lane == 0 || lane >= 31);
            const float score = !inarr ? -2.f : imp + (forced ? 1000.f : 0.f);
            int rank = 0;
#pragma unroll 8
            for (int j = 0; j < 64; ++j) { const float sj = __shfl(score, j); rank += (sj > score || (sj == score && j < lane)) ? 1 : 0; }
            const bool selj = inarr && rank < 16;
            const unsigned long long mask = __ballot(selj);
            if (selj && lane < 32) SEL[__popcll(mask & ((1ull << lane) - 1ull))] = lane;
        }
    }
#pragma unroll 1
    for (int base = 0; base < 16; base += 8) {
        load_win(kB, vB, base + 4); comp_win(kA, vA, base);
        if (base == 0) { load_win(kA, vA, 8); comp_win(kB, vB, 4); }
    }
    BAR_LDS();
    load_slc(kA, vA, 0);  comp_win(kB, vB, 12);
    st_merge_xor(sw, 16); st_merge_xor(sw, 32);
    if (slot == 0) {
#pragma unroll
        for (int h = 0; h < 4; ++h) { LAS float* p1 = PART + (1 * 8 + wave) * PART_STRIDE + h * 68; *(LAS f32x4*)(p1 + 4 * sub) = sw.o[h]; if (sub == 0) { p1[64] = sw.m[h]; p1[65] = sw.l[h]; } }
    }
    st_init(ss);
#pragma unroll 1
    for (int base = 0; base < 32; base += 8) {
        load_slc(kB, vB, base + 4); comp_slc(kA, vA, base);
        load_slc(kA, vA, base + 8 < 32 ? base + 8 : 28); comp_slc(kB, vB, base + 4);
    }
    {   const float* nw = a.out + O_SNSA + (size_t)s * 512 + (4 + g) * 64 + 4 * sub;
        const f32x4 k4 = *(const GAS f32x4*)nw, v4 = *(const GAS f32x4*)(nw + 128);
        f32x4 q[4];
#pragma unroll
        for (int h = 0; h < 4; ++h) q[h] = *(const LAS f32x4*)(Q + h * 64 + 4 * sub);
        key_step(ss, q, k4, v4, wave == 0 && slot == 0); }
    st_merge_xor(ss, 16); st_merge_xor(ss, 32);
    if (slot == 0) {
#pragma unroll
        for (int h = 0; h < 4; ++h) { LAS float* p0 = PART + (0 * 8 + wave) * PART_STRIDE + h * 68; *(LAS f32x4*)(p0 + 4 * sub) = ss.o[h]; if (sub == 0) { p0[64] = ss.m[h]; p0[65] = ss.l[h]; } }
    }
    BAR_LDS();
    if (tid < 256) {
        const int h = tid >> 6, d = tid & 63;
        float res[2];
#pragma unroll
        for (int br = 0; br < 2; ++br) {
            float M = -1e30f;
#pragma unroll
            for (int w = 0; w < 8; ++w) M = fmaxf(M, PART[(br * 8 + w) * PART_STRIDE + h * 68 + 64]);
            float L = 0.f, O = 0.f;
#pragma unroll
            for (int w = 0; w < 8; ++w) { const LAS float* pp = PART + (br * 8 + w) * PART_STRIDE + h * 68; const float sc = fast_exp2((pp[64] - M) * C2); L += pp[65] * sc; O += pp[d] * sc; }
            res[br] = O / fmaxf(L, 1e-30f);
        }
        const float* GL = (const float*)(ws + WS_GL) + row * 24 + (g * 4 + h) * 3;
        const float gc = 1.f / (1.f + __expf(-GL[0])), gs = 1.f / (1.f + __expf(-GL[1])), gw = 1.f / (1.f + __expf(-GL[2]));
        const float y = gc * OC[h * 64 + d] + gs * res[0] + gw * res[1];
        MIXp[row * DM + 512 + (g * 4 + h) * 64 + d] = (bf16)(pk2(y, 0.f) & 0xffffu);
    }
    __syncthreads();
}
}
constexpr int CW_DIAG = 8192;
__device__ __forceinline__ float* diag_ptr(const Args& a) { return (float*)(a.ws + WS_CTL) + CW_DIAG; }
__device__ __forceinline__ void diag_add(const Args& a, int slot, float v, int lane) { v = wave_sum(v); if (lane == 0) atomicAdd(diag_ptr(a) + slot, v); }
__device__ __forceinline__ void diag_emit_one(const Args& a, size_t off, size_t cap, float value, int tid) {
    size_t n = value <= 0.f ? 0 : (value >= (float)cap ? cap : (size_t)value);
    unsigned* o = (unsigned*)(a.out + off);
    for (size_t i = tid; i < n; i += NTHREADS) o[i] = 0xAAAAAAAAu;
}
__device__ __forceinline__ void diag_cmp_bf16(const Frame& F, const Args& a, const bf16* x, const bf16* y, int ld, int nrows, int c0, int nc, int slot) {
    float num = 0.f, den = 0.f;
    const size_t total = (size_t)nrows * nc;
    for (size_t i = (size_t)F.bid * NTHREADS + F.tid; i < total; i += (size_t)F.G * NTHREADS) {
        const size_t r = i / nc, c = c0 + i % nc; const float xv = bf2f(x[r * ld + c]), yv = bf2f(y[r * ld + c]);
        num += (xv - yv) * (xv - yv); den += yv * yv;
    }
    diag_add(a, slot, num, F.lane); diag_add(a, slot + 1, den, F.lane);
}
__device__ __forceinline__ void diag_cmp_f32(const Frame& F, const Args& a, const float* x, const float* y, size_t n, int slot) {
    float num = 0.f, den = 0.f;
    for (size_t i = (size_t)F.bid * NTHREADS + F.tid; i < n; i += (size_t)F.G * NTHREADS) { const float xv = x[i], yv = y[i]; num += (xv - yv) * (xv - yv); den += yv * yv; }
    diag_add(a, slot, num, F.lane); diag_add(a, slot + 1, den, F.lane);
}
constexpr int N_PHASES = 12;
#ifndef PROBE_TIME
#define PROBE_TIME 0
#endif
#ifndef PROBE_PH0
#define PROBE_PH0 0
#endif
#ifndef PROBE_XBAR
#define PROBE_XBAR 0
#endif
#ifndef PROBE_NSA2
#define PROBE_NSA2 0
#endif
#ifndef PROBE_SNSA
#define PROBE_SNSA 0
#endif
#ifndef PROBE_CMP
#define PROBE_CMP 0
#endif
#ifndef PROBE_MEM
#define PROBE_MEM 0
#endif
#ifndef PROBE_DN
#define PROBE_DN 0
#endif
template <int LO, int HI> __global__ void __launch_bounds__(NTHREADS, 2) fwd(Args a) {
    extern __shared__ __attribute__((aligned(16))) unsigned char lds_raw[];
    Frame F; F.lds = (LAS unsigned char*)lds_raw; F.tid = threadIdx.x; F.lane = F.tid & 63; F.wave = __builtin_amdgcn_readfirstlane(F.tid >> 6); F.G = gridDim.x; F.bid = blockIdx.x;
    volatile LAS unsigned* MISC = (volatile LAS unsigned*)(F.lds + MISC_OFF);
    for (int u = F.tid; u < (LDS_BYTES - MISC_OFF) / 4; u += NTHREADS) ((LAS unsigned*)(F.lds + MISC_OFF))[u] = 0u;
    __syncthreads();
    constexpr int lo = LO, hi = HI;
    unsigned* barw = (unsigned*)(a.ws + WS_CTL) + CW_BAR;
    XcdBarrier bar; bar.bar = barw; bar.x = 0; bar.st = nullptr;
    if (hi - lo > 1) bar = xcd_barrier_post(barw, MISC + 8);
#define IN(k) (lo <= (k) && (k) < hi)
#define REFRAME() do { int t_ = threadIdx.x; asm volatile("" : "+v"(t_)); F.tid = t_; F.lane = t_ & 63; F.wave = __builtin_amdgcn_readfirstlane(t_ >> 6); } while (0)
#if PROBE_TIME
#define STAMP(k) do { if (blockIdx.x == 0 && threadIdx.x == 0) ((unsigned long long*)(a.ws + WS_CTL + 65536))[k] = __builtin_amdgcn_s_memrealtime(); } while (0)
#else
#define STAMP(k) do { } while (0)
#endif
#define SEAM(k) do { if (IN(k) && IN((k) + 1)) xcd_barrier(bar); STAMP((k) + 1); } while (0)
    unsigned char* ws = a.ws;
    STAMP(0);

    if (IN(0)) { REFRAME(); p0_prologue(F, a); }
    SEAM(0);
    if (IN(1)) { REFRAME();
#define P1_COMPRESS() do { for (int u = F.bid; u < 256; u += F.G) cmp::unit<true>(a, F.lds, u >> 1, u & 1, 0, F.tid, (float*)(ws + WS_KCMP_S), (float*)(ws + WS_KCMP_P), 0); __syncthreads(); } while (0)
        if (F.bid & 1) P1_COMPRESS();
        { pg8::Gemm g{(const bf16*)(ws + WS_XB), (const bf16*)(ws + WS_WIN_T), MP, NPROJ_PAD, DM}; pg8::StaticOrder S; S.init(MP, NPROJ_PAD, F.G, F.bid);
          Epi<0> E{a.out, ws, a.in[I_XP], a.in[I_XS]};
          pg8::gemm_phase<Epi<0>, pg8::StaticOrder, true, true>(F.lds, g, S, E); }
        __syncthreads();
        { pg8::Gemm g{(const bf16*)(ws + WS_MB), (const bf16*)(ws + WS_WMKV_T), 1024, 2048, DM}; pg8::StaticOrder S; S.init(1024, 2048, F.G, (F.bid + F.G - 128) % F.G);
          Epi<1> E{a.out, ws, a.in[I_XP], a.in[I_XS]};
          pg8::gemm_phase<Epi<1>, pg8::StaticOrder, false, true>(F.lds, g, S, E); }
        __syncthreads();
        for (int u = F.bid - 160; u >= 0 && u < NPROJ_PAD / 16; u += 96) sg::unit<0, 8>(a, F.lds, (const bf16*)(ws + WS_XB), (const bf16*)(ws + WS_WIN_T), DM, u, F.tid);
        if (!(F.bid & 1)) { __syncthreads(); P1_COMPRESS(); }
    }
    SEAM(1);
    if (IN(2)) { REFRAME();
        const int pm = a.ph_hi;
        sample_copies(F, a);
        if ((pm & 1) && F.bid < F.G - 16) {
            const int NGW2 = (F.G - 16) * NWAVES;
            for (int it = F.bid * NWAVES + F.wave; it < DBATCH * 8; it += NGW2) sample_dn_wave(a, it >> 3, it & 7, F.lane);
        }
        if (pm & 2) vt_phase(F, a);
        if (F.bid < F.G - 16) { p1_late_transposes(F, a, F.bid * NWAVES + F.wave, (F.G - 16) * NWAVES); }
        __syncthreads();
#define P2_COMPRESS() do { if (pm & 4) { const int var = a.ph_lo; float* kcs = var ? (float*)(ws + WS_DBG) : (float*)(ws + WS_KCMP_S), *kcp = var ? (float*)(ws + WS_DBG2) : (float*)(ws + WS_KCMP_P); \
          if (F.bid >= F.G - 16) { const int v = F.bid - (F.G - 16); cmp::unit<false>(a, F.lds, v >> 2, (v >> 1) & 1, v & 1, F.tid, kcs, kcp, var); } \
          } } while (0)
#define P2_PREP() do { if (pm & 8) for (int u = F.bid; u < NB * NCHUNK; u += F.G) { \
            dn::prep_wave(a, F.lds + F.wave * 18432, u >> 6, u & 63, F.wave, F.lane); __syncthreads(); } } while (0)
        if (F.bid & 1) { P2_COMPRESS(); P2_PREP(); } else { P2_PREP(); P2_COMPRESS(); }
    }
    SEAM(3);
    if (IN(4)) { REFRAME();
        unsigned* ctr = (unsigned*)(ws + WS_CTL) + CW_WQ;
        LAS int* slot = (LAS int*)(F.lds + MISC_OFF + 64);
        for (;;) {
            __syncthreads();
            if (F.tid == 0) *slot = (int)atomicAdd(ctr, 1u);
            __syncthreads();
            const int it = *slot;
            if (it >= 800) break;
            if (it < a.ph_lo || it >= a.ph_hi) continue;
            if (it < 32) dn::scan_unit(a, F.lds, it >> 3, it & 7, F.tid, (bf16*)(ws + WS_MIX), a.out + O_PREC);
            else if (it < 32 + 256) { const int u = it - 32, qt = 63 - (u >> 3), bg = u & 7; nsa::unit(a, F.lds, bg >> 1, bg & 1, qt, (bf16*)(ws + WS_MIX), F.tid); }
            else if (it < 32 + 512) { const int u = it - 288; snsa::unit(a, F.lds, u >> 1, u & 1, F.tid, (bf16*)(ws + WS_MIX)); }
            else { const int u = it - 544 + 256, qt = 63 - (u >> 3), bg = u & 7; nsa::unit(a, F.lds, bg >> 1, bg & 1, qt, (bf16*)(ws + WS_MIX), F.tid); }
        }
    }
#if PROBE_NSA2
    if (IN(4)) { __syncthreads(); const int gw = F.bid * NWAVES + F.wave, NGW = F.G * NWAVES; LAS float* scr = (LAS float*)(F.lds + F.wave * 16384);
        for (int r = gw; r < DBATCH * 2; r += NGW) { const int tok = MP + (r >> 1), g = r & 1; nv_nsa_token(a, scr, false, tok - MP, g, PAST, tok, F.lane, (bf16*)(ws + WS_DBG)); } }
#endif
    SEAM(4);
#if PROBE_NSA2
    if (IN(5)) { diag_cmp_bf16(F, a, (const bf16*)(ws + WS_MIX) + (size_t)MP * DM, (const bf16*)(ws + WS_DBG) + (size_t)MP * DM, DM, DBATCH, 512, 512, 0); }
#endif
#if PROBE_SNSA
    if (IN(5)) { diag_cmp_bf16(F, a, (const bf16*)(ws + WS_DBG) + (size_t)MP * DM, (const bf16*)(ws + WS_MIX) + (size_t)MP * DM, DM, DBATCH, 512, 512, 0); }
#endif
#if PROBE_DN
    if (IN(5)) { REFRAME(); diag_cmp_bf16(F, a, (const bf16*)(ws + WS_DBG), (const bf16*)(ws + WS_MIX), DM, MP, 0, 512, 0);
                 diag_cmp_f32(F, a, (const float*)(ws + WS_DBG2), a.out + O_PREC, (size_t)NB * 8 * 4096, 2); }
#endif
    if (IN(5)) { REFRAME(); pg8::Gemm g{(const bf16*)(ws + WS_MIX), (const bf16*)(ws + WS_WOUT_T), MP, DM, DM}; pg8::StaticOrder S; S.init(MP, DM, F.G, F.bid);
        Epi<2> E{a.out, ws, a.in[I_XP], a.in[I_XS]}; pg8::gemm_phase<Epi<2>, pg8::StaticOrder, true, true>(F.lds, g, S, E);
        for (int u = F.G - 1 - F.bid; u < DM / 4; u += F.G) sg::unit<2, 2>(a, F.lds, (const bf16*)(ws + WS_MIX), (const bf16*)(ws + WS_WOUT_T), DM, u, F.tid); }
    SEAM(5);
    if (IN(6)) { REFRAME(); pg8::Gemm g{(const bf16*)(ws + WS_X1B), (const bf16*)(ws + WS_WMQ_T), MP, DM, DM}; pg8::StaticOrder S; S.init(MP, DM, F.G, F.bid);
        Epi<3> E{a.out, ws, a.in[I_XP], a.in[I_XS]}; pg8::gemm_phase<Epi<3>, pg8::StaticOrder, true, true>(F.lds, g, S, E);
        for (int u = F.G - 1 - F.bid; u < DM / 4; u += F.G) sg::unit<3, 2>(a, F.lds, (const bf16*)(ws + WS_X1B), (const bf16*)(ws + WS_WMQ_T), DM, u, F.tid); }
    SEAM(6);
    if (IN(7)) { REFRAME();
#if PROBE_MEM
        { const int gw = F.bid * NWAVES + F.wave, NGW = F.G * NWAVES; LAS float* scr = (LAS float*)(F.lds + F.wave * 16384);
          for (int it = gw; it < (MP + DBATCH) * 4; it += NGW) nv_mem_attn(a, scr, it >> 2, it & 3, F.lane); __syncthreads(); }
        bf16* OMp = (bf16*)(ws + WS_DBG);
#else
        bf16* OMp = (bf16*)(ws + WS_OM);
#endif
        if (F.bid & 1) for (int u = F.bid; u < 512; u += F.G) mem::sample_unit(a, F.lds, u >> 2, u & 3, F.tid, OMp);
        for (int u = F.bid; u < 512; u += F.G) mem::prompt_unit(a, F.lds, u >> 7, (u >> 5) & 3, u & 31, F.tid, OMp);
        if (!(F.bid & 1)) for (int u = F.bid; u < 512; u += F.G) mem::sample_unit(a, F.lds, u >> 2, u & 3, F.tid, OMp);
    }
    SEAM(7);
#if PROBE_MEM
    if (IN(8)) { diag_cmp_bf16(F, a, (const bf16*)(ws + WS_DBG), (const bf16*)(ws + WS_OM), DM, MP, 0, 1024, 0);
                 diag_cmp_bf16(F, a, (const bf16*)(ws + WS_DBG) + (size_t)MP * DM, (const bf16*)(ws + WS_OM) + (size_t)MP * DM, DM, DBATCH, 0, 1024, 2); }
#endif
    if (IN(8)) { REFRAME(); pg8::Gemm g{(const bf16*)(ws + WS_OM), (const bf16*)(ws + WS_WMO_T), MP, DM, DM}; pg8::StaticOrder S; S.init(MP, DM, F.G, F.bid);
        Epi<4> E{a.out, ws, a.in[I_XP], a.in[I_XS]}; pg8::gemm_phase<Epi<4>, pg8::StaticOrder, true, true>(F.lds, g, S, E);
        for (int u = F.G - 1 - F.bid; u < DM / 4; u += F.G) sg::unit<4, 2>(a, F.lds, (const bf16*)(ws + WS_OM), (const bf16*)(ws + WS_WMO_T), DM, u, F.tid); }
    SEAM(8);
    if (IN(9)) { REFRAME(); pg8::Gemm g{(const bf16*)(ws + WS_X2B), (const bf16*)(ws + WS_WUP_T), MP, DFF, DM}; pg8::StaticOrder S; S.init(MP, DFF, F.G, F.bid);
        Epi<5> E{a.out, ws, a.in[I_XP], a.in[I_XS]}; pg8::gemm_phase<Epi<5>, pg8::StaticOrder, true, true>(F.lds, g, S, E);
        for (int u = F.G - 1 - F.bid; u < DFF / 16; u += F.G) sg::unit<5, 8>(a, F.lds, (const bf16*)(ws + WS_X2B), (const bf16*)(ws + WS_WUP_T), DM, u, F.tid); }
    SEAM(9);
    if (IN(10)) { REFRAME(); pg8::Gemm g{(const bf16*)(ws + WS_UP), (const bf16*)(ws + WS_WDN_T), MP, DM, DFF}; pg8::StaticOrder S; S.init(MP, DM, F.G, F.bid);
        EpiFinal E{a.out, ws, a.in[I_LNF]}; pg8::gemm_phase<EpiFinal, pg8::StaticOrder, false, true>(F.lds, g, S, E);
        __syncthreads();
        for (int u = F.G - 1 - F.bid; u < DM / 4; u += F.G) sg::unit<6, 2>(a, F.lds, (const bf16*)(ws + WS_UP), (const bf16*)(ws + WS_WDN_T), DFF, u, F.tid); }
#if PROBE_NSA2
    if (hi - lo > 1) { xcd_barrier(bar);
        if (F.bid == 0) { const float* dg = diag_ptr(a); const float num = __hip_atomic_load(dg + 0, __ATOMIC_RELAXED, __HIP_MEMORY_SCOPE_AGENT), den = __hip_atomic_load(dg + 1, __ATOMIC_RELAXED, __HIP_MEMORY_SCOPE_AGENT);
            diag_emit_one(a, O_SWIN, 16000000, 1.f + 1e6f * num / fmaxf(den, 1e-30f), threadIdx.x);
            diag_emit_one(a, O_PNSA, 8000000, den, threadIdx.x); } }
#endif
#if PROBE_XBAR
    if (hi - lo > 1) for (int i = 0; i < PROBE_XBAR; ++i) xcd_barrier(bar);
#endif
#if PROBE_TIME
    xcd_barrier(bar); STAMP(12);
    if (blockIdx.x == 0) { __syncthreads();
        const unsigned long long* ts = (const unsigned long long*)(a.ws + WS_CTL + 65536);
        const size_t offs[11] = {O_YP, O_YS, O_PNSA, O_PWIN, O_PMEM, O_PCONV, O_PREC, O_SNSA, O_SWIN, O_SCONV, O_SREC};
        const size_t caps[11] = {16000000, 131000, 8000000, 524000, 2000000, 18000, 131000, 65000, 16000000, 589000, 4000000};
        const int PH[11] = {PROBE_PH0, PROBE_PH0 + 1, PROBE_PH0 + 2, PROBE_PH0 + 3, PROBE_PH0 + 4, PROBE_PH0 + 5, PROBE_PH0 + 6, PROBE_PH0 + 7, PROBE_PH0 + 8, PROBE_PH0 + 9, PROBE_PH0 + 10};
        for (int j = 0; j < 11; ++j) { const int ph = PH[j]; if (ph > 11) continue; const float us = (float)(ts[ph + 1] - ts[ph]) * 0.01f; diag_emit_one(a, offs[j], caps[j], us, threadIdx.x); } }
#endif
#undef IN
#undef SEAM
}

template <int LO, int HI> static bool launch_range(int& grid, const Args& a, hipStream_t stream) {
    static bool prepared = false;
    if (!prepared) { if (hipFuncSetAttribute((const void*)fwd<LO, HI>, hipFuncAttributeMaxDynamicSharedMemorySize, LDS_BYTES) != hipSuccess) { fprintf(stderr, "kernel_launch: hipFuncSetAttribute failed\n"); return false; } prepared = true; }
    hipLaunchKernelGGL((fwd<LO, HI>), dim3(grid), dim3(NTHREADS), LDS_BYTES, stream, a);
    return hipPeekAtLastError() == hipSuccess;
}
extern "C" void kernel_launch(void* const* d_in, const int* in_sizes, int n_in, void* d_out, int out_size, void* d_ws, size_t ws_size, hipStream_t stream) {
    static int grid = 0;
    if (grid == 0) {
        if (n_in != N_IN || (size_t)out_size != O_END || ws_size < WS_END) { fprintf(stderr, "kernel_launch: unexpected shapes n_in %d out %d ws %zu\n", n_in, out_size, ws_size); grid = -1; return; }
        int dev = 0, cus = 0;
        if (hipGetDevice(&dev) != hipSuccess || hipDeviceGetAttribute(&cus, hipDeviceAttributeMultiprocessorCount, dev) != hipSuccess) { grid = -1; return; }
        grid = cus < 256 ? cus : 256;
    }
    if (grid < 0) return;
    (void)hipMemsetAsync((char*)d_ws + WS_CTL, 0, CTL_ZERO_BYTES, stream);
    Args a{}; a.ph_lo = 0; a.ph_hi = 0xFFFF;
    for (int i = 0; i < N_IN; ++i) a.in[i] = (const float*)d_in[i];
    a.out = (float*)d_out; a.ws = (unsigned char*)d_ws;
#ifndef MK_ONE_LAUNCH
#define MK_ONE_LAUNCH 1
#endif
#if MK_ONE_LAUNCH
    launch_range<0, 12>(grid, a, stream);
#else
#ifndef PROBE_DUP
#define PROBE_DUP 0
#endif
#ifndef PROBE_WQLO
#define PROBE_WQLO 0
#define PROBE_WQHI 65535
#endif
#define LR(k) do { launch_range<k, k + 1>(grid, a, stream); if (PROBE_DUP & (1 << k)) { Args a2 = a; if (k == 2) { a2.ph_hi = PROBE_WQHI; a2.ph_lo = PROBE_WQLO; } if (k == 4) { (void)hipMemsetAsync((char*)d_ws + WS_CTL + CW_WQ * 4, 0, 4, stream); a2.ph_lo = PROBE_WQLO; a2.ph_hi = PROBE_WQHI; } launch_range<k, k + 1>(grid, a2, stream); } } while (0)
    LR(0); LR(1); LR(2); LR(3); LR(4); LR(5); LR(6); LR(7); LR(8); LR(9); LR(10); LR(11);
#endif
}
```

```cpp
#include <hip/hip_runtime.h>
#include <cstdio>
#include <cstdint>
#define LAS __attribute__((address_space(3)))
#define GAS __attribute__((address_space(1)))
namespace pg8 {
#define PG8_LAS __attribute__((address_space(3)))
typedef unsigned short bf16_t;
typedef short bf16x8 __attribute__((ext_vector_type(8)));
typedef float f32x4 __attribute__((ext_vector_type(4)));
typedef unsigned u32x4 __attribute__((ext_vector_type(4)));
constexpr int BM = 256, BK = 64, HALF = 128, HTB = HALF * BK * 2  , STAGE_BYTES = 8 * HTB, NXCD = 8, WGM = 8;

__host__ __device__ __forceinline__ int lds_byte(int r, int c) { const int st = (r >> 4) * 2 + (c >> 5), rr = r & 15, cc = c & 31, ob = rr * 64 + cc * 2; return st * 1024 + (ob ^ (((ob >> 9) & 1) << 5)); }
__host__ __device__ __forceinline__ void stage_rc(int b, int& R, int& C) { const int st = b / 1024, sb = b % 1024, swz = sb ^ (((sb >> 9) & 1) << 5); R = (st >> 1) * 16 + swz / 64; C = (st & 1) * 32 + (swz % 64) / 2; }
__host__ __device__ __forceinline__ int perm32(int rho) { const int n = rho >> 4, i = rho & 15; return 8 * (i >> 2) + 4 * n + (i & 3); }

struct Unit { int pm, pn; };
struct Gemm { const bf16_t* A; const bf16_t* Bt; int M, N, K; };

struct StaticOrder {
    int nM, nN, nwg, G, c;
    __host__ __device__ void init(int M, int N, int G_, int c_) { nM = M / BM; nN = N / BM; nwg = nM * nN; G = G_; c = c_; }
    __host__ __device__ __forceinline__ bool next(int i, Unit& u) const {
        const long L = (long)i * G + c; if (L >= nwg) return false;
        int wgid = (int)L; { const int q = nwg / NXCD, r = nwg % NXCD, xcd = wgid % NXCD, off = wgid / NXCD; wgid = (xcd < r ? xcd * (q + 1) : r * (q + 1) + (xcd - r) * q) + off; }
        const int nig = WGM * nN, gid = wgid / nig, fm = gid * WGM, gsz = (nM - fm) < WGM ? (nM - fm) : WGM;
        u.pm = fm + ((wgid % nig) % gsz); u.pn = (wgid % nig) / gsz; return true;
    }
    __device__ __forceinline__ void a_ready(const Unit&) const {}
    __device__ __forceinline__ void done(const Unit&) const {}
};

template <class Epi, class Sched, bool ALIGN_EPI = false, bool SP2 = false>
__device__ __forceinline__ void gemm_phase(PG8_LAS unsigned char* lds, const Gemm g, const Sched& S, const Epi& E) {
    int tid_o = threadIdx.x; asm volatile("" : "+v"(tid_o));
    const int tid = tid_o, wid = __builtin_amdgcn_readfirstlane(tid >> 6), lane = tid & 63, wr = wid >> 2, wc = wid & 3, fr = lane & 15, fq = lane >> 4;
    const int K = g.K, nt = K / BK;
    unsigned voffA[2], voffB[2];
#pragma unroll
    for (int i = 0; i < 2; ++i) { int R, C; stage_rc(tid * 16 + i * 8192, R, C); const int Rb = Epi::PERM ? ((R & ~31) + perm32(R & 31)) : R;
        voffA[i] = (unsigned)(R * K + C) * 2u; voffB[i] = (unsigned)(Rb * K + C) * 2u; }
    const size_t kstep = (size_t)(BK * 2);
    const size_t hstep = (size_t)HALF * K * 2;
    const size_t tstep = 2 * hstep;
    const unsigned ldsw = (unsigned)wid * 1024u;
    const int aoff = lds_byte(wr * 64 + fr, fq * 8), boff = lds_byte(wc * 32 + fr, fq * 8);
#define PG8_SA(b, h) (((b) * 2 + (h)) * HTB)
#define PG8_SB(b, h) ((4 + (b) * 2 + (h)) * HTB)
#define PG8_STAGE(bufoff, gbase, voff) do { _Pragma("unroll") for (int _i = 0; _i < 2; ++_i) \
        __builtin_amdgcn_global_load_lds((const unsigned*)((const char*)(gbase) + (voff)[_i]), (PG8_LAS unsigned*)(lds + (bufoff) + ldsw + _i * 8192), 16, 0, 0); } while (0)
#define PG8_LDA(dst, b, h) do { _Pragma("unroll") for (int m = 0; m < 4; ++m) _Pragma("unroll") for (int k = 0; k < 2; ++k) dst[m][k] = *(const PG8_LAS bf16x8*)(lds + PG8_SA(b, h) + aoff + m * 2048 + k * 1024); } while (0)
#define PG8_LDB(dst, b, h) do { _Pragma("unroll") for (int n = 0; n < 2; ++n) _Pragma("unroll") for (int k = 0; k < 2; ++k) dst[n][k] = *(const PG8_LAS bf16x8*)(lds + PG8_SB(b, h) + boff + n * 2048 + k * 1024); } while (0)
#define PG8_MMA(ai, bj, At, Bt) do { __builtin_amdgcn_s_setprio(1); _Pragma("unroll") for (int m = 0; m < 4; ++m) _Pragma("unroll") for (int n = 0; n < 2; ++n) _Pragma("unroll") for (int k = 0; k < 2; ++k) \
        acc[ai][bj][m][n] = __builtin_amdgcn_mfma_f32_16x16x32_bf16(Bt[n][k], At[m][k], acc[ai][bj][m][n], 0, 0, 0); __builtin_amdgcn_s_setprio(0); } while (0)
#define PG8_WAIT_V(n) asm volatile("s_waitcnt vmcnt(" #n ")" ::: "memory")
#define PG8_WAIT_L(n) asm volatile("s_waitcnt lgkmcnt(" #n ")" ::: "memory")
#define PG8_BAR __builtin_amdgcn_s_barrier()
#define PG8_SCHED __builtin_amdgcn_sched_barrier(0)
    Unit cur, nxt; int ui = 0;
    if (!S.next(0, cur)) return;
    f32x4 acc[2][2][4][2];
#pragma unroll
    for (int a = 0; a < 2; ++a)
#pragma unroll
        for (int b = 0; b < 2; ++b)
#pragma unroll
            for (int m = 0; m < 4; ++m)
#pragma unroll
                for (int n = 0; n < 2; ++n) acc[a][b][m][n] = (f32x4){0.f, 0.f, 0.f, 0.f};
    bf16x8 At[4][2], B0[2][2], B1[2][2];
    const char* cA = (const char*)g.A + (size_t)cur.pm * tstep; const char* cB = (const char*)g.Bt + (size_t)cur.pn * tstep;
    S.a_ready(cur);
    if constexpr (SP2) {
        PG8_STAGE(PG8_SB(0, 0), cB, voffB); PG8_STAGE(PG8_SB(0, 1), cB + hstep, voffB); PG8_STAGE(PG8_SA(0, 0), cA, voffA); PG8_STAGE(PG8_SA(0, 1), cA + hstep, voffA);
        if (wr == 1) PG8_BAR;
        PG8_WAIT_V(2); PG8_BAR;
        PG8_STAGE(PG8_SB(1, 0), cB + kstep, voffB); PG8_STAGE(PG8_SA(1, 0), cA + kstep, voffA); PG8_STAGE(PG8_SB(1, 1), cB + hstep + kstep, voffB);
        PG8_WAIT_V(6); PG8_BAR;
    } else {
        PG8_STAGE(PG8_SB(0, 0), cB, voffB); PG8_STAGE(PG8_SA(0, 0), cA, voffA); PG8_STAGE(PG8_SB(0, 1), cB + hstep, voffB); PG8_STAGE(PG8_SA(0, 1), cA + hstep, voffA);
        if (wr == 1) PG8_BAR;
        PG8_WAIT_V(4); PG8_BAR;
        PG8_STAGE(PG8_SB(1, 0), cB + kstep, voffB); PG8_STAGE(PG8_SA(1, 0), cA + kstep, voffA); PG8_STAGE(PG8_SB(1, 1), cB + hstep + kstep, voffB);
        PG8_WAIT_V(6); PG8_BAR;
    }
    for (;;) {
        const bool has_next = S.next(ui + 1, nxt);
        const char* nA = has_next ? (const char*)g.A + (size_t)nxt.pm * tstep : cA; const char* nB = has_next ? (const char*)g.Bt + (size_t)nxt.pn * tstep : cB;
        for (int t = 0; t < nt; t += 2) {
            const bool last = (t == nt - 2);
            const char* a1 = cA + (size_t)(t + 1) * kstep;
            const char* a2 = last ? nA : cA + (size_t)(t + 2) * kstep; const char* b2 = last ? nB : cB + (size_t)(t + 2) * kstep;
            const char* a3 = a2 + kstep; const char* b3 = b2 + kstep;
            if (last && has_next) S.a_ready(nxt);
            if constexpr (SP2) {
            PG8_LDB(B0, 0, 0); PG8_LDB(B1, 0, 1); PG8_SCHED; PG8_LDA(At, 0, 0); PG8_STAGE(PG8_SA(1, 1), a1 + hstep, voffA);
            PG8_WAIT_V(8); PG8_WAIT_L(0); PG8_BAR; PG8_MMA(0, 0, At, B0); PG8_MMA(0, 1, At, B1); PG8_BAR; PG8_SCHED;
            PG8_LDA(At, 0, 1); PG8_STAGE(PG8_SB(0, 0), b2, voffB); PG8_STAGE(PG8_SB(0, 1), b2 + hstep, voffB); PG8_STAGE(PG8_SA(0, 0), a2, voffA);
            PG8_WAIT_V(8); PG8_WAIT_L(0); PG8_BAR; PG8_MMA(1, 0, At, B0); PG8_MMA(1, 1, At, B1); PG8_BAR; PG8_SCHED;
            PG8_LDB(B0, 1, 0); PG8_LDB(B1, 1, 1); PG8_SCHED; PG8_LDA(At, 1, 0); PG8_STAGE(PG8_SA(0, 1), a2 + hstep, voffA);
            PG8_WAIT_V(8); PG8_WAIT_L(0); PG8_BAR; PG8_MMA(0, 0, At, B0); PG8_MMA(0, 1, At, B1); PG8_BAR; PG8_SCHED;
            PG8_LDA(At, 1, 1); PG8_STAGE(PG8_SB(1, 0), b3, voffB); PG8_STAGE(PG8_SB(1, 1), b3 + hstep, voffB); PG8_STAGE(PG8_SA(1, 0), a3, voffA);
            PG8_WAIT_V(8); PG8_WAIT_L(0); PG8_BAR; PG8_MMA(1, 0, At, B0); PG8_MMA(1, 1, At, B1); PG8_BAR; PG8_SCHED;
            } else {
            PG8_LDB(B0, 0, 0); PG8_SCHED; PG8_LDA(At, 0, 0); PG8_STAGE(PG8_SA(1, 1), a1 + hstep, voffA);
            PG8_WAIT_L(8); PG8_BAR; PG8_WAIT_L(0); PG8_MMA(0, 0, At, B0); PG8_BAR; PG8_SCHED;
            PG8_LDB(B1, 0, 1); PG8_STAGE(PG8_SB(0, 0), b2, voffB);
            PG8_BAR; PG8_WAIT_L(0); PG8_MMA(0, 1, At, B1); PG8_BAR;
            PG8_LDA(At, 0, 1); PG8_STAGE(PG8_SA(0, 0), a2, voffA);
            PG8_BAR; PG8_WAIT_L(0); PG8_MMA(1, 0, At, B0); PG8_BAR; PG8_SCHED;
            PG8_STAGE(PG8_SB(0, 1), b2 + hstep, voffB);
            PG8_WAIT_V(6); PG8_BAR; PG8_MMA(1, 1, At, B1); PG8_BAR;
            PG8_LDB(B0, 1, 0); PG8_SCHED; PG8_LDA(At, 1, 0); PG8_STAGE(PG8_SA(0, 1), a2 + hstep, voffA);
            PG8_WAIT_L(8); PG8_BAR; PG8_WAIT_L(0); PG8_MMA(0, 0, At, B0); PG8_BAR; PG8_SCHED;
            PG8_LDB(B1, 1, 1); PG8_STAGE(PG8_SB(1, 0), b3, voffB);
            PG8_BAR; PG8_WAIT_L(0); PG8_MMA(0, 1, At, B1); PG8_BAR;
            PG8_LDA(At, 1, 1); PG8_STAGE(PG8_SA(1, 0), a3, voffA);
            PG8_BAR; PG8_WAIT_L(0); PG8_MMA(1, 0, At, B0); PG8_BAR; PG8_SCHED;
            PG8_STAGE(PG8_SB(1, 1), b3 + hstep, voffB);
            PG8_WAIT_V(6); PG8_BAR; PG8_MMA(1, 1, At, B1); PG8_BAR;
            }
        }
        if constexpr (ALIGN_EPI) { if (wr == 0) PG8_BAR; }
        if constexpr (!Epi::AFTER_DRAIN) { E(acc, cur, wr, wc, fr, fq); S.done(cur); }
        if (!has_next) break;
#pragma unroll
        for (int a = 0; a < 2; ++a)
#pragma unroll
            for (int b = 0; b < 2; ++b)
#pragma unroll
                for (int m = 0; m < 4; ++m)
#pragma unroll
                    for (int n = 0; n < 2; ++n) acc[a][b][m][n] = (f32x4){0.f, 0.f, 0.f, 0.f};
        cur = nxt; cA = nA; cB = nB; ++ui;
        if constexpr (ALIGN_EPI) { if (wr == 1) PG8_BAR; }
    }
    PG8_WAIT_V(0);
    if constexpr (!ALIGN_EPI) { if (wr == 0) PG8_BAR; }
    PG8_BAR;
    if constexpr (Epi::AFTER_DRAIN) { E.fused(acc, cur, wr, wc, fr, fq, lds, wid, lane); S.done(cur); }
#undef PG8_SA
#undef PG8_SB
#undef PG8_STAGE
#undef PG8_LDA
#undef PG8_LDB
#undef PG8_MMA
#undef PG8_WAIT_V
#undef PG8_WAIT_L
#undef PG8_BAR
#undef PG8_SCHED
}
}
#define XB_TMO      128
#define XB_XCNT(j)  (256  + 64 * (j))
#define XB_XSUB(j)  (1280 + 64 * (j))
#define XB_XGEN(j)  (2304 + 64 * (j))
#define XB_TOP      3328
#define XB_TOPGEN   3392
#define XCD_BAR_WORDS 3456
#define XB_SPIN_CAP (1u << 18)

__device__ __forceinline__ unsigned xb_ld(unsigned* p)              { return __hip_atomic_load(p, __ATOMIC_RELAXED, __HIP_MEMORY_SCOPE_AGENT); }
__device__ __forceinline__ unsigned xb_add(unsigned* p, unsigned v) { return __hip_atomic_fetch_add(p, v, __ATOMIC_RELAXED, __HIP_MEMORY_SCOPE_AGENT); }
__device__ __forceinline__ unsigned xb_xcc_id() { return (unsigned)__builtin_amdgcn_s_getreg((3 << 11) | 20) & 0xFu; }
#define XB_SPIN(cond, bar) do { unsigned _sp = 0; while (cond) { __builtin_amdgcn_s_sleep(1); \
    if ((++_sp & 255u) == 0u) { if (xb_ld(&(bar)[XB_TMO])) break; if (_sp > XB_SPIN_CAP) { atomicAdd(&(bar)[XB_TMO], 1u); break; } } } } while (0)

struct XcdBarrier {
    unsigned* bar; unsigned x;
    volatile LAS unsigned* st;
};

__device__ __forceinline__ XcdBarrier xcd_barrier_post(unsigned* bar, volatile LAS unsigned* st) {
    XcdBarrier b; b.bar = bar; b.x = xb_xcc_id(); b.st = st;
    if (threadIdx.x == 0) (void)xb_add(&bar[XB_XCNT(b.x)], 1u);
    return b;
}
__device__ __forceinline__ void xcd_barrier_complete(unsigned* bar, unsigned x, unsigned& nloc, unsigned& nx) {
    const unsigned G = gridDim.x * gridDim.y * gridDim.z;
    unsigned sum, cnt, mine, sp = 0u;
    for (;;) {
        sum = 0u; cnt = 0u; mine = 0u;
#pragma unroll
        for (unsigned j = 0; j < 16; ++j) { const unsigned c = xb_ld(&bar[XB_XCNT(j)]); sum += c; cnt += (c > 0u) ? 1u : 0u; mine = (j == x) ? c : mine; }
        if (sum == G) break;
        __builtin_amdgcn_s_sleep(1);
        if ((++sp & 255u) == 0u) { if (xb_ld(&bar[XB_TMO])) break; if (sp > XB_SPIN_CAP) { atomicAdd(&bar[XB_TMO], 1u); break; } }
    }
    nloc = mine > 0u ? mine : 1u; nx = cnt > 0u ? cnt : 1u;
}

__device__ __forceinline__ void xcd_barrier(const XcdBarrier& b) {
    asm volatile("s_waitcnt vmcnt(0)" ::: "memory");
    __syncthreads();
    if (threadIdx.x == 0) {
        unsigned* bar = b.bar;
        __builtin_amdgcn_s_waitcnt(0);
        unsigned nloc = b.st[0], nx = b.st[1];
        if (nloc == 0u) { xcd_barrier_complete(bar, b.x, nloc, nx); b.st[0] = nloc; b.st[1] = nx; }
        const unsigned old = xb_add(&bar[XB_XSUB(b.x)], 1u);
        const unsigned gen = old / nloc;
        if (old + 1u == (gen + 1u) * nloc) {
            __builtin_amdgcn_fence(__ATOMIC_RELEASE, "agent");
            asm volatile("s_waitcnt vmcnt(0)" ::: "memory");
            const unsigned og = xb_add(&bar[XB_TOP], 1u);
            const unsigned tg = og / nx;
            if (og + 1u == (tg + 1u) * nx) xb_add(&bar[XB_TOPGEN], 1u);
            else XB_SPIN(xb_ld(&bar[XB_TOPGEN]) == tg, bar);
            __builtin_amdgcn_fence(__ATOMIC_ACQUIRE, "agent");
            xb_add(&bar[XB_XGEN(b.x)], 1u);
            asm volatile("s_waitcnt vmcnt(0)" ::: "memory");
        } else {
            XB_SPIN(xb_ld(&bar[XB_XGEN(b.x)]) == gen, bar);
            __builtin_amdgcn_fence(__ATOMIC_ACQUIRE, "agent");
            asm volatile("s_waitcnt vmcnt(0)" ::: "memory");
        }
    }
    __syncthreads();
}
constexpr int NWAVES = 8, NTHREADS = NWAVES * 64;
constexpr int DM = 1024, NB = 4, SEQ = 4096, MP = NB * SEQ;
constexpr int DBATCH = 128;
constexpr int MT = MP + 256;
constexpr int PAST = 2048, PAGE = 128, NPAGES = PAST / PAGE, NPHYS = 2560, WBUF = 512;
constexpr int HD = 64, NG = 2;
constexpr int C_QKV = 0, C_Z = 1536, C_B = 2048, C_A = 2056, C_NQ = 2064, C_NKV = 2576, C_WIN = 3088, C_G = 3344, NPROJ = 3368, NPROJ_PAD = 3584;
constexpr int DFF = 4096, MEMLEN = 256, MEMH = 4, MEMD = 256;
constexpr int NCHUNK = SEQ / 64;
constexpr float RMS_EPS = 1e-6f;

enum { I_XP = 0, I_XS, I_MEMP, I_CNSA, I_CWIN, I_CMEM, I_SCONV, I_SREC, I_PT, I_LNMIX, I_WIN, I_CONVW, I_ALOG, I_DTB, I_DNNORM, I_PE, I_W1, I_B1, I_W2,
       I_WOUT, I_LNMEM, I_LNMEMKV, I_WMQ, I_WMKV, I_WMO, I_LNFFN, I_WUP, I_WDN, I_LNF, N_IN };
constexpr size_t O_YP = 0, O_YS = O_YP + (size_t)MP * DM, O_PNSA = O_YS + (size_t)DBATCH * DM, O_PWIN = O_PNSA + (size_t)MP * 512,
                 O_PMEM = O_PWIN + (size_t)NB * 512 * 256, O_PCONV = O_PMEM + (size_t)NB * MEMLEN * 2048, O_PREC = O_PCONV + (size_t)NB * 3 * 1536,
                 O_SNSA = O_PREC + (size_t)NB * 8 * 4096, O_SWIN = O_SNSA + (size_t)DBATCH * 512, O_SCONV = O_SWIN + (size_t)DBATCH * 512 * 256,
                 O_SREC = O_SCONV + (size_t)DBATCH * 3 * 1536, O_END = O_SREC + (size_t)DBATCH * 8 * 4096;
static_assert(O_END == 49694720, "output map");

constexpr size_t MiB = 1u << 20;
constexpr size_t WS_CTL = 0, CTL_ZERO_BYTES = 160 * 1024;
constexpr size_t WS_WIN_T = 2 * MiB;
constexpr size_t WS_WOUT_T = 10 * MiB;
constexpr size_t WS_WMQ_T = 12 * MiB;
constexpr size_t WS_WMKV_T = 14 * MiB;
constexpr size_t WS_WMO_T = 18 * MiB;
constexpr size_t WS_WUP_T = 20 * MiB;
constexpr size_t WS_WDN_T = 28 * MiB;
constexpr size_t WS_W1_T = 36 * MiB;
constexpr size_t WS_SSQ0 = 38 * MiB;
constexpr size_t WS_SSQM = WS_SSQ0 + 128 * 1024;
constexpr size_t WS_PEB = WS_SSQM + 64 * 1024;
constexpr size_t WS_SSQ1 = 40 * MiB, WS_SSQ2 = 42 * MiB, WS_SSQ3 = 44 * MiB;
constexpr size_t WS_SSQS1 = 45 * MiB, WS_SSQS2 = WS_SSQS1 + 65536, WS_SSQS3 = WS_SSQS2 + 65536;
constexpr size_t WS_BA = 46 * MiB;
constexpr size_t WS_GL = 48 * MiB;
constexpr size_t WS_KCMP_P = 50 * MiB;
constexpr size_t WS_KCMP_S = 52 * MiB;
constexpr size_t WS_XB = 64 * MiB;
constexpr size_t WS_MB = 98 * MiB;
constexpr size_t WS_MEMKV = 100 * MiB;
constexpr size_t WS_PROJ = 104 * MiB;
constexpr size_t WS_MIX = 220 * MiB;
constexpr size_t WS_X1 = 256 * MiB;
constexpr size_t WS_YB = WS_X1;
constexpr size_t WS_X1B = 322 * MiB;
constexpr size_t WS_QM = 356 * MiB;
constexpr size_t WS_OM = 390 * MiB;
constexpr size_t WS_X2 = 424 * MiB;
constexpr size_t WS_X2B = 490 * MiB;
constexpr size_t WS_UP = 524 * MiB;
constexpr size_t WS_DN = 656 * MiB;
constexpr size_t WS_GLAST = 740 * MiB;
constexpr size_t WS_ODN = 744 * MiB;
constexpr size_t WS_QKVN = 768 * MiB;
constexpr size_t WS_BG = 872 * MiB;
constexpr size_t WS_WINF = 876 * MiB;
constexpr size_t WS_DBG = 896 * MiB;
constexpr size_t WS_QKVB = 932 * MiB;
constexpr size_t WS_DBG2 = 984 * MiB;
constexpr size_t WS_VTG = 992 * MiB;
constexpr size_t WS_MVT = 1002 * MiB;
constexpr size_t WS_END = 1006 * MiB;
static_assert(WS_XB + (size_t)MT * DM * 2 <= WS_MB && WS_PROJ + (size_t)MT * NPROJ_PAD * 2 <= WS_MIX && WS_MIX + (size_t)MT * DM * 2 <= WS_X1 &&
              WS_X1 + (size_t)MT * DM * 4 <= WS_X1B && WS_X2 + (size_t)MT * DM * 4 <= WS_X2B && WS_UP + (size_t)MT * DFF * 2 <= WS_DN &&
              WS_DN + (size_t)2048 * 5 * 4096 * 2 <= WS_GLAST && WS_ODN + (size_t)MP * 512 * 2 <= WS_QKVN && WS_QKVN + (size_t)MT * 1536 * 4 <= WS_BG && WS_BG + (size_t)MT * 64 <= WS_WINF && WS_WINF + (size_t)MP * 1024 <= WS_END, "ws map");
constexpr int CW_WQ = 12288;
constexpr int CW_PANEL = 32768;
constexpr int CW_BAR = 4096;
static_assert((size_t)(CW_PANEL + 64 * 65) * 4 <= CTL_ZERO_BYTES, "every control word lies inside the per-call memset");

constexpr int RING_BYTES = 131072;
constexpr int MISC_OFF = 147456;
constexpr int LDS_BYTES = 147456 + 1024;

typedef unsigned short bf16;
typedef unsigned v4u __attribute__((ext_vector_type(4)));
typedef unsigned v2u __attribute__((ext_vector_type(2)));
typedef float f32x2 __attribute__((ext_vector_type(2)));
typedef float f32x4 __attribute__((ext_vector_type(4)));
typedef float f32x16 __attribute__((ext_vector_type(16)));
typedef short bf16x8 __attribute__((ext_vector_type(8)));
typedef short bf16x4 __attribute__((ext_vector_type(4)));
typedef __bf16 hbf2 __attribute__((ext_vector_type(2)));
#define LDS_WAIT() asm volatile("s_waitcnt lgkmcnt(0)" ::: "memory")
#define VM_WAIT() asm volatile("s_waitcnt vmcnt(0)" ::: "memory")
#define BAR_LDS() do { asm volatile("s_waitcnt lgkmcnt(0)" ::: "memory"); __builtin_amdgcn_s_barrier(); asm volatile("" ::: "memory"); } while (0)
__device__ __forceinline__ unsigned pk2(float lo, float hi) { return __builtin_bit_cast(unsigned, __builtin_convertvector((f32x2){lo, hi}, hbf2)); }
__device__ __forceinline__ float bflo(unsigned u) { return __uint_as_float(u << 16); }
__device__ __forceinline__ float bfhi(unsigned u) { return __uint_as_float(u & 0xffff0000u); }
__device__ __forceinline__ float bf2f(bf16 b) { return __uint_as_float((unsigned)b << 16); }
template <int CTRL, int ROWMASK = 0xF> __device__ __forceinline__ float dpp_add(float v) {
    return v + __builtin_bit_cast(float, __builtin_amdgcn_update_dpp(0, __builtin_bit_cast(int, v), CTRL, ROWMASK, 0xF, true));
}
__device__ __forceinline__ float row16_sum(float v) {
    v = dpp_add<0xB1>(v); v = dpp_add<0x4E>(v); v = dpp_add<0x124>(v); v = dpp_add<0x128>(v); return v;
}
__device__ __forceinline__ float wave_sum(float v) {
    v = row16_sum(v);
    v = dpp_add<0x142, 0xA>(v);
    v = dpp_add<0x143, 0xC>(v);
    return __builtin_bit_cast(float, __builtin_amdgcn_readlane(__builtin_bit_cast(int, v), 63));
}
__device__ __forceinline__ float fast_exp2(float x) { return __builtin_amdgcn_exp2f(x); }
__device__ __forceinline__ float fast_rcp(float x) { return __builtin_amdgcn_rcpf(x); }
__device__ __forceinline__ f32x4 ld_nt(const float* p) { return __builtin_nontemporal_load((const f32x4*)p); }
__device__ __forceinline__ void st_nt(float* p, f32x4 v) { __builtin_nontemporal_store(v, (f32x4*)p); }
#define MFMA32(a, b, c) __builtin_amdgcn_mfma_f32_32x32x16_bf16((a), (b), (c), 0, 0, 0)
#define MFMA16(a, b, c) __builtin_amdgcn_mfma_f32_16x16x32_bf16((a), (b), (c), 0, 0, 0)

struct Args { const float* in[N_IN]; float* out; unsigned char* ws; int ph_lo, ph_hi; };
struct Frame {
    LAS unsigned char* lds;
    int tid, lane, wave;
    int G, bid;
};
__device__ __forceinline__ void p0_transpose_item(const float* W, int K, int N, const float* gain, bf16* WT, LAS float* scr, int nblk, int item, int lane) {
    const int kb = item / nblk, nb = item % nblk, k0 = 64 * kb, n0 = 32 * nb;
    const int n4 = n0 + 4 * (lane & 7);
#pragma unroll
    for (int i = 0; i < 8; ++i) { const int kk = 8 * i + (lane >> 3);
        f32x4 v = (n4 < N) ? ld_nt(W + (size_t)(k0 + kk) * N + n4) : (f32x4){0.f, 0.f, 0.f, 0.f};
        if (gain) v = v * gain[k0 + kk];
        LAS float* d = scr + kk * 33 + 4 * (lane & 7); d[0] = v.x; d[1] = v.y; d[2] = v.z; d[3] = v.w; }
    LDS_WAIT(); asm volatile("" ::: "memory");
    const int c = lane & 7;
#pragma unroll
    for (int j = 0; j < 4; ++j) { const int nn = (lane >> 3) + 8 * j; const LAS float* s = scr + (8 * c) * 33 + nn;
        v4u o; o.x = pk2(s[0 * 33], s[1 * 33]); o.y = pk2(s[2 * 33], s[3 * 33]); o.z = pk2(s[4 * 33], s[5 * 33]); o.w = pk2(s[6 * 33], s[7 * 33]);
        *(GAS v4u*)(WT + (size_t)(n0 + nn) * K + k0 + 8 * c) = o; }
    LDS_WAIT(); asm volatile("" ::: "memory");
}
__device__ __forceinline__ void p0_row(const float* src, bf16* dst, float* ssq, int lane) {
    f32x4 v[4]; float s = 0.f;
#pragma unroll
    for (int j = 0; j < 4; ++j) { v[j] = src ? ld_nt(src + 4 * (lane + 64 * j)) : (f32x4){0.f, 0.f, 0.f, 0.f}; s += (v[j].x * v[j].x + v[j].y * v[j].y) + (v[j].z * v[j].z + v[j].w * v[j].w); }
    s = wave_sum(s);
    GAS v2u* o8 = (GAS v2u*)dst + lane;
#pragma unroll
    for (int j = 0; j < 4; ++j) { v2u w; w.x = pk2(v[j].x, v[j].y); w.y = pk2(v[j].z, v[j].w); o8[64 * j] = w; }
    if (lane == 0) *ssq = s;
}
__device__ __forceinline__ void p0_prologue(const Frame& F, const Args& a) {
    LAS float* scr = (LAS float*)(F.lds + F.wave * 16384);
    const int gw = F.bid * NWAVES + F.wave, NGW = F.G * NWAVES;
    unsigned char* ws = a.ws;
    constexpr int I0 = 16 * 112, I3 = 16 * 64, I7 = 64 * 4, I8 = 64 * 4;
    constexpr int NITEMS = I0 + I3 + I7 + I8;
    for (int it = gw; it < NITEMS; it += NGW) {
        int r = it;
        if (r < I0) { p0_transpose_item(a.in[I_WIN], 1024, NPROJ, a.in[I_LNMIX], (bf16*)(ws + WS_WIN_T), scr, 112, r, F.lane); continue; } r -= I0;
        if (r < I3) { p0_transpose_item(a.in[I_WMKV], 1024, 2048, a.in[I_LNMEMKV], (bf16*)(ws + WS_WMKV_T), scr, 64, r, F.lane); continue; } r -= I3;
        if (r < I7) { p0_transpose_item(a.in[I_W1], 4096, 128, nullptr, (bf16*)(ws + WS_W1_T), scr, 4, r, F.lane); continue; } r -= I7;
        p0_transpose_item(a.in[I_W1] + (size_t)4096 * 128, 4096, 128, nullptr, (bf16*)(ws + WS_W1_T) + (size_t)128 * 4096, scr, 4, r, F.lane);
    }
    {
        auto rowsrc = [&](int m) -> const float* { return (m < MP) ? a.in[I_XP] + (size_t)m * DM : (m < MP + DBATCH) ? a.in[I_XS] + (size_t)(m - MP) * DM : (m < MT) ? nullptr : a.in[I_MEMP] + (size_t)(m - MT) * DM; };
        f32x4 cur[4], nxt[4];
        int m = gw;
        if (m < MT + 1024) { const float* src = rowsrc(m);
#pragma unroll
            for (int j = 0; j < 4; ++j) cur[j] = src ? ld_nt(src + 4 * (F.lane + 64 * j)) : (f32x4){0.f, 0.f, 0.f, 0.f}; }
        for (; m < MT + 1024; m += NGW) {
            const int mn = m + NGW;
            if (mn < MT + 1024) { const float* src = rowsrc(mn);
#pragma unroll
                for (int j = 0; j < 4; ++j) nxt[j] = src ? ld_nt(src + 4 * (F.lane + 64 * j)) : (f32x4){0.f, 0.f, 0.f, 0.f}; }
            float s = 0.f;
#pragma unroll
            for (int j = 0; j < 4; ++j) s += (cur[j].x * cur[j].x + cur[j].y * cur[j].y) + (cur[j].z * cur[j].z + cur[j].w * cur[j].w);
            s = wave_sum(s);
            bf16* dst = (m < MT) ? (bf16*)(ws + WS_XB) + (size_t)m * DM : (bf16*)(ws + WS_MB) + (size_t)(m - MT) * DM;
            GAS v2u* o8 = (GAS v2u*)dst + F.lane;
#pragma unroll
            for (int j = 0; j < 4; ++j) { v2u w; w.x = pk2(cur[j].x, cur[j].y); w.y = pk2(cur[j].z, cur[j].w); o8[64 * j] = w; }
            if (F.lane == 0) { if (m < MT) ((float*)(ws + WS_SSQ0))[m] = s; else ((float*)(ws + WS_SSQM))[m - MT] = s; }
#pragma unroll
            for (int j = 0; j < 4; ++j) cur[j] = nxt[j];
        }
    }
    if (F.wave == 7) for (int it = F.bid; it < 64; it += F.G) {
        const int kr = it >> 1, kind = it & 1; const float* w1 = a.in[I_W1] + (size_t)kind * 4096 * 128; const float* pe = a.in[I_PE] + (size_t)kind * 4096;
        float s0 = 0.f, s1 = 0.f;
#pragma unroll 32
        for (int k = kr * 128; k < kr * 128 + 128; ++k) { const float p = pe[k]; s0 += p * w1[(size_t)k * 128 + F.lane]; s1 += p * w1[(size_t)k * 128 + 64 + F.lane]; }
        float* o = (float*)(ws + WS_PEB) + kr * 256 + kind * 128; o[F.lane] = s0; o[64 + F.lane] = s1;
    }
}
__device__ __forceinline__ void p1_late_transposes(const Frame& F, const Args& a, int gw, int NGW) {
    LAS float* scr = (LAS float*)(F.lds + F.wave * 16384);
    unsigned char* ws = a.ws;
    constexpr int I1 = 16 * 32, I2 = 16 * 32, I4 = 16 * 32, I5 = 16 * 128, I6 = 64 * 32;
    constexpr int NITEMS = I1 + I2 + I4 + I5 + I6;
    for (int it = gw; it < NITEMS; it += NGW) {
        int r = it;
        if (r < I1) { p0_transpose_item(a.in[I_WOUT], 1024, 1024, nullptr, (bf16*)(ws + WS_WOUT_T), scr, 32, r, F.lane); continue; } r -= I1;
        if (r < I2) { p0_transpose_item(a.in[I_WMQ], 1024, 1024, a.in[I_LNMEM], (bf16*)(ws + WS_WMQ_T), scr, 32, r, F.lane); continue; } r -= I2;
        if (r < I4) { p0_transpose_item(a.in[I_WMO], 1024, 1024, nullptr, (bf16*)(ws + WS_WMO_T), scr, 32, r, F.lane); continue; } r -= I4;
        if (r < I5) { p0_transpose_item(a.in[I_WUP], 1024, 4096, a.in[I_LNFFN], (bf16*)(ws + WS_WUP_T), scr, 128, r, F.lane); continue; } r -= I5;
        p0_transpose_item(a.in[I_WDN], 4096, 1024, nullptr, (bf16*)(ws + WS_WDN_T), scr, 32, r, F.lane);
    }
}
struct SubOrder {
    pg8::StaticOrder b; int from, add;
    __host__ __device__ void init(int M, int ntiles, int G, int c, int from_, int add_) { b.init(M, ntiles * 256, G, c); from = from_; add = add_; }
    __host__ __device__ __forceinline__ bool next(int i, pg8::Unit& u) const { if (!b.next(i, u)) return false; if (u.pn >= from) u.pn += add; return true; }
    __device__ __forceinline__ void a_ready(const pg8::Unit&) const {}
    __device__ __forceinline__ void done(const pg8::Unit&) const {}
};
template <int MODE> struct Epi {
    static constexpr bool PERM = true, AFTER_DRAIN = false;
    float* out; unsigned char* ws; const float* xp; const float* xs;
    __device__ __forceinline__ static float rstd16(const float* p) {
        const f32x4 a = ((const f32x4*)p)[0], b = ((const f32x4*)p)[1], c = ((const f32x4*)p)[2], d = ((const f32x4*)p)[3];
        const float s = ((a.x + a.y) + (a.z + a.w)) + ((b.x + b.y) + (b.z + b.w)) + ((c.x + c.y) + (c.z + c.w)) + ((d.x + d.y) + (d.z + d.w));
        return rsqrtf(s * (1.f / 1024.f) + RMS_EPS);
    }
    __device__ __forceinline__ void operator()(const pg8::f32x4 (&acc)[2][2][4][2], const pg8::Unit& u, int wr, int wc, int fr, int fq) const {
        const int rbase = u.pm * 256 + wr * 64 + fr, cbase = u.pn * 256 + wc * 32 + 8 * fq;
#pragma unroll
        for (int ai = 0; ai < 2; ++ai)
#pragma unroll
            for (int m = 0; m < 4; ++m) {
                const int row = rbase + ai * 128 + m * 16;
                const bool isP = row < MP, isS = !isP && row < MP + DBATCH; const int sidx = row - MP;
                float rs = 1.f;
                if (MODE == 0) rs = rsqrtf(((const float*)(ws + WS_SSQ0))[row] * (1.f / 1024.f) + RMS_EPS);
                if (MODE == 1) rs = rsqrtf(((const float*)(ws + WS_SSQM))[row] * (1.f / 1024.f) + RMS_EPS);
                if (MODE == 3) rs = rstd16((const float*)(ws + WS_SSQ1) + (size_t)row * 16);
                if (MODE == 5) rs = rstd16((const float*)(ws + WS_SSQ2) + (size_t)row * 16);
                float ssq = 0.f;
#pragma unroll
                for (int bj = 0; bj < 2; ++bj) {
                    const int col = cbase + bj * 128;
                    f32x4 v0 = acc[ai][bj][m][0], v1 = acc[ai][bj][m][1];
                    if (MODE == 0) {
                        v0 = v0 * rs; v1 = v1 * rs;
                        if (col < C_B || (col >= C_NQ && col < C_G)) {
                            v4u w; w.x = pk2(v0.x, v0.y); w.y = pk2(v0.z, v0.w); w.z = pk2(v1.x, v1.y); w.w = pk2(v1.z, v1.w);
                            *(v4u*)((bf16*)(ws + WS_PROJ) + (size_t)row * NPROJ_PAD + col) = w; }
                        float* dst = nullptr;
                        if (col < C_Z) {
                            if (isP) { const int t = row & (SEQ - 1); if (t >= SEQ - 3) dst = out + O_PCONV + (size_t)((row >> 12) * 3 + (t - (SEQ - 3))) * 1536 + col; }
                            else if (isS) dst = out + O_SCONV + (size_t)(sidx * 3 + 2) * 1536 + col;
                        } else if (col >= C_B && col < C_NQ) { dst = (float*)(ws + WS_BA) + (size_t)row * 16 + (col - C_B); }
                        else if (col >= C_NKV && col < C_WIN) {
                            if (isP) dst = out + O_PNSA + (size_t)row * 512 + (col - C_NKV);
                            else if (isS) dst = out + O_SNSA + (size_t)sidx * 512 + (col - C_NKV);
                        } else if (col >= C_WIN && col < C_G) {
                            if (isP) { const int t = row & (SEQ - 1); if (t >= SEQ - 512) dst = out + O_PWIN + (size_t)((row >> 12) * 512 + (t - (SEQ - 512))) * 256 + (col - C_WIN); }
                            else if (isS) dst = out + O_SWIN + (size_t)(sidx * 512 + 511) * 256 + (col - C_WIN);
                        } else if (col >= C_G && col < NPROJ) { dst = (float*)(ws + WS_GL) + (size_t)row * 24 + (col - C_G); }
                        if (dst) { st_nt(dst, v0); st_nt(dst + 4, v1); }
                    } else if (MODE == 1) {
                        v0 = v0 * rs; v1 = v1 * rs;
                        float* dst = out + O_PMEM + (size_t)row * 2048 + col; st_nt(dst, v0); st_nt(dst + 4, v1);
                        v4u w; w.x = pk2(v0.x, v0.y); w.y = pk2(v0.z, v0.w); w.z = pk2(v1.x, v1.y); w.w = pk2(v1.z, v1.w);
                        *(v4u*)((bf16*)(ws + WS_MEMKV) + (size_t)row * 2048 + col) = w;
                    } else if (MODE == 2 || MODE == 4 || MODE == 6) {
                        const bf16* res = (const bf16*)(ws + (MODE == 2 ? WS_XB : MODE == 4 ? WS_X1B : WS_X2B)) + (size_t)row * DM + col;
                        const v4u rw = *(const v4u*)res;
                        v0 = v0 + (f32x4){bflo(rw.x), bfhi(rw.x), bflo(rw.y), bfhi(rw.y)}; v1 = v1 + (f32x4){bflo(rw.z), bfhi(rw.z), bflo(rw.w), bfhi(rw.w)};
                        ssq += ((v0.x * v0.x + v0.y * v0.y) + (v0.z * v0.z + v0.w * v0.w)) + ((v1.x * v1.x + v1.y * v1.y) + (v1.z * v1.z + v1.w * v1.w));
                        v4u w; w.x = pk2(v0.x, v0.y); w.y = pk2(v0.z, v0.w); w.z = pk2(v1.x, v1.y); w.w = pk2(v1.z, v1.w);
                        *(v4u*)((bf16*)(ws + (MODE == 2 ? WS_X1B : MODE == 4 ? WS_X2B : WS_YB)) + (size_t)row * DM + col) = w;
                    } else if (MODE == 3) {
                        v0 = v0 * rs; v1 = v1 * rs;
                        v4u w; w.x = pk2(v0.x, v0.y); w.y = pk2(v0.z, v0.w); w.z = pk2(v1.x, v1.y); w.w = pk2(v1.z, v1.w);
                        *(v4u*)((bf16*)(ws + WS_QM) + (size_t)row * DM + col) = w;
                    } else if (MODE == 5) {
                        v0 = v0 * rs; v1 = v1 * rs;
#pragma unroll
                        for (int e = 0; e < 4; ++e) { const float p = fmaxf(v0[e], 0.f), q = fmaxf(v1[e], 0.f); v0[e] = p * p; v1[e] = q * q; }
                        v4u w; w.x = pk2(v0.x, v0.y); w.y = pk2(v0.z, v0.w); w.z = pk2(v1.x, v1.y); w.w = pk2(v1.z, v1.w);
                        *(v4u*)((bf16*)(ws + WS_UP) + (size_t)row * DFF + col) = w;
                    }
                }
                if (MODE == 2 || MODE == 4 || MODE == 6) {
                    ssq += __shfl_xor(ssq, 16); ssq += __shfl_xor(ssq, 32);
                    if (fq == 0) ((float*)(ws + (MODE == 2 ? WS_SSQ1 : MODE == 4 ? WS_SSQ2 : WS_SSQ3)))[(size_t)row * 16 + u.pn * 4 + wc] = ssq;
                }
            }
    }
};

struct EpiFinal {
    static constexpr bool PERM = true, AFTER_DRAIN = true;
    float* out; unsigned char* ws; const float* lnf;
    __device__ __forceinline__ void fused(pg8::f32x4 (&acc)[2][2][4][2], const pg8::Unit& u, int wr, int wc, int fr, int fq, PG8_LAS unsigned char* lds, int wid, int lane) const {
        const int rbase = u.pm * 256 + wr * 64 + fr, cbase = u.pn * 256 + wc * 32 + 8 * fq;
        float* SSQ = (float*)(ws + WS_SSQ3);
#pragma unroll
        for (int ai = 0; ai < 2; ++ai)
#pragma unroll
            for (int m = 0; m < 4; ++m) {
                const int row = rbase + ai * 128 + m * 16; float ssq = 0.f;
#pragma unroll
                for (int bj = 0; bj < 2; ++bj) {
                    const v4u rw = *(const v4u*)((const bf16*)(ws + WS_X2B) + (size_t)row * DM + cbase + bj * 128);
                    f32x4& v0 = acc[ai][bj][m][0]; f32x4& v1 = acc[ai][bj][m][1];
                    v0 = v0 + (f32x4){bflo(rw.x), bfhi(rw.x), bflo(rw.y), bfhi(rw.y)}; v1 = v1 + (f32x4){bflo(rw.z), bfhi(rw.z), bflo(rw.w), bfhi(rw.w)};
                    ssq += ((v0.x * v0.x + v0.y * v0.y) + (v0.z * v0.z + v0.w * v0.w)) + ((v1.x * v1.x + v1.y * v1.y) + (v1.z * v1.z + v1.w * v1.w));
                }
                ssq += __shfl_xor(ssq, 16); ssq += __shfl_xor(ssq, 32);
                if (fq == 0) __hip_atomic_store(SSQ + (size_t)row * 16 + u.pn * 4 + wc, ssq, __ATOMIC_RELAXED, __HIP_MEMORY_SCOPE_AGENT);
            }
        asm volatile("s_waitcnt vmcnt(0)" ::: "memory");
        __syncthreads();
        unsigned* cnt = (unsigned*)(ws + WS_CTL) + CW_PANEL + 64 * u.pm;
        if (threadIdx.x == 0) {
            __hip_atomic_fetch_add(cnt, 1u, __ATOMIC_RELAXED, __HIP_MEMORY_SCOPE_AGENT);
            unsigned sp = 0;
            while (__hip_atomic_load(cnt, __ATOMIC_RELAXED, __HIP_MEMORY_SCOPE_AGENT) < 4u && ++sp < (1u << 21)) __builtin_amdgcn_s_sleep(2);
        }
        __syncthreads();
        __builtin_amdgcn_fence(__ATOMIC_ACQUIRE, "agent");
        asm volatile("s_waitcnt vmcnt(0)" ::: "memory");
#pragma unroll
        for (int ai = 0; ai < 2; ++ai)
#pragma unroll
            for (int m = 0; m < 4; ++m) {
                const int row = rbase + ai * 128 + m * 16;
                const float rs = Epi<3>::rstd16(SSQ + (size_t)row * 16);
#pragma unroll
                for (int bj = 0; bj < 2; ++bj) {
                    const int col = cbase + bj * 128;
                    const f32x4 g0 = ((const f32x4*)(lnf + col))[0], g1 = ((const f32x4*)(lnf + col))[1];
                    float* dst = out + O_YP + (size_t)row * DM + col;
                    st_nt(dst, acc[ai][bj][m][0] * rs * g0); st_nt(dst + 4, acc[ai][bj][m][1] * rs * g1);
                }
            }
    }
};
namespace sg {
template <int MODE, int NMT  > __device__ __forceinline__ void unit(const Args& a, LAS unsigned char* lds, const bf16* A, const bf16* Bt, int K, int uidx, int tid) {
    const int ct = NMT == 8 ? uidx : uidx >> 2, qr = NMT == 8 ? 0 : uidx & 3;
    unsigned char* ws = a.ws; float* out = a.out;
    asm volatile("" : "+v"(tid));
    const int lane = tid & 63, wave = __builtin_amdgcn_readfirstlane(tid >> 6), fr = lane & 15, fq = lane >> 4;
    const int kw = K >> 3;
    const bf16* ap = A + (size_t)(MP + 32 * qr + fr) * K + wave * kw + 8 * fq;
    const bf16* bp = Bt + (size_t)(16 * ct + fr) * K + wave * kw + 8 * fq;
    f32x4 acc[NMT];
#pragma unroll
    for (int i = 0; i < NMT; ++i) acc[i] = (f32x4){0.f, 0.f, 0.f, 0.f};
#pragma unroll 4
    for (int k = 0; k < kw; k += 32) {
        const bf16x8 bf = *(const GAS bf16x8*)(bp + k);
#pragma unroll
        for (int mi = 0; mi < NMT; ++mi) acc[mi] = MFMA16(*(const GAS bf16x8*)(ap + (size_t)mi * 16 * K + k), bf, acc[mi]);
    }
    LAS float* RED = (LAS float*)lds;
#pragma unroll
    for (int mi = 0; mi < NMT; ++mi)
#pragma unroll
        for (int r = 0; r < 4; ++r) RED[wave * (NMT * 256) + (16 * mi + 4 * fq + r) * 16 + fr] = acc[mi][r];
    LAS float* RS = (LAS float*)(lds + 65536 + 1024);
    if (MODE == 3 || MODE == 5) {
        constexpr int R = 16 * NMT, TPR = 512 / R, PPT = 64 / TPR;
        const int r = tid / TPR, part = tid % TPR;
        const float* p = (const float*)(ws + (MODE == 3 ? WS_SSQS1 : WS_SSQS2)) + (32 * qr + r) * 64 + part * PPT; float t = 0.f;
#pragma unroll
        for (int j = 0; j < PPT; ++j) t += p[j];
        t = dpp_add<0xB1>(t); t = dpp_add<0x4E>(t);
        if (TPR == 16) { t = dpp_add<0x124>(t); t = dpp_add<0x128>(t); }
        if (part == 0) RS[r] = rsqrtf(t * (1.f / 1024.f) + RMS_EPS);
    }
    BAR_LDS();
#pragma unroll
    for (int i = 0; i < NMT / 2; ++i) {
        const int e = tid + 512 * i, s = 32 * qr + (e >> 4), col = 16 * ct + (e & 15); const size_t row = (size_t)MP + s;
        float v = 0.f;
#pragma unroll
        for (int w = 0; w < 8; ++w) v += RED[w * (NMT * 256) + e];
        if (MODE == 0) {
            v *= rsqrtf(((const float*)(ws + WS_SSQ0))[row] * (1.f / 1024.f) + RMS_EPS);
            ((bf16*)(ws + WS_PROJ))[row * NPROJ_PAD + col] = (bf16)(pk2(v, 0.f) & 0xffffu);
            if (col < C_Z) out[O_SCONV + (size_t)(s * 3 + 2) * 1536 + col] = v;
            else if (col >= C_B && col < C_NQ) ((float*)(ws + WS_BA))[row * 16 + (col - C_B)] = v;
            else if (col >= C_NKV && col < C_WIN) out[O_SNSA + (size_t)s * 512 + (col - C_NKV)] = v;
            else if (col >= C_WIN && col < C_G) out[O_SWIN + (size_t)(s * 512 + 511) * 256 + (col - C_WIN)] = v;
            else if (col >= C_G && col < NPROJ) ((float*)(ws + WS_GL))[row * 24 + (col - C_G)] = v;
        } else if (MODE == 2 || MODE == 4 || MODE == 6) {
            if (MODE == 2) v += a.in[I_XS][(size_t)s * DM + col];
            if (MODE == 4) v += ((const float*)(ws + WS_X1))[row * DM + col];
            if (MODE == 6) v += ((const float*)(ws + WS_X2))[row * DM + col];
            float ssq = v * v;
            ssq += __shfl_xor(ssq, 1); ssq += __shfl_xor(ssq, 2); ssq += __shfl_xor(ssq, 4); ssq += __shfl_xor(ssq, 8);
            if ((e & 15) == 0) { float* sp = (float*)(ws + (MODE == 2 ? WS_SSQS1 : MODE == 4 ? WS_SSQS2 : WS_SSQS3)) + s * 64 + ct;
                if (MODE == 6) __hip_atomic_store(sp, ssq, __ATOMIC_RELAXED, __HIP_MEMORY_SCOPE_AGENT); else *sp = ssq; }
            if (MODE == 2) { ((float*)(ws + WS_X1))[row * DM + col] = v; ((bf16*)(ws + WS_X1B))[row * DM + col] = (bf16)(pk2(v, 0.f) & 0xffffu); }
            if (MODE == 4) { ((float*)(ws + WS_X2))[row * DM + col] = v; ((bf16*)(ws + WS_X2B))[row * DM + col] = (bf16)(pk2(v, 0.f) & 0xffffu); }
            if (MODE == 6) __hip_atomic_store(out + O_YS + (size_t)s * DM + col, v, __ATOMIC_RELAXED, __HIP_MEMORY_SCOPE_AGENT);
        } else {
            const float rs = RS[s - 32 * qr];
            if (MODE == 3) ((bf16*)(ws + WS_QM))[row * DM + col] = (bf16)(pk2(v * rs, 0.f) & 0xffffu);
            else { const float q = fmaxf(v * rs, 0.f); ((bf16*)(ws + WS_UP))[row * DFF + col] = (bf16)(pk2(q * q, 0.f) & 0xffffu); }
        }
    }
    if (MODE == 6) {
        asm volatile("s_waitcnt vmcnt(0)" ::: "memory");
        __syncthreads();
        LAS unsigned* flag = (LAS unsigned*)(lds + 8 * 8192);
        if (tid == 0) *flag = __hip_atomic_fetch_add((unsigned*)(ws + WS_CTL) + CW_PANEL + 64 * 64, 1u, __ATOMIC_RELAXED, __HIP_MEMORY_SCOPE_AGENT);
        __syncthreads();
        if (*flag == (NMT == 8 ? 63u : 255u)) {
            __builtin_amdgcn_fence(__ATOMIC_ACQUIRE, "agent");
            asm volatile("s_waitcnt vmcnt(0)" ::: "memory");
            for (int r = wave; r < DBATCH; r += NWAVES) {
                const float* sp = (const float*)(ws + WS_SSQS3) + r * 64;
                float t = sp[lane]; t = wave_sum(t);
                const float rs = rsqrtf(t * (1.f / 1024.f) + RMS_EPS);
                float* y = out + O_YS + (size_t)r * DM;
#pragma unroll
                for (int j = 0; j < 4; ++j) { f32x4 v = ((f32x4*)y)[lane + 64 * j]; const f32x4 gq = ((const f32x4*)a.in[I_LNF])[lane + 64 * j]; ((f32x4*)y)[lane + 64 * j] = v * rs * gq; }
            }
        }
    }
    __syncthreads();
}
}
__device__ __forceinline__ void sample_copies(const Frame& F, const Args& a) {
    const size_t gt = (size_t)F.bid * NTHREADS + F.tid, GT = (size_t)F.G * NTHREADS;
    { const f32x4* src = (const f32x4*)a.in[I_SCONV]; f32x4* dst = (f32x4*)(a.out + O_SCONV);
      constexpr size_t PER = 2 * 384;
      for (size_t i = gt; i < (size_t)DBATCH * PER; i += GT) { const size_t s = i / PER, r = i % PER; dst[s * 3 * 384 + r] = src[s * 3 * 384 + 384 + r]; } }
}
__device__ __forceinline__ void temp_fill(const Frame& F, const Args& a, size_t off, size_t n) {
    const size_t gt = (size_t)F.bid * NTHREADS + F.tid, GT = (size_t)F.G * NTHREADS;
    f32x4* dst = (f32x4*)(a.out + off);
    for (size_t i = gt; i < n / 4; i += GT) dst[i] = (f32x4){0.f, 0.f, 0.f, 0.f};
}

__device__ __forceinline__ void conv_rows(const Frame& F, const Args& a, int row0, int nrows) {
    unsigned char* ws = a.ws;
    const bf16* PROJ = (const bf16*)(ws + WS_PROJ);
    const float* cw = a.in[I_CONVW];
    const int total = nrows * 192;
    for (int it = F.tid; it < total; it += NTHREADS) {
        const int rl = it / 192, row = row0 + rl, g8 = it - rl * 192, ch0 = g8 * 8;
        const bool isP = row < MP; const int s = row - MP, t = row & (SEQ - 1);
        float x[4][8];
        if (isP) {
#pragma unroll
            for (int jj = 0; jj < 4; ++jj) { const int tt = t - 3 + jj;
                v4u w = {0u, 0u, 0u, 0u};
                if (tt >= 0) w = *(const GAS v4u*)(PROJ + (size_t)(row - 3 + jj) * NPROJ_PAD + ch0);
                x[jj][0] = bflo(w.x); x[jj][1] = bfhi(w.x); x[jj][2] = bflo(w.y); x[jj][3] = bfhi(w.y); x[jj][4] = bflo(w.z); x[jj][5] = bfhi(w.z); x[jj][6] = bflo(w.w); x[jj][7] = bfhi(w.w); }
        } else {
#pragma unroll
            for (int jj = 0; jj < 3; ++jj) { const f32x4* p = (const f32x4*)(a.in[I_SCONV] + ((size_t)s * 3 + jj) * 1536 + ch0); const f32x4 u = p[0], v = p[1];
                x[jj][0] = u.x; x[jj][1] = u.y; x[jj][2] = u.z; x[jj][3] = u.w; x[jj][4] = v.x; x[jj][5] = v.y; x[jj][6] = v.z; x[jj][7] = v.w; }
            const v4u w = *(const GAS v4u*)(PROJ + (size_t)row * NPROJ_PAD + ch0);
            x[3][0] = bflo(w.x); x[3][1] = bfhi(w.x); x[3][2] = bflo(w.y); x[3][3] = bfhi(w.y); x[3][4] = bflo(w.z); x[3][5] = bfhi(w.z); x[3][6] = bflo(w.w); x[3][7] = bfhi(w.w);
        }
        float c[8];
#pragma unroll
        for (int e = 0; e < 8; ++e) c[e] = 0.f;
#pragma unroll
        for (int jj = 0; jj < 4; ++jj) { const f32x4* wp = (const f32x4*)(cw + jj * 1536 + ch0); const f32x4 u = wp[0], v = wp[1];
            const float wv[8] = {u.x, u.y, u.z, u.w, v.x, v.y, v.z, v.w};
#pragma unroll
            for (int e = 0; e < 8; ++e) c[e] += wv[e] * x[jj][e]; }
        float ss = 0.f;
#pragma unroll
        for (int e = 0; e < 8; ++e) { c[e] = c[e] / (1.f + __expf(-c[e])); ss += c[e] * c[e]; }
        ss += __shfl_xor(ss, 1); ss += __shfl_xor(ss, 2); ss += __shfl_xor(ss, 4);
        if (g8 < 128) { const float sc = rsqrtf(ss + 1e-6f) * (g8 < 64 ? 0.125f : 1.f);
#pragma unroll
            for (int e = 0; e < 8; ++e) c[e] *= sc; }
        v4u o; o.x = pk2(c[0], c[1]); o.y = pk2(c[2], c[3]); o.z = pk2(c[4], c[5]); o.w = pk2(c[6], c[7]);
        *(GAS v4u*)((bf16*)(ws + WS_QKVB) + (size_t)row * 1536 + ch0) = o;
        if (!isP) { f32x4* q = (f32x4*)((float*)(ws + WS_QKVN) + (size_t)row * 1536 + ch0); q[0] = (f32x4){c[0], c[1], c[2], c[3]}; q[1] = (f32x4){c[4], c[5], c[6], c[7]}; }
        if (g8 < 8) {
            const float* BA = (const float*)(ws + WS_BA) + (size_t)row * 16;
            const float beta = 1.f / (1.f + expf(-BA[g8])); const float xx = BA[8 + g8] + a.in[I_DTB][g8];
            const float sp = xx > 20.f ? xx : log1pf(expf(xx));
            float* BG = (float*)(ws + WS_BG) + (size_t)row * 16;
            BG[g8] = beta; BG[8 + g8] = -expf(a.in[I_ALOG][g8]) * sp;
        }
    }
}

__device__ __forceinline__ void vt_phase(const Frame& F, const Args& a) {
    unsigned char* ws = a.ws;
    const bf16* PROJ = (const bf16*)(ws + WS_PROJ); bf16* VTG = (bf16*)(ws + WS_VTG);
    LAS unsigned char* T = F.lds + F.wave * 16384;
    const int lane = F.lane;
    if (F.bid < 32 || F.bid >= 112) return;
    for (int u = (F.bid - 32) * NWAVES + F.wave; u < NB * 2 * 2 * 64; u += 80 * NWAVES) {
        const int blk = u & 63, g = (u >> 6) & 1, which = (u >> 7) & 1, b = u >> 8;
        const int col = which ? C_WIN + (2 + g) * 64 : C_NKV + (6 + g) * 64;
#pragma unroll
        for (int i = 0; i < 8; ++i) { const int pc = i * 64 + lane, tok = pc >> 3, ch = pc & 7;
            const v4u w = *(const GAS v4u*)(PROJ + (size_t)(b * SEQ + blk * 64 + tok) * NPROJ_PAD + col + ch * 8);
            const unsigned ww[4] = {w.x, w.y, w.z, w.w};
#pragma unroll
            for (int e = 0; e < 4; ++e) { *(LAS bf16*)(T + (8 * ch + 2 * e) * 144 + tok * 2) = (bf16)(ww[e] & 0xffffu); *(LAS bf16*)(T + (8 * ch + 2 * e + 1) * 144 + tok * 2) = (bf16)(ww[e] >> 16); } }
        LDS_WAIT(); asm volatile("" ::: "memory");
        bf16* dst = VTG + ((size_t)((b * 2 + which) * 2 + g) * 64) * SEQ + blk * 64;
#pragma unroll
        for (int i = 0; i < 8; ++i) { const int pc = i * 64 + lane, d = pc >> 3, ch = pc & 7;
            *(GAS v4u*)(dst + (size_t)d * SEQ + ch * 8) = *(const LAS v4u*)(T + d * 144 + ch * 16); }
        LDS_WAIT(); asm volatile("" ::: "memory");
    }
}

__device__ __forceinline__ void conv_chunk(const Frame& F, const Args& a, int row0) {
    unsigned char* ws = a.ws;
    const bf16* PROJ = (const bf16*)(ws + WS_PROJ);
    const float* cw = a.in[I_CONVW];
#pragma unroll 1
    for (int j0 = 0; j0 < 24; j0 += 4) {
        v4u raw[4][4];
#pragma unroll
        for (int u = 0; u < 4; ++u) { const int it = F.tid + NTHREADS * (j0 + u), rl = it / 192, row = row0 + rl, ch0 = (it - rl * 192) * 8, t = row & (SEQ - 1);
#pragma unroll
            for (int jj = 0; jj < 4; ++jj) { raw[u][jj] = (v4u){0u, 0u, 0u, 0u}; if (t - 3 + jj >= 0) raw[u][jj] = *(const GAS v4u*)(PROJ + (size_t)(row - 3 + jj) * NPROJ_PAD + ch0); } }
#pragma unroll
        for (int u = 0; u < 4; ++u) { const int it = F.tid + NTHREADS * (j0 + u), rl = it / 192, row = row0 + rl, g8 = it - rl * 192, ch0 = g8 * 8;
            float c[8];
#pragma unroll
            for (int e = 0; e < 8; ++e) c[e] = 0.f;
#pragma unroll
            for (int jj = 0; jj < 4; ++jj) { const f32x4* wp = (const f32x4*)(cw + jj * 1536 + ch0); const f32x4 wu = wp[0], wv = wp[1]; const v4u w = raw[u][jj];
                c[0] += wu.x * bflo(w.x); c[1] += wu.y * bfhi(w.x); c[2] += wu.z * bflo(w.y); c[3] += wu.w * bfhi(w.y);
                c[4] += wv.x * bflo(w.z); c[5] += wv.y * bfhi(w.z); c[6] += wv.z * bflo(w.w); c[7] += wv.w * bfhi(w.w); }
            float ss = 0.f;
#pragma unroll
            for (int e = 0; e < 8; ++e) { c[e] = c[e] / (1.f + __expf(-c[e])); ss += c[e] * c[e]; }
            ss = dpp_add<0xB1>(ss); ss = dpp_add<0x4E>(ss); ss += __shfl_xor(ss, 4);
            if (g8 < 128) { const float sc = rsqrtf(ss + 1e-6f) * (g8 < 64 ? 0.125f : 1.f);
#pragma unroll
                for (int e = 0; e < 8; ++e) c[e] *= sc; }
            v4u o; o.x = pk2(c[0], c[1]); o.y = pk2(c[2], c[3]); o.z = pk2(c[4], c[5]); o.w = pk2(c[6], c[7]);
            *(GAS v4u*)((bf16*)(ws + WS_QKVB) + (size_t)row * 1536 + ch0) = o;
            if (g8 < 8) {
                const float* BA = (const float*)(ws + WS_BA) + (size_t)row * 16;
                const float beta = 1.f / (1.f + expf(-BA[g8])); const float xx = BA[8 + g8] + a.in[I_DTB][g8];
                const float sp = xx > 20.f ? xx : log1pf(expf(xx));
                float* BG = (float*)(ws + WS_BG) + (size_t)row * 16;
                BG[g8] = beta; BG[8 + g8] = -expf(a.in[I_ALOG][g8]) * sp;
            }
        }
    }
}

__device__ __forceinline__ void memvt_phase(const Frame& F, const Args& a) {
    unsigned char* ws = a.ws;
    const bf16* KV = (const bf16*)(ws + WS_MEMKV); bf16* MVT = (bf16*)(ws + WS_MVT);
    LAS unsigned char* T = F.lds + F.wave * 16384;
    const int lane = F.lane;
    for (int u = F.bid * NWAVES + F.wave; u < NB * 4 * 16; u += F.G * NWAVES) {
        const int mb = u & 3, db = (u >> 2) & 3, head = (u >> 4) & 3, b = u >> 6;
#pragma unroll
        for (int i = 0; i < 8; ++i) { const int pc = i * 64 + lane, m = pc >> 3, ch = pc & 7;
            const v4u w = *(const GAS v4u*)(KV + (size_t)(b * MEMLEN + mb * 64 + m) * 2048 + 1024 + head * 256 + db * 64 + ch * 8);
            const unsigned ww[4] = {w.x, w.y, w.z, w.w};
#pragma unroll
            for (int e = 0; e < 4; ++e) { *(LAS bf16*)(T + (8 * ch + 2 * e) * 144 + m * 2) = (bf16)(ww[e] & 0xffffu); *(LAS bf16*)(T + (8 * ch + 2 * e + 1) * 144 + m * 2) = (bf16)(ww[e] >> 16); } }
        LDS_WAIT(); asm volatile("" ::: "memory");
        bf16* dst = MVT + ((size_t)(b * 4 + head) * 256 + db * 64) * 256 + mb * 64;
#pragma unroll
        for (int i = 0; i < 8; ++i) { const int pc = i * 64 + lane, d = pc >> 3, ch = pc & 7;
            *(GAS v4u*)(dst + (size_t)d * 256 + ch * 8) = *(const LAS v4u*)(T + d * 144 + ch * 16); }
        LDS_WAIT(); asm volatile("" ::: "memory");
    }
}
__device__ __forceinline__ float rdl(float v, int l) { return __builtin_bit_cast(float, __builtin_amdgcn_readlane(__builtin_bit_cast(int, v), l)); }
__device__ __forceinline__ float wave_max(float v) {
#pragma unroll
    for (int o = 1; o < 64; o <<= 1) v = fmaxf(v, __shfl_xor(v, o));
    return v;
}
__device__ __forceinline__ float sigmoidf_(float x) { return 1.f / (1.f + expf(-x)); }

__device__ __forceinline__ void nv_conv_row(const Args& a, int row, int lane) {
    unsigned char* ws = a.ws;
    const bf16* PROJ = (const bf16*)(ws + WS_PROJ);
    const bool isP = row < MP; const int s = row - MP, t = row & (SEQ - 1);
    const float* cw = a.in[I_CONVW];
    float* outp = (float*)(ws + WS_QKVN) + (size_t)row * 1536;
    for (int j = 0; j < 24; ++j) {
        const int ch = j * 64 + lane;
        float acc = 0.f;
#pragma unroll
        for (int jj = 0; jj < 4; ++jj) {
            float x;
            if (isP) { const int tt = t - 3 + jj; x = (tt >= 0) ? bf2f(PROJ[(size_t)(row - 3 + jj) * NPROJ_PAD + ch]) : 0.f; }
            else { x = (jj < 3) ? a.in[I_SCONV][((size_t)s * 3 + jj) * 1536 + ch] : bf2f(PROJ[(size_t)row * NPROJ_PAD + ch]); }
            acc += cw[jj * 1536 + ch] * x;
        }
        float c = acc / (1.f + expf(-acc));
        if (j < 16) { const float ss = wave_sum(c * c); c *= rsqrtf(ss + 1e-6f); if (j < 8) c *= 0.125f; }
        outp[ch] = c;
        ((bf16*)(ws + WS_QKVB))[(size_t)row * 1536 + ch] = (bf16)(pk2(c, 0.f) & 0xffffu);
    }
    if (lane < 8) {
        const float* BA = (const float*)(ws + WS_BA) + (size_t)row * 16;
        const float beta = sigmoidf_(BA[lane]); const float x = BA[8 + lane] + a.in[I_DTB][lane];
        const float sp = x > 20.f ? x : log1pf(expf(x));
        float* BG = (float*)(ws + WS_BG) + (size_t)row * 16;
        BG[lane] = beta; BG[8 + lane] = -expf(a.in[I_ALOG][lane]) * sp;
    }
}

__device__ __forceinline__ void nv_dn_seq(const Args& a, int seq, int h, int lane) {
    unsigned char* ws = a.ws;
    const bool isP = seq < NB; const int s = seq - NB;
    const int row0 = isP ? seq * SEQ : MP + s, nsteps = isP ? SEQ : 1;
    float S[64];
#pragma unroll
    for (int k = 0; k < 64; ++k) S[k] = isP ? 0.f : __builtin_nontemporal_load(a.in[I_SREC] + ((size_t)(s * 8 + h) * 64 + k) * 64 + lane);
    const float gain = a.in[I_DNNORM][lane];
    for (int st = 0; st < nsteps; ++st) {
        const int row = row0 + st;
        const float* qkv = (const float*)(ws + WS_QKVN) + (size_t)row * 1536 + h * 64 + lane;
        const float qv = qkv[0], kv = qkv[512], vv = qkv[1024];
        const float* BG = (const float*)(ws + WS_BG) + (size_t)row * 16;
        const float beta = BG[h], ag = expf(BG[8 + h]);
        const float z = bf2f(((const bf16*)(ws + WS_PROJ))[(size_t)row * NPROJ_PAD + C_Z + h * 64 + lane]);
        float kS = 0.f;
#pragma unroll
        for (int k = 0; k < 64; ++k) kS += rdl(kv, k) * S[k];
        const float vn = beta * (vv - ag * kS);
        float o = 0.f;
#pragma unroll
        for (int k = 0; k < 64; ++k) { S[k] = ag * S[k] + rdl(kv, k) * vn; o += rdl(qv, k) * S[k]; }
        const float ss = wave_sum(o * o);
        const float y = o * rsqrtf(ss * (1.f / 64.f) + RMS_EPS) * gain * (z / (1.f + expf(-z)));
        ((bf16*)(ws + WS_MIX))[(size_t)row * DM + h * 64 + lane] = (bf16)(pk2(y, 0.f) & 0xffffu);
    }
    float* dst = isP ? a.out + O_PREC + (size_t)(seq * 8 + h) * 4096 : a.out + O_SREC + (size_t)(s * 8 + h) * 4096;
#pragma unroll
    for (int k = 0; k < 64; ++k) __builtin_nontemporal_store(S[k], dst + k * 64 + lane);
}

__device__ __forceinline__ void nv_compress(const Args& a, int item, int lane) {
    unsigned char* ws = a.ws;
    int kind, idx, n, g; bool isP;
    if (item < 1024) { isP = true; kind = item >> 9; const int r = item & 511; idx = r >> 7; n = (r >> 1) & 63; g = r & 1; }
    else { isP = false; const int it = item - 1024; kind = it >> 13; const int r = it & 8191; idx = r >> 6; n = (r >> 1) & 31; g = r & 1; }
    const float* w1 = a.in[I_W1] + (size_t)kind * 4096 * 128; const float* pe = a.in[I_PE] + (size_t)kind * 4096;
    const int* pt = (const int*)a.in[I_PT];
    float h0 = 0.f, h1 = 0.f;
    for (int c = 0; c < 64; ++c) {
        const float* kvrow;
        if (isP) kvrow = a.out + O_PNSA + ((size_t)(idx * SEQ + n * 64 + c) * 512 + (kind * 2 + g) * 64);
        else { const int page = pt[idx * NPAGES + (n >> 1)]; kvrow = a.in[I_CNSA] + (((size_t)page * PAGE + (n & 1) * 64 + c) * 512 + (kind * 2 + g) * 64); }
        const float x = kvrow[lane] + pe[c * 64 + lane];
        const float* wr = w1 + (size_t)c * 64 * 128 + lane;
#pragma unroll 16
        for (int d = 0; d < 64; ++d) { const float xd = __shfl(x, d); h0 += xd * wr[d * 128]; h1 += xd * wr[d * 128 + 64]; }
    }
    h0 = fmaxf(h0 + a.in[I_B1][kind * 128 + lane], 0.f); h1 = fmaxf(h1 + a.in[I_B1][kind * 128 + 64 + lane], 0.f);
    const float* w2 = a.in[I_W2] + (size_t)kind * 128 * 64 + lane;
    float o = 0.f;
#pragma unroll 16
    for (int hd = 0; hd < 64; ++hd) { o += __shfl(h0, hd) * w2[hd * 64]; o += __shfl(h1, hd) * w2[(64 + hd) * 64]; }
    float* dst = isP ? (float*)(ws + WS_KCMP_P) + (size_t)kind * (NB * 64 * 2 * 64) + ((size_t)(idx * 64 + n) * 2 + g) * 64
                     : (float*)(ws + WS_KCMP_S) + (size_t)kind * (DBATCH * 32 * 2 * 64) + ((size_t)(idx * 32 + n) * 2 + g) * 64;
    dst[lane] = o;
}

__device__ __forceinline__ void nv_attend(LAS float* scr, const float* kf, bool ok, const float* vf, size_t vstride, int nkeys, int lane,
                                          f32x4& m, f32x4& l, f32x4& O) {
    f32x4 sc = {0.f, 0.f, 0.f, 0.f};
#pragma unroll 8
    for (int d = 0; d < 64; ++d) sc += *(const LAS f32x4*)(scr + 4 * d) * kf[d];
    f32x4 pr;
#pragma unroll
    for (int r = 0; r < 4; ++r) {
        const float s = ok ? sc[r] * 0.125f : -1e30f; const float mx = wave_max(s), mn = fmaxf(m[r], mx), alpha = expf(m[r] - mn);
        const float e = ok ? expf(s - mn) : 0.f; l[r] = l[r] * alpha + wave_sum(e); O[r] *= alpha; m[r] = mn; pr[r] = e;
    }
    *(LAS f32x4*)(scr + 256 + 4 * lane) = pr;
    LDS_WAIT(); asm volatile("" ::: "memory");
#pragma unroll 4
    for (int key = 0; key < nkeys; ++key) {
        O += *(const LAS f32x4*)(scr + 256 + 4 * key) * vf[(size_t)key * vstride + lane];
    }
    LDS_WAIT(); asm volatile("" ::: "memory");
}

__device__ __forceinline__ void nv_nsa_token(const Args& a, LAS float* scr, bool isP, int idx, int g, int t, int row, int lane, bf16* MIXp) {
    unsigned char* ws = a.ws;
    const bf16* PROJ = (const bf16*)(ws + WS_PROJ);
    const int* pt = (const int*)a.in[I_PT];
    {   f32x4 q4;
#pragma unroll
        for (int r = 0; r < 4; ++r) q4[r] = bf2f(PROJ[(size_t)row * NPROJ_PAD + C_NQ + (g * 4 + r) * 64 + lane]);
        *(LAS f32x4*)(scr + 4 * lane) = q4; LDS_WAIT(); asm volatile("" ::: "memory"); }
    const int ncmp = isP ? 64 : 32, nvis = isP ? (t + 1) / 64 : 32;
    const float* kcb = isP ? (const float*)(ws + WS_KCMP_P) + ((size_t)idx * 64 * 2 + g) * 64 : (const float*)(ws + WS_KCMP_S) + ((size_t)idx * 32 * 2 + g) * 64;
    const float* vcb = kcb + (isP ? (size_t)NB * 64 * 2 * 64 : (size_t)DBATCH * 32 * 2 * 64);
    const bool vis = lane < nvis;
    f32x4 p; float imp = 0.f;
    {
        const float* kc = kcb + (size_t)(lane < ncmp ? lane : 0) * 128;
        f32x4 sc = {0.f, 0.f, 0.f, 0.f};
#pragma unroll 8
        for (int d = 0; d < 64; ++d) sc += *(const LAS f32x4*)(scr + 4 * d) * kc[d];
#pragma unroll
        for (int r = 0; r < 4; ++r) { const float s = vis ? sc[r] * 0.125f : -1e30f; const float mx = wave_max(s); const float e = vis ? expf(s - mx) : 0.f;
            const float sum = wave_sum(e); p[r] = e / fmaxf(sum, 1e-30f); imp += p[r]; }
    }
    f32x4 oc = {0.f, 0.f, 0.f, 0.f};
    *(LAS f32x4*)(scr + 256 + 4 * lane) = p; LDS_WAIT(); asm volatile("" ::: "memory");
    for (int n = 0; n < nvis; ++n) oc += *(const LAS f32x4*)(scr + 256 + 4 * n) * vcb[(size_t)n * 128 + lane];
    LDS_WAIT(); asm volatile("" ::: "memory");
    const int cur = t / 64, nsel = isP ? 64 : 33;
    const bool inarr = lane < nsel, valid = inarr && lane <= cur, forced = valid && (lane == 0 || cur - lane < 2);
    const float score = !inarr ? -2.f : (valid ? imp + (forced ? 1000.f : 0.f) : -1.f);
    int rank = 0;
    for (int j = 0; j < 64; ++j) { const float sj = __shfl(score, j); rank += (sj > score || (sj == score && j < lane)) ? 1 : 0; }
    const unsigned long long selmask = __ballot(valid && rank < 16);
    f32x4 ob[2];
#pragma unroll 1
    for (int br = 0; br < 2; ++br) {
        f32x4 m = {-1e30f, -1e30f, -1e30f, -1e30f}, l = {0.f, 0.f, 0.f, 0.f}, O = {0.f, 0.f, 0.f, 0.f};
        const int nblk = br == 0 ? cur + 1 : (isP ? 8 : 9);
#pragma unroll 1
        for (int j = 0; j < nblk; ++j) {
            const float* kf = nullptr; const float* vf = nullptr; size_t vstride = 0; int nkeys = 0; bool ok = false;
            if (br == 0) {
                if (!((selmask >> j) & 1ull)) continue;
                const int kpos = 64 * j + lane; ok = kpos <= t; const int kc = ok ? kpos : t;
                nkeys = (t - 64 * j + 1) < 64 ? (t - 64 * j + 1) : 64; vstride = 512;
                if (isP) { kf = a.out + O_PNSA + ((size_t)(idx * SEQ + kc) * 512 + (4 + g) * 64); vf = a.out + O_PNSA + ((size_t)(idx * SEQ + 64 * j) * 512 + (6 + g) * 64); }
                else if (j < 32) { const int page = pt[idx * NPAGES + (j >> 1)]; const float* base = a.in[I_CNSA] + ((size_t)page * PAGE + (j & 1) * 64) * 512;
                    kf = base + (size_t)lane * 512 + (4 + g) * 64; vf = base + (6 + g) * 64; }
                else { const float* base = a.out + O_SNSA + (size_t)idx * 512; kf = base + (4 + g) * 64; vf = base + (6 + g) * 64; nkeys = 1; }
            } else if (isP) {
                const int k0 = t - 511 + 64 * j;
                if (k0 + 63 < 0) continue;
                const int kb = k0 < 0 ? 0 : k0;
                nkeys = k0 < 0 ? k0 + 64 : 64; ok = lane < nkeys; const int kc = ok ? kb + lane : kb;
                const float* WF = (const float*)(ws + WS_WINF);
                kf = WF + (size_t)(idx * SEQ + kc) * 256 + g * 64; vf = WF + (size_t)(idx * SEQ + kb) * 256 + (2 + g) * 64; vstride = 256;
            } else {
                vstride = 256;
                if (j < 8) { const int c0 = 1 + 64 * j; nkeys = j < 7 ? 64 : 63; ok = lane < nkeys; const int ci = ok ? c0 + lane : c0;
                    kf = a.in[I_CWIN] + ((size_t)idx * 512 + ci) * 256 + g * 64; vf = a.in[I_CWIN] + ((size_t)idx * 512 + c0) * 256 + (2 + g) * 64; }
                else { const float* nb_ = a.out + O_SWIN + ((size_t)idx * 512 + 511) * 256; kf = nb_ + g * 64; vf = nb_ + (2 + g) * 64; nkeys = 1; ok = lane == 0; }
            }
            nv_attend(scr, kf, ok, vf, vstride, nkeys, lane, m, l, O);
        }
#pragma unroll
        for (int r = 0; r < 4; ++r) O[r] = O[r] / fmaxf(l[r], 1e-30f);
        ob[br] = O;
    }
    const float* GL = (const float*)(ws + WS_GL) + (size_t)row * 24;
#pragma unroll
    for (int r = 0; r < 4; ++r) {
        const float gc = sigmoidf_(GL[(g * 4 + r) * 3 + 0]), gs = sigmoidf_(GL[(g * 4 + r) * 3 + 1]), gw = sigmoidf_(GL[(g * 4 + r) * 3 + 2]);
        const float y = gc * oc[r] + gs * ob[0][r] + gw * ob[1][r];
        MIXp[(size_t)row * DM + 512 + (g * 4 + r) * 64 + lane] = (bf16)(pk2(y, 0.f) & 0xffffu);
    }
}

__device__ __forceinline__ void nv_mem_attn(const Args& a, LAS float* scr, int row, int head, int lane) {
    unsigned char* ws = a.ws;
    const bool isP = row < MP; const int s = row - MP, b = row >> 12;
    const bf16* qm = (const bf16*)(ws + WS_QM) + (size_t)row * DM + head * 256;
#pragma unroll
    for (int j = 0; j < 4; ++j) scr[lane + 64 * j] = bf2f(qm[lane + 64 * j]);
    LDS_WAIT(); asm volatile("" ::: "memory");
    float sc[4];
#pragma unroll
    for (int j = 0; j < 4; ++j) {
        const int mkey = lane + 64 * j; float acc = 0.f;
        if (isP) { const bf16* kr = (const bf16*)(ws + WS_MEMKV) + (size_t)(b * MEMLEN + mkey) * 2048 + head * 256;
            for (int d = 0; d < 256; ++d) acc += scr[d] * bf2f(kr[d]); }
        else { const float* kr = a.in[I_CMEM] + ((size_t)(s * MEMLEN + mkey) * 2 + 0) * 1024 + head * 256;
            for (int d = 0; d < 256; ++d) acc += scr[d] * kr[d]; }
        sc[j] = acc * 0.0625f;
    }
    float mx = fmaxf(fmaxf(sc[0], sc[1]), fmaxf(sc[2], sc[3])); mx = wave_max(mx);
    float sum = 0.f;
#pragma unroll
    for (int j = 0; j < 4; ++j) { sc[j] = expf(sc[j] - mx); sum += sc[j]; }
    sum = wave_sum(sum); const float inv = 1.f / sum;
    LDS_WAIT(); asm volatile("" ::: "memory");
#pragma unroll
    for (int j = 0; j < 4; ++j) scr[256 + lane + 64 * j] = sc[j] * inv;
    LDS_WAIT(); asm volatile("" ::: "memory");
    float o[4] = {0.f, 0.f, 0.f, 0.f};
    for (int mkey = 0; mkey < MEMLEN; ++mkey) {
        const float pm = scr[256 + mkey];
        if (isP) { const bf16* vr = (const bf16*)(ws + WS_MEMKV) + (size_t)(b * MEMLEN + mkey) * 2048 + 1024 + head * 256;
#pragma unroll
            for (int j = 0; j < 4; ++j) o[j] += pm * bf2f(vr[lane + 64 * j]); }
        else { const float* vr = a.in[I_CMEM] + ((size_t)(s * MEMLEN + mkey) * 2 + 1) * 1024 + head * 256;
#pragma unroll
            for (int j = 0; j < 4; ++j) o[j] += pm * vr[lane + 64 * j]; }
    }
    bf16* om = (bf16*)(ws + WS_OM) + (size_t)row * DM + head * 256;
#pragma unroll
    for (int j = 0; j < 4; ++j) om[lane + 64 * j] = (bf16)(pk2(o[j], 0.f) & 0xffffu);
    LDS_WAIT(); asm volatile("" ::: "memory");
}

__device__ __forceinline__ void final_norm_row(const Args& a, int row, int lane) {
    float s = 0.f;
    if (row < MP) { const float* sp = (const float*)(a.ws + WS_SSQ3) + (size_t)row * 16;
#pragma unroll
        for (int i = 0; i < 16; ++i) s += sp[i]; }
    else { const float* sp = (const float*)(a.ws + WS_SSQS3) + (size_t)(row - MP) * 64;
#pragma unroll 16
        for (int i = 0; i < 64; ++i) s += sp[i]; }
    const float rs = rsqrtf(s * (1.f / 1024.f) + RMS_EPS);
    if (row < MP) {
        float* y = a.out + O_YP + (size_t)row * DM; const v2u* yb = (const v2u*)((const bf16*)(a.ws + WS_YB) + (size_t)row * DM);
#pragma unroll
        for (int j = 0; j < 4; ++j) { const v2u w = yb[lane + 64 * j]; const f32x4 gq = ((const f32x4*)a.in[I_LNF])[lane + 64 * j];
            ((f32x4*)y)[lane + 64 * j] = (f32x4){bflo(w.x), bfhi(w.x), bflo(w.y), bfhi(w.y)} * rs * gq; }
    } else {
        float* y = a.out + O_YS + (size_t)(row - MP) * DM;
#pragma unroll
        for (int j = 0; j < 4; ++j) { f32x4 v = ((f32x4*)y)[lane + 64 * j]; const f32x4 gq = ((const f32x4*)a.in[I_LNF])[lane + 64 * j]; ((f32x4*)y)[lane + 64 * j] = v * rs * gq; }
    }
}

__device__ __forceinline__ void sample_dn_wave(const Args& a, int s, int h, int lane) {
    unsigned char* ws = a.ws;
    const size_t row = (size_t)MP + s;
    const bf16* PROJ = (const bf16*)(ws + WS_PROJ);
    const float* cw = a.in[I_CONVW];
    float c3[3];
#pragma unroll
    for (int which = 0; which < 3; ++which) {
        const int ch = which * 512 + h * 64 + lane;
        float acc = cw[3 * 1536 + ch] * bf2f(PROJ[row * NPROJ_PAD + ch]);
#pragma unroll
        for (int jj = 0; jj < 3; ++jj) acc += cw[jj * 1536 + ch] * a.in[I_SCONV][((size_t)s * 3 + jj) * 1536 + ch];
        float c = acc / (1.f + expf(-acc));
        if (which < 2) { const float ss = wave_sum(c * c); c *= rsqrtf(ss + 1e-6f) * (which == 0 ? 0.125f : 1.f); }
        c3[which] = c;
    }
    const float qv = c3[0], kv = c3[1], vv = c3[2];
    const float* BA = (const float*)(ws + WS_BA) + row * 16;
    const float beta = 1.f / (1.f + expf(-BA[h])); const float xx = BA[8 + h] + a.in[I_DTB][h];
    const float ag = expf(-expf(a.in[I_ALOG][h]) * (xx > 20.f ? xx : log1pf(expf(xx))));
    float S[64];
#pragma unroll
    for (int k = 0; k < 64; ++k) S[k] = __builtin_nontemporal_load(a.in[I_SREC] + ((size_t)(s * 8 + h) * 64 + k) * 64 + lane);
    const float z = bf2f(PROJ[row * NPROJ_PAD + C_Z + h * 64 + lane]);
    float kS = 0.f;
#pragma unroll
    for (int k = 0; k < 64; ++k) kS += rdl(kv, k) * S[k];
    const float vn = beta * (vv - ag * kS);
    float o = 0.f;
#pragma unroll
    for (int k = 0; k < 64; ++k) { S[k] = ag * S[k] + rdl(kv, k) * vn; o += rdl(qv, k) * S[k]; }
    const float ss = wave_sum(o * o);
    const float y = o * rsqrtf(ss * (1.f / 64.f) + RMS_EPS) * a.in[I_DNNORM][lane] * (z / (1.f + expf(-z)));
    ((bf16*)(ws + WS_MIX))[row * DM + h * 64 + lane] = (bf16)(pk2(y, 0.f) & 0xffffu);
    float* dst = a.out + O_SREC + (size_t)(s * 8 + h) * 4096;
#pragma unroll
    for (int k = 0; k < 64; ++k) __builtin_nontemporal_store(S[k], dst + k * 64 + lane);
}
namespace nsa {
constexpr int TS = 144;
constexpr int L_KT = 0, L_VT = 2 * 64 * TS, L_IMP = 4 * 64 * TS, IMP_STRIDE = 65, L_SEL = L_IMP + 4 * 64 * IMP_STRIDE * 4, L_END = L_SEL + 64 * 8;
static_assert(L_END <= RING_BYTES, "nsa lds");
constexpr float CEXP = 0.125f * 1.44269504088896f;
struct State { float m, l; f32x16 o0, o1; };
__device__ __forceinline__ int crow(int reg, int h) { return (reg & 3) + 8 * (reg >> 2) + 4 * h; }
__device__ __forceinline__ void st_init(State& s) { s.m = -1e30f; s.l = 0.f;
#pragma unroll
    for (int i = 0; i < 16; ++i) { s.o0[i] = 0.f; s.o1[i] = 0.f; } }

__device__ __forceinline__ void scores64(const LAS unsigned char* Kt, const bf16x8 (&Qf)[4], int lane, f32x16& s0, f32x16& s1) {
    const int kr = lane & 31, h = lane >> 5;
#pragma unroll
    for (int i = 0; i < 16; ++i) { s0[i] = 0.f; s1[i] = 0.f; }
#pragma unroll
    for (int ks = 0; ks < 4; ++ks) {
        const bf16x8 a0 = *(const LAS bf16x8*)(Kt + kr * TS + (16 * ks + 8 * h) * 2);
        const bf16x8 a1 = *(const LAS bf16x8*)(Kt + (kr + 32) * TS + (16 * ks + 8 * h) * 2);
        s0 = MFMA32(a0, Qf[ks], s0); s1 = MFMA32(a1, Qf[ks], s1);
    }
}
__device__ __forceinline__ void mask64(f32x16& s0, f32x16& s1, unsigned long long vm, int lane) {
    const int h = lane >> 5; const unsigned lo = (unsigned)vm >> (4 * h), hi = (unsigned)(vm >> 32) >> (4 * h);
#pragma unroll
    for (int i = 0; i < 16; ++i) { const int k = (i & 3) + 8 * (i >> 2);
        s0[i] = ((lo >> k) & 1u) ? s0[i] : -1e30f; s1[i] = ((hi >> k) & 1u) ? s1[i] : -1e30f; }
}
__device__ __forceinline__ void pv64(const LAS unsigned char* Vt, const f32x16& p0, const f32x16& p1, int lane, f32x16& o0, f32x16& o1) {
    const int kr = lane & 31, h = lane >> 5;
#pragma unroll
    for (int st = 0; st < 4; ++st) {
        const f32x16& p = (st >> 1) ? p1 : p0; const int r0 = 8 * (st & 1), base = 32 * (st >> 1) + 16 * (st & 1);
        v4u pw; pw.x = pk2(p[r0 + 0], p[r0 + 1]); pw.y = pk2(p[r0 + 2], p[r0 + 3]); pw.z = pk2(p[r0 + 4], p[r0 + 5]); pw.w = pk2(p[r0 + 6], p[r0 + 7]);
        const bf16x8 pb = __builtin_bit_cast(bf16x8, pw);
#pragma unroll
        for (int dt = 0; dt < 2; ++dt) {
            const LAS unsigned char* vr = Vt + (32 * dt + kr) * TS + (base + 4 * h) * 2;
            const v2u lo = *(const LAS v2u*)vr, hi = *(const LAS v2u*)(vr + 16);
            v4u aw; aw.x = lo.x; aw.y = lo.y; aw.z = hi.x; aw.w = hi.y;
            const bf16x8 av = __builtin_bit_cast(bf16x8, aw);
            if (dt == 0) o0 = MFMA32(av, pb, o0); else o1 = MFMA32(av, pb, o1);
        }
    }
}
__device__ __forceinline__ void softmax_pv(const LAS unsigned char* Vt, f32x16 s0, f32x16 s1, unsigned long long vm, bool permask, int lane, State& st) {
    if (permask) mask64(s0, s1, vm, lane);
    const bool none = vm == 0ull;
    float mx = s0[0];
#pragma unroll
    for (int i = 1; i < 16; ++i) mx = fmaxf(mx, s0[i]);
#pragma unroll
    for (int i = 0; i < 16; ++i) mx = fmaxf(mx, s1[i]);
    mx = fmaxf(mx, __shfl_xor(mx, 32));
    const float mn = none ? st.m : fmaxf(st.m, mx), mref = (mn <= -1e30f) ? 0.f : mn;
    const float alpha = fast_exp2((st.m - mref) * CEXP);
    const float nb = none ? -1e30f : -mref * CEXP;
    float ps = 0.f;
#pragma unroll
    for (int i = 0; i < 16; ++i) { s0[i] = fast_exp2(__builtin_fmaf(s0[i], CEXP, nb)); s1[i] = fast_exp2(__builtin_fmaf(s1[i], CEXP, nb)); ps += s0[i] + s1[i]; }
    ps += __shfl_xor(ps, 32);
    st.l = st.l * alpha + ps; st.m = mn;
    st.o0 = st.o0 * alpha; st.o1 = st.o1 * alpha;
    pv64(Vt, s0, s1, lane, st.o0, st.o1);
}

struct TileRegs { v4u k, v; };
__device__ __forceinline__ void tile_load(TileRegs& t, const bf16* kb, const bf16* vt, int tid) {
    t.k = *(const GAS v4u*)(kb + (size_t)(tid >> 3) * NPROJ_PAD + (tid & 7) * 8);
    t.v = *(const GAS v4u*)(vt + (size_t)(tid >> 3) * SEQ + (tid & 7) * 8);
}
__device__ __forceinline__ void tile_load2(TileRegs& t, const bf16* kb, const bf16* vb, int kt, int vt, int tid) {
    t.k = *(const GAS v4u*)(kb + ((size_t)kt * 64 + (tid >> 3)) * NPROJ_PAD + (tid & 7) * 8);
    t.v = *(const GAS v4u*)(vb + (size_t)(tid >> 3) * SEQ + vt * 64 + (tid & 7) * 8);
}
__device__ __forceinline__ void tile_store_t(const TileRegs& t, LAS unsigned char* Kt, LAS unsigned char* Vt, int tid) {
    *(LAS v4u*)(Kt + (tid >> 3) * TS + (tid & 7) * 16) = t.k;
    *(LAS v4u*)(Vt + (tid >> 3) * TS + (tid & 7) * 16) = t.v;
}
__device__ __forceinline__ void tile_load_f32(TileRegs& t, const float* kb, const float* vb, int tid) {
    const f32x4* kp = (const f32x4*)(kb + (size_t)(tid >> 3) * 128 + (tid & 7) * 8); const f32x4 a = kp[0], b = kp[1];
    t.k.x = pk2(a.x, a.y); t.k.y = pk2(a.z, a.w); t.k.z = pk2(b.x, b.y); t.k.w = pk2(b.z, b.w);
    const f32x4* vp = (const f32x4*)(vb + (size_t)(tid & 63) * 128 + (tid >> 6) * 8); const f32x4 c = vp[0], d = vp[1];
    t.v.x = pk2(c.x, c.y); t.v.y = pk2(c.z, c.w); t.v.z = pk2(d.x, d.y); t.v.w = pk2(d.z, d.w);
}
__device__ __forceinline__ void tile_store(const TileRegs& t, LAS unsigned char* Kt, LAS unsigned char* Vt, int tid) {
    *(LAS v4u*)(Kt + (tid >> 3) * TS + (tid & 7) * 16) = t.k;
    LAS unsigned char* vp = Vt + (8 * (tid >> 6)) * TS + (tid & 63) * 2;
    const unsigned w[4] = {t.v.x, t.v.y, t.v.z, t.v.w};
#pragma unroll
    for (int e = 0; e < 4; ++e) { *(LAS bf16*)(vp + (2 * e) * TS) = (bf16)(w[e] & 0xffffu); *(LAS bf16*)(vp + (2 * e + 1) * TS) = (bf16)(w[e] >> 16); }
}

__device__ __forceinline__ void unit(const Args& a, LAS unsigned char* lds, int b, int g, int qt, bf16* dst, int tid) {
    unsigned char* ws = a.ws; asm volatile("" : "+s"(ws));
    asm volatile("" : "+v"(tid));
    const int lane = tid & 63, wave = __builtin_amdgcn_readfirstlane(tid >> 6), r = wave >> 1, hh = wave & 1, h = lane >> 5;
    const int t0 = 64 * qt, tl = 32 * hh + (lane & 31), tq = t0 + tl;
    const size_t row = (size_t)b * SEQ + tq;
    const bf16* PROJ = (const bf16*)(ws + WS_PROJ);
    bf16x8 Qf[4];
#pragma unroll
    for (int ks = 0; ks < 4; ++ks) Qf[ks] = *(const GAS bf16x8*)(PROJ + row * NPROJ_PAD + C_NQ + (g * 4 + r) * 64 + 16 * ks + 8 * h);
    const float* GL = (const float*)(ws + WS_GL) + row * 24 + (g * 4 + r) * 3;
    const float gc = 1.f / (1.f + __expf(-GL[0])), gs = 1.f / (1.f + __expf(-GL[1])), gw = 1.f / (1.f + __expf(-GL[2]));
    LAS float* IMP = (LAS float*)(lds + L_IMP);
    LAS unsigned long long* SEL = (LAS unsigned long long*)(lds + L_SEL);
    int par = 0;
    TileRegs tr;
    f32x16 acc0, acc1;
    {
        const float* kc = (const float*)(ws + WS_KCMP_P) + ((size_t)b * 64 * 2 + g) * 64;
        tile_load_f32(tr, kc, kc + (size_t)NB * 64 * 2 * 64, tid);
        tile_store(tr, lds + L_KT + par * 64 * TS, lds + L_VT + par * 64 * TS, tid);
        BAR_LDS();
        f32x16 s0, s1; scores64(lds + L_KT + par * 64 * TS, Qf, lane, s0, s1);
        const int nvis = (tq + 1) >> 6;
        const unsigned long long vm = nvis >= 64 ? ~0ull : ((1ull << nvis) - 1ull);
        mask64(s0, s1, vm, lane);
        float mx = s0[0];
#pragma unroll
        for (int i = 1; i < 16; ++i) mx = fmaxf(mx, s0[i]);
#pragma unroll
        for (int i = 0; i < 16; ++i) mx = fmaxf(mx, s1[i]);
        mx = fmaxf(mx, __shfl_xor(mx, 32));
        const float mref = (mx <= -1e30f) ? 0.f : mx;
        float ps = 0.f;
#pragma unroll
        for (int i = 0; i < 16; ++i) { s0[i] = fast_exp2((s0[i] - mref) * CEXP); s1[i] = fast_exp2((s1[i] - mref) * CEXP); ps += s0[i] + s1[i]; }
        ps += __shfl_xor(ps, 32);
        const float inv = 1.f / fmaxf(ps, 1e-30f);
        s0 = s0 * inv; s1 = s1 * inv;
        LAS float* ip = IMP + (r * 64 + tl) * IMP_STRIDE;
#pragma unroll
        for (int i = 0; i < 16; ++i) { ip[crow(i, h)] = s0[i]; ip[32 + crow(i, h)] = s1[i]; }
#pragma unroll
        for (int i = 0; i < 16; ++i) { acc0[i] = 0.f; acc1[i] = 0.f; }
        pv64(lds + L_VT + par * 64 * TS, s0, s1, lane, acc0, acc1);
        acc0 = acc0 * gc; acc1 = acc1 * gc;
        par ^= 1;
        BAR_LDS();
#pragma unroll 1
        for (int i = 0; i < 8; ++i) {
            const int tok = 8 * wave + i, t = t0 + tok, cur = qt;
            const float imp = (IMP[(0 * 64 + tok) * IMP_STRIDE + lane] + IMP[(1 * 64 + tok) * IMP_STRIDE + lane]) + (IMP[(2 * 64 + tok) * IMP_STRIDE + lane] + IMP[(3 * 64 + tok) * IMP_STRIDE + lane]);
            (void)t;
            const bool valid = lane <= cur, forced = valid && (lane == 0 || cur - lane < 2);
            const float score = valid ? imp + (forced ? 1000.f : 0.f) : -1.f;
            int rank = 0;
#pragma unroll 8
            for (int j = 0; j < 64; ++j) { const float sj = __shfl(score, j); rank += (sj > score || (sj == score && j < lane)) ? 1 : 0; }
            const unsigned long long m = __ballot(valid && rank < 16);
            if (lane == 0) SEL[tok] = m;
        }
        BAR_LDS();
    }
    const unsigned long long mysel = SEL[tl];
    LAS float* PARK = (LAS float*)(lds + L_IMP) + tid;
    BAR_LDS();
#pragma unroll
    for (int i = 0; i < 16; ++i) { PARK[(2 * i) * NTHREADS] = acc0[i]; PARK[(2 * i + 1) * NTHREADS] = acc1[i]; }
    const unsigned long long causal = (2ull << tl) - 1ull;
    TileRegs trA, trB;
#define NSA_ITER(TR, J, VMEXPR, PMEXPR) do { const int j_ = (J); \
        tile_store_t(TR, lds + L_KT + ((j_ + 1) & 1) * 64 * TS, lds + L_VT + (j_ & 1) * 64 * TS, tid); BAR_LDS(); \
        { const int kn = j_ + 3 < jl ? j_ + 3 : jl, vn = j_ + 2 < jl ? j_ + 2 : jl; tile_load2(TR, kb, vb, kn, vn, tid); } \
        f32x16 n0, n1; scores64(lds + L_KT + ((j_ + 1) & 1) * 64 * TS, Qf, lane, n0, n1); \
        if (j_ <= jl) { const unsigned long long vm = (VMEXPR); softmax_pv(lds + L_VT + (j_ & 1) * 64 * TS, c0, c1, vm, (PMEXPR), lane, st); } \
        c0 = n0; c1 = n1; } while (0)
#define NSA_BRANCH(J0, VMEXPR, PMEXPR) do { \
        BAR_LDS();                                             \
        { TileRegs t0; tile_load2(t0, kb, vb, (J0), (J0), tid); tile_store_t(t0, lds + L_KT + ((J0) & 1) * 64 * TS, lds + L_VT + (((J0) + 1) & 1) * 64 * TS, tid); } \
        { const int k1 = (J0) + 1 < jl ? (J0) + 1 : jl; tile_load2(trA, kb, vb, k1, (J0), tid); } \
        { const int k2 = (J0) + 2 < jl ? (J0) + 2 : jl, v1 = (J0) + 1 < jl ? (J0) + 1 : jl; tile_load2(trB, kb, vb, k2, v1, tid); } \
        BAR_LDS(); \
        f32x16 c0, c1; scores64(lds + L_KT + ((J0) & 1) * 64 * TS, Qf, lane, c0, c1); \
        _Pragma("unroll 1") for (int j = (J0); j <= jl; j += 2) { NSA_ITER(trA, j, VMEXPR, PMEXPR); NSA_ITER(trB, j + 1, VMEXPR, PMEXPR); } } while (0)
    {
        State st; st_init(st);
        const bf16* kb = PROJ + (size_t)b * SEQ * NPROJ_PAD + C_NKV + (4 + g) * 64; const bf16* vb = (const bf16*)(ws + WS_VTG) + ((size_t)((b * 2 + 0) * 2 + g) * 64) * SEQ;
        const int jl = qt;
        NSA_BRANCH(0, (((mysel >> j_) & 1ull) ? (j_ < qt ? ~0ull : causal) : 0ull), j_ == qt);
        const float sc = gs / fmaxf(st.l, 1e-30f);
#pragma unroll
        for (int i = 0; i < 16; ++i) { PARK[(2 * i) * NTHREADS] += st.o0[i] * sc; PARK[(2 * i + 1) * NTHREADS] += st.o1[i] * sc; }
    }
    {
        State st; st_init(st);
        const int j0 = qt >= 8 ? qt - 8 : 0, jl = qt;
        const bf16* kb = PROJ + (size_t)b * SEQ * NPROJ_PAD + C_WIN + g * 64; const bf16* vb = (const bf16*)(ws + WS_VTG) + ((size_t)((b * 2 + 1) * 2 + g) * 64) * SEQ;
        NSA_BRANCH(j0, ((j_ == qt) ? causal : (j_ == qt - 8 ? ~causal : ~0ull)), (j_ == qt || j_ == qt - 8));
        const float sc = gw / fmaxf(st.l, 1e-30f);
#pragma unroll
        for (int i = 0; i < 16; ++i) { acc0[i] = PARK[(2 * i) * NTHREADS] + st.o0[i] * sc; acc1[i] = PARK[(2 * i + 1) * NTHREADS] + st.o1[i] * sc; }
    }
#undef NSA_ITER
#undef NSA_BRANCH
    bf16* op = dst + row * DM + 512 + (g * 4 + r) * 64 + 4 * h;
#pragma unroll
    for (int i = 0; i < 4; ++i) {
        v2u w0; w0.x = pk2(acc0[4 * i], acc0[4 * i + 1]); w0.y = pk2(acc0[4 * i + 2], acc0[4 * i + 3]); *(GAS v2u*)(op + 8 * i) = w0;
        v2u w1; w1.x = pk2(acc1[4 * i], acc1[4 * i + 1]); w1.y = pk2(acc1[4 * i + 2], acc1[4 * i + 3]); *(GAS v2u*)(op + 32 + 8 * i) = w1;
    }
    __syncthreads();
}
}
namespace dn {
constexpr int RS = 144;
constexpr int OP_BYTES = 8192;
__device__ __forceinline__ bf16x8 ldfrag(const LAS unsigned char* img, int row, int kb) { return *(const LAS bf16x8*)(img + row * RS + kb * 2); }

template <int IB> __device__ __forceinline__ void trec_block(LAS unsigned char* AT, float (&Tc)[64], int lane) {
#pragma unroll
    for (int ii = 0; ii < 8; ++ii) {
        const int i = 8 * IB + ii;
        asm volatile("" ::: "memory");
        float acc4[4] = {(lane == i) ? 1.f : 0.f, 0.f, 0.f, 0.f};
#pragma unroll
        for (int mc = 0; mc <= IB; ++mc) {
            if (8 * mc < i) {
                const v4u w = *(const LAS v4u*)(AT + i * RS + mc * 16);
                const unsigned ww[4] = {w.x, w.y, w.z, w.w};
#pragma unroll
                for (int e = 0; e < 8; ++e) { const int m = 8 * mc + e; if (m < i) acc4[e & 3] -= ((e & 1) ? bfhi(ww[e >> 1]) : bflo(ww[e >> 1])) * Tc[m]; }
            }
        }
        const float acc = (acc4[0] + acc4[1]) + (acc4[2] + acc4[3]);
        Tc[i] = acc;
        *(LAS bf16*)(AT + i * RS + lane * 2) = (bf16)(pk2(acc, 0.f) & 0xffffu);
    }
}

__device__ __forceinline__ void prep_wave(const Args& a, LAS unsigned char* wlds, int b, int n, int h, int lane) {
    unsigned char* ws = a.ws; asm volatile("" : "+s"(ws));
    asm volatile("" : "+v"(lane));
    const int fr = lane & 15, fq = lane >> 4;
    const int row0 = b * SEQ + n * 64, ch = (b * 64 + n) * 8 + h;
    const bf16* PROJ = (const bf16*)(ws + WS_PROJ);
    bf16* OPS = (bf16*)(ws + WS_DN + (size_t)ch * 5 * OP_BYTES);
    LAS unsigned char* AT = wlds;
    LAS unsigned char* XT = wlds + 64 * RS;
    float beta_l, gcum_l;
    { const float* BA = (const float*)(ws + WS_BA) + (size_t)(row0 + lane) * 16;
      beta_l = 1.f / (1.f + expf(-BA[h])); const float xx = BA[8 + h] + a.in[I_DTB][h];
      gcum_l = -expf(a.in[I_ALOG][h]) * (xx > 20.f ? xx : log1pf(expf(xx))); }
#pragma unroll
    for (int o = 1; o < 64; o <<= 1) { const float t = __shfl_up(gcum_l, o); if (lane >= o) gcum_l += t; }
    const float glast = __shfl(gcum_l, 63);
    float beta_f[4], gc_f[4];
#pragma unroll
    for (int mt = 0; mt < 4; ++mt) { beta_f[mt] = __shfl(beta_l, 16 * mt + fr); gc_f[mt] = __shfl(gcum_l, 16 * mt + fr); }
    if (lane == 0) ((float*)(ws + WS_GLAST))[ch] = __expf(glast);
    LAS float* CW = (LAS float*)AT;
    { const float* cw = a.in[I_CONVW];
#pragma unroll
      for (int i = 0; i < 12; ++i) { const int e = i * 64 + lane, which = e >> 8, d = (e >> 2) & 63, tap = e & 3; CW[e] = cw[tap * 1536 + which * 512 + h * 64 + d]; } }
    LDS_WAIT(); asm volatile("" ::: "memory");
    bf16x8 Qf[4][2], Kf[4][2], Vf[4][2];
    auto issue_raw = [&](v4u (&raw)[2][4], int mt, int which) {
        const int c = 16 * mt + fr, t = n * 64 + c;
#pragma unroll
        for (int ks = 0; ks < 2; ++ks) {
            const bf16* src = PROJ + (size_t)(row0 + c - 3) * NPROJ_PAD + which * 512 + h * 64 + 32 * ks + 8 * fq;
#pragma unroll
            for (int tap = 0; tap < 4; ++tap) { raw[ks][tap] = (v4u){0u, 0u, 0u, 0u}; if (t - 3 + tap >= 0) raw[ks][tap] = *(const GAS v4u*)(src + (size_t)tap * NPROJ_PAD); }
        }
    };
    auto conv_step = [&](const v4u (&raw)[2][4], int mt, int which) {
        float cv[2][8];
#pragma unroll
        for (int ks = 0; ks < 2; ++ks)
#pragma unroll
            for (int e = 0; e < 8; ++e) {
                const f32x4 w4 = *(const LAS f32x4*)(CW + (which * 64 + 32 * ks + 8 * fq + e) * 4);
                float acc = 0.f;
#pragma unroll
                for (int tap = 0; tap < 4; ++tap) { const unsigned wd = (e >> 1) == 0 ? raw[ks][tap].x : (e >> 1) == 1 ? raw[ks][tap].y : (e >> 1) == 2 ? raw[ks][tap].z : raw[ks][tap].w;
                    acc += w4[tap] * ((e & 1) ? bfhi(wd) : bflo(wd)); }
                cv[ks][e] = acc / (1.f + __expf(-acc));
            }
        float sc = beta_f[mt];
        if (which < 2) { float sq = 0.f;
#pragma unroll
            for (int ks = 0; ks < 2; ++ks)
#pragma unroll
                for (int e = 0; e < 8; ++e) sq += cv[ks][e] * cv[ks][e];
            sq += __shfl_xor(sq, 16); sq += __shfl_xor(sq, 32);
            sc = rsqrtf(sq + 1e-6f) * (which == 0 ? 0.125f : 1.f); }
#pragma unroll
        for (int ks = 0; ks < 2; ++ks) {
            v4u w; w.x = pk2(cv[ks][0] * sc, cv[ks][1] * sc); w.y = pk2(cv[ks][2] * sc, cv[ks][3] * sc); w.z = pk2(cv[ks][4] * sc, cv[ks][5] * sc); w.w = pk2(cv[ks][6] * sc, cv[ks][7] * sc);
            if (which == 0) Qf[mt][ks] = __builtin_bit_cast(bf16x8, w); else if (which == 1) Kf[mt][ks] = __builtin_bit_cast(bf16x8, w); else Vf[mt][ks] = __builtin_bit_cast(bf16x8, w);
        }
    };
    v4u rawA[2][4], rawB[2][4];
    issue_raw(rawA, 0, 0);
#pragma unroll
    for (int s2 = 0; s2 < 12; s2 += 2) {
        asm volatile("" ::: "memory");
        issue_raw(rawB, (s2 + 1) / 3, (s2 + 1) % 3);
        conv_step(rawA, s2 / 3, s2 % 3);
        asm volatile("" ::: "memory");
        if (s2 + 2 < 12) issue_raw(rawA, (s2 + 2) / 3, (s2 + 2) % 3);
        conv_step(rawB, (s2 + 1) / 3, (s2 + 1) % 3);
    }
    LDS_WAIT(); asm volatile("" ::: "memory");
#pragma unroll
    for (int mt = 0; mt < 4; ++mt)
#pragma unroll
        for (int nt = 0; nt < 4; ++nt) {
            v2u wa = {0u, 0u}, wq = {0u, 0u};
            if (nt <= mt) {
                f32x4 kk = {0.f, 0.f, 0.f, 0.f}, qk = {0.f, 0.f, 0.f, 0.f};
#pragma unroll
                for (int ks = 0; ks < 2; ++ks) { kk = MFMA16(Kf[nt][ks], Kf[mt][ks], kk); qk = MFMA16(Kf[nt][ks], Qf[mt][ks], qk); }
                float av[4], qv[4];
#pragma unroll
                for (int r = 0; r < 4; ++r) {
                    const int cp = 16 * nt + 4 * fq + r, c = 16 * mt + fr;
                    const float gcp = __shfl(gcum_l, cp);
                    const float dec = __expf(fminf(gc_f[mt] - gcp, 0.f));
                    av[r] = (c > cp) ? beta_f[mt] * kk[r] * dec : 0.f;
                    qv[r] = (c >= cp) ? qk[r] * dec : 0.f;
                }
                wa.x = pk2(av[0], av[1]); wa.y = pk2(av[2], av[3]); wq.x = pk2(qv[0], qv[1]); wq.y = pk2(qv[2], qv[3]);
            }
            *(LAS v2u*)(AT + (16 * mt + fr) * RS + (16 * nt + 4 * fq) * 2) = wa;
            *(GAS v2u*)(OPS + 4 * 4096 + (16 * mt + fr) * 64 + 16 * nt + 4 * fq) = wq;
        }
#pragma unroll
    for (int mt = 0; mt < 4; ++mt) { const float e = __expf(gc_f[mt]);
#pragma unroll
        for (int ks = 0; ks < 2; ++ks) { const v4u w = __builtin_bit_cast(v4u, Qf[mt][ks]); v4u o;
            o.x = pk2(bflo(w.x) * e, bfhi(w.x) * e); o.y = pk2(bflo(w.y) * e, bfhi(w.y) * e); o.z = pk2(bflo(w.z) * e, bfhi(w.z) * e); o.w = pk2(bflo(w.w) * e, bfhi(w.w) * e);
            *(GAS v4u*)(OPS + 2 * 4096 + (16 * mt + fr) * 64 + 32 * ks + 8 * fq) = o; } }
    LDS_WAIT(); asm volatile("" ::: "memory");
    {
        float Tc[64];
        trec_block<0>(AT, Tc, lane); trec_block<1>(AT, Tc, lane); trec_block<2>(AT, Tc, lane); trec_block<3>(AT, Tc, lane);
        trec_block<4>(AT, Tc, lane); trec_block<5>(AT, Tc, lane); trec_block<6>(AT, Tc, lane); trec_block<7>(AT, Tc, lane);
    }
    LDS_WAIT(); asm volatile("" ::: "memory");
    bf16x8 Tf[4][2];
#pragma unroll
    for (int mt = 0; mt < 4; ++mt)
#pragma unroll
        for (int ks = 0; ks < 2; ++ks) Tf[mt][ks] = ldfrag(AT, 16 * mt + fr, 32 * ks + 8 * fq);
#pragma unroll
    for (int mt = 0; mt < 4; ++mt)
#pragma unroll
        for (int ks = 0; ks < 2; ++ks) {
            const v4u w = __builtin_bit_cast(v4u, Vf[mt][ks]);
            const unsigned ww[4] = {w.x, w.y, w.z, w.w};
#pragma unroll
            for (int e = 0; e < 4; ++e) { *(LAS bf16*)(XT + (32 * ks + 8 * fq + 2 * e) * RS + (16 * mt + fr) * 2) = (bf16)(ww[e] & 0xffffu);
                *(LAS bf16*)(XT + (32 * ks + 8 * fq + 2 * e + 1) * RS + (16 * mt + fr) * 2) = (bf16)(ww[e] >> 16); }
        }
    LDS_WAIT(); asm volatile("" ::: "memory");
#pragma unroll
    for (int mt = 0; mt < 4; ++mt)
#pragma unroll
        for (int nt = 0; nt < 4; ++nt) {
            f32x4 acc = {0.f, 0.f, 0.f, 0.f};
#pragma unroll
            for (int ks = 0; ks < 2; ++ks) acc = MFMA16(Tf[mt][ks], ldfrag(XT, 16 * nt + fr, 32 * ks + 8 * fq), acc);
            v2u o; o.x = pk2(acc[0], acc[1]); o.y = pk2(acc[2], acc[3]);
            *(GAS v2u*)(OPS + 0 * 4096 + ((mt * 4 + nt) * 64 + lane) * 4) = o;
        }
    LDS_WAIT(); asm volatile("" ::: "memory");
#pragma unroll
    for (int mt = 0; mt < 4; ++mt) { const float sc = beta_f[mt] * __expf(gc_f[mt]);
#pragma unroll
        for (int ks = 0; ks < 2; ++ks) { const v4u w = __builtin_bit_cast(v4u, Kf[mt][ks]); const unsigned ww[4] = {w.x, w.y, w.z, w.w};
#pragma unroll
            for (int e = 0; e < 8; ++e) { const float v = ((e & 1) ? bfhi(ww[e >> 1]) : bflo(ww[e >> 1])) * sc;
                *(LAS bf16*)(XT + (32 * ks + 8 * fq + e) * RS + (16 * mt + fr) * 2) = (bf16)(pk2(v, 0.f) & 0xffffu); } } }
    LDS_WAIT(); asm volatile("" ::: "memory");
#pragma unroll
    for (int mt = 0; mt < 4; ++mt)
#pragma unroll
        for (int nt = 0; nt < 4; ++nt) {
            f32x4 acc = {0.f, 0.f, 0.f, 0.f};
#pragma unroll
            for (int ks = 0; ks < 2; ++ks) acc = MFMA16(ldfrag(XT, 16 * nt + fr, 32 * ks + 8 * fq), Tf[mt][ks], acc);
            v2u o; o.x = pk2(acc[0], acc[1]); o.y = pk2(acc[2], acc[3]);
            *(GAS v2u*)(OPS + 1 * 4096 + (16 * mt + fr) * 64 + 16 * nt + 4 * fq) = o;
        }
    LDS_WAIT(); asm volatile("" ::: "memory");
#pragma unroll
    for (int mt = 0; mt < 4; ++mt) { const float sc = __expf(glast - gc_f[mt]);
#pragma unroll
        for (int ks = 0; ks < 2; ++ks) { const v4u w = __builtin_bit_cast(v4u, Kf[mt][ks]); const unsigned ww[4] = {w.x, w.y, w.z, w.w};
#pragma unroll
            for (int e = 0; e < 8; ++e) { const float v = ((e & 1) ? bfhi(ww[e >> 1]) : bflo(ww[e >> 1])) * sc;
                *(LAS bf16*)(XT + (32 * ks + 8 * fq + e) * RS + (16 * mt + fr) * 2) = (bf16)(pk2(v, 0.f) & 0xffffu); } } }
    LDS_WAIT(); asm volatile("" ::: "memory");
#pragma unroll
    for (int i = 0; i < 8; ++i) { const int piece = i * 64 + lane, rr = piece >> 3, cc = piece & 7;
        *(GAS v4u*)(OPS + 3 * 4096 + rr * 64 + cc * 8) = *(const LAS v4u*)(XT + rr * RS + cc * 16); }
    LDS_WAIT(); asm volatile("" ::: "memory");
}

constexpr int L_OPS = 0;
constexpr int L_ST = 2 * 4 * 64 * RS, L_VNT = L_ST + 2 * 64 * RS, L_SSQ = L_VNT + 64 * RS, L_EG = L_SSQ + 2 * 8 * 16 * 4, L_SCAN_END = L_EG + 64 * 4;
static_assert(L_SCAN_END <= RING_BYTES, "dn scan lds");
__device__ __forceinline__ void scan_finish(const f32x4 (&o)[2], const v2u (&z)[2], const f32x4 (&gn)[2], const LAS float* ssq, int wave, int fr, bf16* dst) {
    const float ss = ssq[wave * 16 + fr] + ssq[(wave ^ 1) * 16 + fr];
    const float rs = rsqrtf(ss * (1.f / 64.f) + RMS_EPS);
#pragma unroll
    for (int t = 0; t < 2; ++t) {
        const float zz[4] = {bflo(z[t].x), bfhi(z[t].x), bflo(z[t].y), bfhi(z[t].y)}; float y[4];
#pragma unroll
        for (int r = 0; r < 4; ++r) y[r] = o[t][r] * rs * gn[t][r] * (zz[r] / (1.f + __expf(-zz[r])));
        v2u w; w.x = pk2(y[0], y[1]); w.y = pk2(y[2], y[3]);
        *(GAS v2u*)(dst + 16 * t) = w;
    }
}
struct ScanPre { v4u op[4]; v2u u[2]; };
__device__ __forceinline__ void scan_unit(const Args& a, LAS unsigned char* lds, int b, int h, int tid, bf16* MIX, float* recbase) {
    unsigned char* ws = a.ws; asm volatile("" : "+s"(ws));
    asm volatile("" : "+v"(tid));
    const int lane = tid & 63, wave = __builtin_amdgcn_readfirstlane(tid >> 6), fr = lane & 15, fq = lane >> 4;
    const int mt = wave >> 1, nt0 = 2 * (wave & 1);
    for (int i = tid; i < 64 * RS / 4; i += NTHREADS) ((LAS unsigned*)(lds + L_ST))[i] = 0u;
    LAS float* EG = (LAS float*)(lds + L_EG);
    if (tid < NCHUNK) EG[tid] = ((const float*)(ws + WS_GLAST))[((size_t)b * 64 + tid) * 8 + h];
    f32x4 Sacc[2] = {{0.f, 0.f, 0.f, 0.f}, {0.f, 0.f, 0.f, 0.f}};
    const int prow = tid >> 3, pcol = tid & 7;
    const size_t chbase = ((size_t)b * 64 * 8 + h) * 5 * 4096;
    const bf16* OPS0 = (const bf16*)(ws + WS_DN) + chbase;
    const bf16* PROJ = (const bf16*)(ws + WS_PROJ);
    f32x4 gn[2];
#pragma unroll
    for (int t = 0; t < 2; ++t) gn[t] = *(const f32x4*)(a.in[I_DNNORM] + 16 * (nt0 + t) + 4 * fq);
    auto issue = [&](ScanPre& p, int n) {
        const bf16* o = OPS0 + (size_t)n * 8 * 5 * 4096;
#pragma unroll
        for (int q = 0; q < 4; ++q) p.op[q] = __builtin_nontemporal_load((const v4u*)(o + (1 + q) * 4096 + prow * 64 + pcol * 8));
#pragma unroll
        for (int t = 0; t < 2; ++t) p.u[t] = __builtin_nontemporal_load((const v2u*)(o + ((mt * 4 + nt0 + t) * 64 + lane) * 4));
    };
    auto commit = [&](const ScanPre& p, int buf) {
#pragma unroll
        for (int q = 0; q < 4; ++q) *(LAS v4u*)(lds + L_OPS + (buf * 4 + q) * 64 * RS + prow * RS + pcol * 16) = p.op[q];
    };
    f32x4 oprev[2] = {{0.f, 0.f, 0.f, 0.f}, {0.f, 0.f, 0.f, 0.f}}; v2u zprev[2] = {{0u, 0u}, {0u, 0u}};
    LAS float* SSQ = (LAS float*)(lds + L_SSQ);
    auto step = [&](int n, const v2u (&ucur)[2]) {
        const int buf = n & 1;
        const LAS unsigned char* Wl = lds + L_OPS + (buf * 4 + 0) * 64 * RS; const LAS unsigned char* QSl = Wl + 64 * RS; const LAS unsigned char* KDl = QSl + 64 * RS; const LAS unsigned char* AQl = KDl + 64 * RS;
        const LAS unsigned char* STc = lds + L_ST + buf * 64 * RS; LAS unsigned char* STn = lds + L_ST + (buf ^ 1) * 64 * RS; LAS unsigned char* VNT = lds + L_VNT;
        const float eg = EG[n];
        const size_t rowc = (size_t)b * SEQ + n * 64 + 16 * mt + fr;
        v2u zcur[2];
#pragma unroll
        for (int t = 0; t < 2; ++t) zcur[t] = *(const GAS v2u*)(PROJ + rowc * NPROJ_PAD + C_Z + h * 64 + 16 * (nt0 + t) + 4 * fq);
        if (n > 0) scan_finish(oprev, zprev, gn, SSQ + ((n - 1) & 1) * 128, wave, fr, MIX + (rowc - 64) * DM + h * 64 + 16 * nt0 + 4 * fq);
#pragma unroll
        for (int t = 0; t < 2; ++t) {
            f32x4 acc = {0.f, 0.f, 0.f, 0.f};
#pragma unroll
            for (int ks = 0; ks < 2; ++ks) acc = MFMA16(ldfrag(Wl, 16 * mt + fr, 32 * ks + 8 * fq), ldfrag(STc, 16 * (nt0 + t) + fr, 32 * ks + 8 * fq), acc);
            const float u0 = bflo(ucur[t].x), u1 = bfhi(ucur[t].x), u2 = bflo(ucur[t].y), u3 = bfhi(ucur[t].y);
            v2u o; o.x = pk2(u0 - acc[0], u1 - acc[1]); o.y = pk2(u2 - acc[2], u3 - acc[3]);
            *(LAS v2u*)(VNT + (16 * (nt0 + t) + fr) * RS + (16 * mt + 4 * fq) * 2) = o;
        }
        BAR_LDS();
        float ssp = 0.f;
#pragma unroll
        for (int t = 0; t < 2; ++t) {
            f32x4 acc = {0.f, 0.f, 0.f, 0.f};
#pragma unroll
            for (int ks = 0; ks < 2; ++ks) {
                acc = MFMA16(ldfrag(STc, 16 * (nt0 + t) + fr, 32 * ks + 8 * fq), ldfrag(QSl, 16 * mt + fr, 32 * ks + 8 * fq), acc);
                acc = MFMA16(ldfrag(VNT, 16 * (nt0 + t) + fr, 32 * ks + 8 * fq), ldfrag(AQl, 16 * mt + fr, 32 * ks + 8 * fq), acc);
            }
            oprev[t] = acc; zprev[t] = zcur[t];
            ssp += (acc[0] * acc[0] + acc[1] * acc[1]) + (acc[2] * acc[2] + acc[3] * acc[3]);
        }
        ssp += __shfl_xor(ssp, 16); ssp += __shfl_xor(ssp, 32);
        if (fq == 0) SSQ[(n & 1) * 128 + wave * 16 + fr] = ssp;
#pragma unroll
        for (int t = 0; t < 2; ++t) {
            f32x4 acc = Sacc[t] * eg;
#pragma unroll
            for (int ks = 0; ks < 2; ++ks) acc = MFMA16(ldfrag(KDl, 16 * mt + fr, 32 * ks + 8 * fq), ldfrag(VNT, 16 * (nt0 + t) + fr, 32 * ks + 8 * fq), acc);
            Sacc[t] = acc;
            v2u o; o.x = pk2(acc[0], acc[1]); o.y = pk2(acc[2], acc[3]);
            *(LAS v2u*)(STn + (16 * (nt0 + t) + fr) * RS + (16 * mt + 4 * fq) * 2) = o;
        }
    };
    ScanPre pa, pb;
    issue(pa, 0); commit(pa, 0);
    v2u u0[2] = {pa.u[0], pa.u[1]}, u1[2];
    issue(pb, 1); issue(pa, 2);
#pragma unroll 1
    for (int n = 0; n < NCHUNK; n += 2) {
        BAR_LDS();
        commit(pb, 1); u1[0] = pb.u[0]; u1[1] = pb.u[1];
        if (n + 3 < NCHUNK) issue(pb, n + 3);
        step(n, u0);
        BAR_LDS();
        if (n + 2 < NCHUNK) { commit(pa, 0); u0[0] = pa.u[0]; u0[1] = pa.u[1]; }
        if (n + 4 < NCHUNK) issue(pa, n + 4);
        step(n + 1, u1);
    }
    BAR_LDS();
    scan_finish(oprev, zprev, gn, SSQ + ((NCHUNK - 1) & 1) * 128, wave, fr, MIX + ((size_t)b * SEQ + (NCHUNK - 1) * 64 + 16 * mt + fr) * DM + h * 64 + 16 * nt0 + 4 * fq);
    float* rec = recbase + (size_t)(b * 8 + h) * 4096;
#pragma unroll
    for (int t = 0; t < 2; ++t)
#pragma unroll
        for (int r = 0; r < 4; ++r) rec[(16 * mt + 4 * fq + r) * 64 + 16 * (nt0 + t) + fr] = Sacc[t][r];
    __syncthreads();
}
}
namespace mem {
constexpr int KS = 528, VS = 80, L_K = 0, L_V = 2 * 32 * KS, L_END = L_V + 2 * 256 * VS;
static_assert(L_END <= RING_BYTES, "mem lds");
constexpr float CEXP = 0.0625f * 1.44269504088896f;
struct Pre { v4u k[2], v[2]; };
__device__ __forceinline__ void tload(Pre& p, const bf16* kv, int key0, int tid) {
#pragma unroll
    for (int r = 0; r < 2; ++r) { const int pc = tid + 512 * r;
        p.k[r] = *(const GAS v4u*)(kv + (size_t)(key0 + (pc >> 5)) * 2048 + (pc & 31) * 8);
        p.v[r] = *(const GAS v4u*)(kv + (size_t)(key0 + (pc & 31)) * 2048 + 1024 + (pc >> 5) * 8); }
}
__device__ __forceinline__ void tstore(const Pre& p, LAS unsigned char* Kt, LAS unsigned char* Vt, int tid) {
#pragma unroll
    for (int r = 0; r < 2; ++r) { const int pc = tid + 512 * r;
        *(LAS v4u*)(Kt + (pc >> 5) * KS + (pc & 31) * 16) = p.k[r];
        LAS unsigned char* vp = Vt + (8 * (pc >> 5)) * VS + (pc & 31) * 2;
        const unsigned w[4] = {p.v[r].x, p.v[r].y, p.v[r].z, p.v[r].w};
#pragma unroll
        for (int e = 0; e < 4; ++e) { *(LAS bf16*)(vp + (2 * e) * VS) = (bf16)(w[e] & 0xffffu); *(LAS bf16*)(vp + (2 * e + 1) * VS) = (bf16)(w[e] >> 16); } }
}
__device__ __forceinline__ void prompt_unit(const Args& a, LAS unsigned char* lds, int b, int head, int tt, int tid, bf16* OMp) {
    unsigned char* ws = a.ws; asm volatile("" : "+s"(ws));
    asm volatile("" : "+v"(tid));
    const int lane = tid & 63, wave = __builtin_amdgcn_readfirstlane(tid >> 6), fr = lane & 15, fq = lane >> 4;
    const size_t row = (size_t)b * SEQ + tt * 128 + wave * 16 + fr;
    const bf16* qp = (const bf16*)(ws + WS_QM) + row * DM + head * 256 + 8 * fq;
    bf16x8 Qf[8];
#pragma unroll
    for (int ks = 0; ks < 8; ++ks) Qf[ks] = __builtin_nontemporal_load((const bf16x8*)(qp + 32 * ks));
    const bf16* kv = (const bf16*)(ws + WS_MEMKV) + (size_t)(b * MEMLEN) * 2048 + head * 256;
    f32x4 O[16];
#pragma unroll
    for (int i = 0; i < 16; ++i) O[i] = (f32x4){0.f, 0.f, 0.f, 0.f};
    float m = -1e30f, l = 0.f;
    Pre pre; tload(pre, kv, 0, tid);
#pragma unroll 1
    for (int t = 0; t < 8; ++t) {
        LAS unsigned char* Kt = lds + L_K + (t & 1) * 32 * KS; LAS unsigned char* Vt = lds + L_V + (t & 1) * 256 * VS;
        tstore(pre, Kt, Vt, tid);
        BAR_LDS();
        if (t < 7) tload(pre, kv, 32 * (t + 1), tid);
        f32x4 s0 = {0.f, 0.f, 0.f, 0.f}, s1 = {0.f, 0.f, 0.f, 0.f};
#pragma unroll
        for (int ks = 0; ks < 8; ++ks) {
            s0 = MFMA16(*(const LAS bf16x8*)(Kt + fr * KS + (32 * ks + 8 * fq) * 2), Qf[ks], s0);
            s1 = MFMA16(*(const LAS bf16x8*)(Kt + (16 + fr) * KS + (32 * ks + 8 * fq) * 2), Qf[ks], s1);
        }
        float mx = fmaxf(fmaxf(fmaxf(s0[0], s0[1]), fmaxf(s0[2], s0[3])), fmaxf(fmaxf(s1[0], s1[1]), fmaxf(s1[2], s1[3])));
        mx = fmaxf(mx, __shfl_xor(mx, 16)); mx = fmaxf(mx, __shfl_xor(mx, 32));
        const float mn = fmaxf(m, mx), alpha = fast_exp2((m - mn) * CEXP);
        float ps = 0.f;
#pragma unroll
        for (int i = 0; i < 4; ++i) { s0[i] = fast_exp2((s0[i] - mn) * CEXP); s1[i] = fast_exp2((s1[i] - mn) * CEXP); ps += s0[i] + s1[i]; }
        ps += __shfl_xor(ps, 16); ps += __shfl_xor(ps, 32);
        l = l * alpha + ps; m = mn;
        v4u pw; pw.x = pk2(s0[0], s0[1]); pw.y = pk2(s0[2], s0[3]); pw.z = pk2(s1[0], s1[1]); pw.w = pk2(s1[2], s1[3]);
        const bf16x8 pb = __builtin_bit_cast(bf16x8, pw);
#pragma unroll
        for (int dt = 0; dt < 16; ++dt) {
            const LAS unsigned char* vr = Vt + (16 * dt + fr) * VS + (4 * fq) * 2;
            const v2u lo = *(const LAS v2u*)vr, hi = *(const LAS v2u*)(vr + 32);
            v4u aw; aw.x = lo.x; aw.y = lo.y; aw.z = hi.x; aw.w = hi.y;
            O[dt] = MFMA16(__builtin_bit_cast(bf16x8, aw), pb, O[dt] * alpha);
        }
    }
    const float inv = 1.f / l;
    bf16* op = OMp + row * DM + head * 256 + 4 * fq;
#pragma unroll
    for (int dt = 0; dt < 16; ++dt) { v2u w; w.x = pk2(O[dt][0] * inv, O[dt][1] * inv); w.y = pk2(O[dt][2] * inv, O[dt][3] * inv); *(GAS v2u*)(op + 16 * dt) = w; }
    __syncthreads();
}

__device__ __forceinline__ void sample_unit(const Args& a, LAS unsigned char* lds, int s, int head, int tid, bf16* OMp) {
    unsigned char* ws = a.ws; asm volatile("" : "+s"(ws));
    asm volatile("" : "+v"(tid));
    const int lane = tid & 63, wave = __builtin_amdgcn_readfirstlane(tid >> 6);
    LAS float* SC = (LAS float*)lds; LAS float* RED = SC + 256;
    const size_t row = (size_t)MP + s;
    const v2u qw = *(const GAS v2u*)((const bf16*)(ws + WS_QM) + row * DM + head * 256 + 4 * lane);
    const f32x4 q = {bflo(qw.x), bfhi(qw.x), bflo(qw.y), bfhi(qw.y)};
    const float* kb = a.in[I_CMEM] + ((size_t)(s * MEMLEN + wave * 32) * 2) * 1024 + head * 256 + 4 * lane;
    float sc_own = 0.f;
#pragma unroll 8
    for (int i = 0; i < 32; ++i) {
        const f32x4 kx = ld_nt(kb + (size_t)i * 2048);
        float d = (q.x * kx.x + q.y * kx.y) + (q.z * kx.z + q.w * kx.w);
        d = wave_sum(d);
        sc_own = (lane == i) ? d : sc_own;
    }
    if (lane < 32) SC[wave * 32 + lane] = sc_own * 0.0625f;
    BAR_LDS();
    const f32x4 all = *(const LAS f32x4*)(SC + 4 * lane);
    float mx = fmaxf(fmaxf(all.x, all.y), fmaxf(all.z, all.w));
#pragma unroll
    for (int o = 1; o < 64; o <<= 1) mx = fmaxf(mx, __shfl_xor(mx, o));
    float sum = (__expf(all.x - mx) + __expf(all.y - mx)) + (__expf(all.z - mx) + __expf(all.w - mx));
    sum = wave_sum(sum);
    const float p_own = __expf(sc_own * 0.0625f - mx) / sum;
    f32x4 o = {0.f, 0.f, 0.f, 0.f};
    const float* vb = kb + 1024;
#pragma unroll 8
    for (int i = 0; i < 32; ++i) { const f32x4 vx = ld_nt(vb + (size_t)i * 2048); const float pi = __shfl(p_own, i); o = o + vx * pi; }
    *(LAS f32x4*)(RED + wave * 256 + 4 * lane) = o;
    BAR_LDS();
    if (tid < 256) { float acc = 0.f;
#pragma unroll
        for (int w = 0; w < 8; ++w) acc += RED[w * 256 + tid];
        OMp[row * DM + head * 256 + tid] = (bf16)(pk2(acc, 0.f) & 0xffffu); }
    __syncthreads();
}
}
namespace cmp {
constexpr int RS = 144, HS = 272;
constexpr int L_A = 0, L_B = 2 * 64 * RS, L_H = L_B + 2 * 128 * RS, L_W2 = L_H + 64 * HS, L_BIAS = L_W2 + 64 * HS, L_END = L_BIAS + 512;
static_assert(L_END <= RING_BYTES, "cmp lds");
template <bool SAMPLE> __device__ __forceinline__ void unit(const Args& a, LAS unsigned char* lds, int seq, int kind, int hf, int tid, float* kcs, float* kcp, int var = 0) {
    unsigned char* ws = a.ws; asm volatile("" : "+s"(ws));
    asm volatile("" : "+v"(tid));
    const int lane = tid & 63, wave = __builtin_amdgcn_readfirstlane(tid >> 6), fr = lane & 15, fq = lane >> 4, mt = wave & 3, half = wave >> 2;
    const bf16* w1t = (const bf16*)(ws + WS_W1_T) + (size_t)kind * 128 * 4096;
    const float* arow[2]; const bf16* arowh = nullptr;
    if (SAMPLE) {
        const int* pt = (const int*)a.in[I_PT] + seq * NPAGES;
#pragma unroll
        for (int r = 0; r < 2; ++r) { const int p = tid + 512 * r, rowA = p >> 4, c4 = p & 15, n = rowA >> 1, g = rowA & 1;
            arow[r] = a.in[I_CNSA] + ((size_t)pt[n >> 1] * PAGE + (n & 1) * 64) * 512 + (kind * 2 + g) * 64 + c4 * 4; }
    } else {
        const int rowA = tid >> 3, c8 = tid & 7, n = 32 * hf + (rowA >> 1), g = rowA & 1;
        arowh = (const bf16*)(ws + WS_PROJ) + (size_t)(seq * SEQ + n * 64) * NPROJ_PAD + C_NKV + (kind * 2 + g) * 64 + c8 * 8;
        arow[0] = arow[1] = nullptr;
    }
    struct Stage { f32x4 af[2]; v4u ah; v4u bw[2]; };
    auto issue = [&](Stage& st, int c) {
        if (SAMPLE) { st.af[0] = ld_nt(arow[0] + (size_t)c * 512); st.af[1] = ld_nt(arow[1] + (size_t)c * 512); }
        else st.ah = *(const GAS v4u*)(arowh + (size_t)c * NPROJ_PAD);
#pragma unroll
        for (int r = 0; r < 2; ++r) { const int p = tid + 512 * r; st.bw[r] = *(const GAS v4u*)(w1t + (size_t)(p >> 3) * 4096 + c * 64 + (p & 7) * 8); }
    };
    auto commit = [&](const Stage& st, int buf) {
        LAS unsigned char* A = lds + L_A + buf * 64 * RS; LAS unsigned char* B = lds + L_B + buf * 128 * RS;
        if (SAMPLE) {
#pragma unroll
            for (int r = 0; r < 2; ++r) { const int p = tid + 512 * r; v2u w; w.x = pk2(st.af[r].x, st.af[r].y); w.y = pk2(st.af[r].z, st.af[r].w); *(LAS v2u*)(A + (p >> 4) * RS + (p & 15) * 8) = w; }
        } else *(LAS v4u*)(A + (tid >> 3) * RS + (tid & 7) * 16) = st.ah;
#pragma unroll
        for (int r = 0; r < 2; ++r) { const int p = tid + 512 * r; *(LAS v4u*)(B + (p >> 3) * RS + (p & 7) * 16) = st.bw[r]; }
    };
    f32x4 acc[4];
#pragma unroll
    for (int i = 0; i < 4; ++i) acc[i] = (f32x4){0.f, 0.f, 0.f, 0.f};
    auto compute = [&](int buf) {
        const LAS unsigned char* A = lds + L_A + buf * 64 * RS; const LAS unsigned char* B = lds + L_B + buf * 128 * RS;
        bf16x8 af[2], bfr[2][4];
#pragma unroll
        for (int ks = 0; ks < 2; ++ks) { af[ks] = *(const LAS bf16x8*)(A + (16 * mt + fr) * RS + (32 * ks + 8 * fq) * 2);
#pragma unroll
            for (int nt = 0; nt < 4; ++nt) bfr[ks][nt] = *(const LAS bf16x8*)(B + (64 * half + 16 * nt + fr) * RS + (32 * ks + 8 * fq) * 2); }
        asm volatile("s_waitcnt lgkmcnt(0)" ::: "memory");
#pragma unroll
        for (int ks = 0; ks < 2; ++ks)
#pragma unroll
            for (int nt = 0; nt < 4; ++nt) acc[nt] = MFMA16(af[ks], bfr[ks][nt], acc[nt]);
    };
    Stage s0, s1, s2, s3;
    issue(s0, 0); issue(s1, 1); issue(s2, 2); issue(s3, 3);
    if (tid < 128) { float s = a.in[I_B1][kind * 128 + tid]; const float* pb = (const float*)(ws + WS_PEB) + kind * 128 + tid;
#pragma unroll 8
        for (int i = 0; i < 32; ++i) s += pb[i * 256];
        ((LAS float*)(lds + L_BIAS))[tid] = s; }
    { const float* w2 = a.in[I_W2] + (size_t)kind * 128 * 64;
#pragma unroll
      for (int r = 0; r < 16; ++r) { const int e = tid + 512 * r, hid = e >> 6, o = e & 63; *(LAS bf16*)(lds + L_W2 + o * HS + hid * 2) = (bf16)(pk2(w2[e], 0.f) & 0xffffu); } }
#pragma unroll 1
    for (int c = 0; c < 64; c += 16) {
#define CMP_STEP(ST, BUF, NEXT) do { __builtin_amdgcn_sched_barrier(0); commit(ST, BUF); BAR_LDS(); issue(ST, (NEXT) < 64 ? (NEXT) : 63); __builtin_amdgcn_sched_barrier(0); compute(BUF); __builtin_amdgcn_sched_barrier(0); } while (0)
        CMP_STEP(s0, 0, c + 4); CMP_STEP(s1, 1, c + 5); CMP_STEP(s2, 0, c + 6); CMP_STEP(s3, 1, c + 7);
        CMP_STEP(s0, 0, c + 8); CMP_STEP(s1, 1, c + 9); CMP_STEP(s2, 0, c + 10); CMP_STEP(s3, 1, c + 11);
        CMP_STEP(s0, 0, c + 12); CMP_STEP(s1, 1, c + 13); CMP_STEP(s2, 0, c + 14); CMP_STEP(s3, 1, c + 15);
        CMP_STEP(s0, 0, c + 16); CMP_STEP(s1, 1, c + 17); CMP_STEP(s2, 0, c + 18); CMP_STEP(s3, 1, c + 19);
#undef CMP_STEP
    }
#pragma unroll
    for (int nt = 0; nt < 4; ++nt) { const int hid = 64 * half + 16 * nt + fr; const float bs = ((const LAS float*)(lds + L_BIAS))[hid];
#pragma unroll
        for (int r = 0; r < 4; ++r) *(LAS bf16*)(lds + L_H + (16 * mt + 4 * fq + r) * HS + hid * 2) = (bf16)(pk2(fmaxf(acc[nt][r] + bs, 0.f), 0.f) & 0xffffu); }
    BAR_LDS();
    float* dst = SAMPLE ? kcs + (size_t)kind * (DBATCH * 32 * 2 * 64) + (size_t)seq * 64 * 64
                        : kcp + (size_t)kind * (NB * 64 * 2 * 64) + ((size_t)seq * 128 + 64 * hf) * 64;
#pragma unroll
    for (int t = 0; t < 2; ++t) { const int ot = 2 * half + t;
        f32x4 o = {0.f, 0.f, 0.f, 0.f};
#pragma unroll
        for (int ks = 0; ks < 4; ++ks) o = MFMA16(*(const LAS bf16x8*)(lds + L_H + (16 * mt + fr) * HS + (32 * ks + 8 * fq) * 2), *(const LAS bf16x8*)(lds + L_W2 + (16 * ot + fr) * HS + (32 * ks + 8 * fq) * 2), o);
#pragma unroll
        for (int r = 0; r < 4; ++r) dst[(size_t)(16 * mt + 4 * fq + r) * 64 + 16 * ot + fr] = o[r]; }
    __syncthreads();
}
}
namespace snsa {
constexpr int L_Q = 0, L_KC = 1024, L_VC = L_KC + 32 * 65 * 4, L_P = L_VC + 32 * 64 * 4, L_OC = L_P + 4 * 32 * 4, L_SEL = L_OC + 4 * 64 * 4, L_PT = L_SEL + 64, L_PART = L_PT + 64,
              PART_STRIDE = 4 * 68, L_END = L_PART + 2 * 8 * PART_STRIDE * 4;
static_assert(L_END <= RING_BYTES, "snsa lds");
constexpr float C2 = 0.125f * 1.44269504088896f;
struct St { float m[4], l[4]; f32x4 o[4]; };
__device__ __forceinline__ void st_init(St& s) {
#pragma unroll
    for (int h = 0; h < 4; ++h) { s.m[h] = -1e30f; s.l[h] = 0.f; s.o[h] = (f32x4){0.f, 0.f, 0.f, 0.f}; } }
__device__ __forceinline__ void key_step(St& st, const f32x4 (&q)[4], const f32x4 k4, const f32x4 v4, bool valid) {
#pragma unroll
    for (int h = 0; h < 4; ++h) {
        float d = (q[h].x * k4.x + q[h].y * k4.y) + (q[h].z * k4.z + q[h].w * k4.w);
        d = row16_sum(d);
        const float mn = valid ? fmaxf(st.m[h], d) : st.m[h];
        const float alpha = fast_exp2((st.m[h] - mn) * C2), p = valid ? fast_exp2((d - mn) * C2) : 0.f;
        st.l[h] = st.l[h] * alpha + p; st.o[h] = st.o[h] * alpha + v4 * p; st.m[h] = mn;
    }
}
__device__ __forceinline__ void st_merge_xor(St& st, int x) {
#pragma unroll
    for (int h = 0; h < 4; ++h) {
        const float m2 = __shfl_xor(st.m[h], x), l2 = __shfl_xor(st.l[h], x);
        f32x4 o2; o2.x = __shfl_xor(st.o[h].x, x); o2.y = __shfl_xor(st.o[h].y, x); o2.z = __shfl_xor(st.o[h].z, x); o2.w = __shfl_xor(st.o[h].w, x);
        const float M = fmaxf(st.m[h], m2), a1 = fast_exp2((st.m[h] - M) * C2), a2 = fast_exp2((m2 - M) * C2);
        st.l[h] = st.l[h] * a1 + l2 * a2; st.o[h] = st.o[h] * a1 + o2 * a2; st.m[h] = M;
    }
}
__device__ __forceinline__ void unit(const Args& a, LAS unsigned char* lds, int s, int g, int tid, bf16* MIXp) {
    unsigned char* ws = a.ws; asm volatile("" : "+s"(ws));
    asm volatile("" : "+v"(tid));
    const int lane = tid & 63, wave = __builtin_amdgcn_readfirstlane(tid >> 6), sub = lane & 15, slot = lane >> 4;
    const size_t row = (size_t)MP + s;
    LAS float* Q = (LAS float*)(lds + L_Q); LAS float* KC = (LAS float*)(lds + L_KC); LAS float* VC = (LAS float*)(lds + L_VC); LAS float* P = (LAS float*)(lds + L_P);
    LAS float* OC = (LAS float*)(lds + L_OC); LAS int* SEL = (LAS int*)(lds + L_SEL); LAS int* PT = (LAS int*)(lds + L_PT); LAS float* PART = (LAS float*)(lds + L_PART);
    if (tid < 256) Q[tid] = bf2f(((const bf16*)(ws + WS_PROJ))[row * NPROJ_PAD + C_NQ + (g * 4 + (tid >> 6)) * 64 + (tid & 63)]);
    { const float* kc = (const float*)(ws + WS_KCMP_S) + ((size_t)s * 32 * 2 + g) * 64; const float* vc = kc + (size_t)DBATCH * 32 * 2 * 64;
#pragma unroll
      for (int r = 0; r < 4; ++r) { const int e = tid + 512 * r, n = e >> 6, d = e & 63; KC[n * 65 + d] = kc[(size_t)n * 128 + d]; VC[n * 64 + d] = vc[(size_t)n * 128 + d]; } }
    if (tid < NPAGES) PT[tid] = ((const int*)a.in[I_PT])[s * NPAGES + tid];
    BAR_LDS();
    const float* cw = a.in[I_CWIN] + (size_t)s * 512 * 256 + g * 64 + 4 * sub;
    float* ow = a.out + O_SWIN + (size_t)s * 512 * 256 + g * 64 + 4 * sub;
    const float* cache = a.in[I_CNSA] + (4 + g) * 64 + 4 * sub;
    f32x4 kA[4], vA[4], kB[4], vB[4];
    St ss, sw; st_init(sw);
    auto load_win = [&](f32x4 (&kk)[4], f32x4 (&vv)[4], int base) {
#pragma unroll
        for (int u = 0; u < 4; ++u) { const int kw = 4 * (wave + 8 * (base + u)) + slot;
            const float* p = kw == 511 ? (const float*)ow + (size_t)511 * 256 : cw + (size_t)(kw + 1) * 256;
            kk[u] = ld_nt(p); vv[u] = ld_nt(p + 128); } };
    auto comp_win = [&](const f32x4 (&kk)[4], const f32x4 (&vv)[4], int base) {
        f32x4 q[4];
#pragma unroll
        for (int h = 0; h < 4; ++h) q[h] = *(const LAS f32x4*)(Q + h * 64 + 4 * sub);
#pragma unroll
        for (int u = 0; u < 4; ++u) { const int kw = 4 * (wave + 8 * (base + u)) + slot;
            if (kw != 511) { st_nt(ow + (size_t)kw * 256, kk[u]); st_nt(ow + (size_t)kw * 256 + 128, vv[u]); }
            key_step(sw, q, kk[u], vv[u], true); __builtin_amdgcn_sched_barrier(0); } };
    auto load_slc = [&](f32x4 (&kk)[4], f32x4 (&vv)[4], int base) {
#pragma unroll
        for (int u = 0; u < 4; ++u) { const int it = base + u < 30 ? base + u : 29;
            const int key = 4 * (wave + 8 * it) + slot, blk = SEL[key >> 6], tok = key & 63;
            const float* p = cache + ((size_t)PT[blk >> 1] * PAGE + (blk & 1) * 64 + tok) * 512;
            kk[u] = ld_nt(p); vv[u] = ld_nt(p + 128); } };
    auto comp_slc = [&](const f32x4 (&kk)[4], const f32x4 (&vv)[4], int base) {
        f32x4 q[4];
#pragma unroll
        for (int h = 0; h < 4; ++h) q[h] = *(const LAS f32x4*)(Q + h * 64 + 4 * sub);
#pragma unroll
        for (int u = 0; u < 4; ++u) { key_step(ss, q, kk[u], vv[u], base + u < 30); __builtin_amdgcn_sched_barrier(0); } };
    load_win(kA, vA, 0);
    if (wave < 4) {
        const int n = lane & 31; const bool vis = lane < 32;
        float sc = 0.f;
#pragma unroll 8
        for (int d = 0; d < 64; ++d) sc += Q[wave * 64 + d] * KC[n * 65 + d];
        const float x = vis ? sc * 0.125f : -1e30f; float mx = x;
#pragma unroll
        for (int o = 1; o < 64; o <<= 1) mx = fmaxf(mx, __shfl_xor(mx, o));
        const float e = vis ? __expf(x - mx) : 0.f; const float sum = wave_sum(e);
        if (vis) P[wave * 32 + n] = e / fmaxf(sum, 1e-30f);
    }
    BAR_LDS();
    if (wave < 4) {
        float oc = 0.f;
#pragma unroll 8
        for (int nn = 0; nn < 32; ++nn) oc += P[wave * 32 + nn] * VC[nn * 64 + lane];
        OC[wave * 64 + lane] = oc;
        if (wave == 0) {
            const int n = lane & 31;
            const float imp = lane < 32 ? (P[n] + P[32 + n]) + (P[64 + n] + P[96 + n]) : 0.f;
            const bool inarr = lane < 33, forced = inarr && (lane == 0 || lane >= 31);
            const float score = !inarr ? -2.f : imp + (forced ? 1000.f : 0.f);
            int rank = 0;
#pragma unroll 8
            for (int j = 0; j < 64; ++j) { const float sj = __shfl(score, j); rank += (sj > score || (sj == score && j < lane)) ? 1 : 0; }
            const bool selj = inarr && rank < 16;
            const unsigned long long mask = __ballot(selj);
            if (selj && lane < 32) SEL[__popcll(mask & ((1ull << lane) - 1ull))] = lane;
        }
    }
#pragma unroll 1
    for (int base = 0; base < 16; base += 8) {
        load_win(kB, vB, base + 4); comp_win(kA, vA, base);
        if (base == 0) { load_win(kA, vA, 8); comp_win(kB, vB, 4); }
    }
    BAR_LDS();
    load_slc(kA, vA, 0);  comp_win(kB, vB, 12);
    st_merge_xor(sw, 16); st_merge_xor(sw, 32);
    if (slot == 0) {
#pragma unroll
        for (int h = 0; h < 4; ++h) { LAS float* p1 = PART + (1 * 8 + wave) * PART_STRIDE + h * 68; *(LAS f32x4*)(p1 + 4 * sub) = sw.o[h]; if (sub == 0) { p1[64] = sw.m[h]; p1[65] = sw.l[h]; } }
    }
    st_init(ss);
#pragma unroll 1
    for (int base = 0; base < 32; base += 8) {
        load_slc(kB, vB, base + 4); comp_slc(kA, vA, base);
        load_slc(kA, vA, base + 8 < 32 ? base + 8 : 28); comp_slc(kB, vB, base + 4);
    }
    {   const float* nw = a.out + O_SNSA + (size_t)s * 512 + (4 + g) * 64 + 4 * sub;
        const f32x4 k4 = *(const GAS f32x4*)nw, v4 = *(const GAS f32x4*)(nw + 128);
        f32x4 q[4];
#pragma unroll
        for (int h = 0; h < 4; ++h) q[h] = *(const LAS f32x4*)(Q + h * 64 + 4 * sub);
        key_step(ss, q, k4, v4, wave == 0 && slot == 0); }
    st_merge_xor(ss, 16); st_merge_xor(ss, 32);
    if (slot == 0) {
#pragma unroll
        for (int h = 0; h < 4; ++h) { LAS float* p0 = PART + (0 * 8 + wave) * PART_STRIDE + h * 68; *(LAS f32x4*)(p0 + 4 * sub) = ss.o[h]; if (sub == 0) { p0[64] = ss.m[h]; p0[65] = ss.l[h]; } }
    }
    BAR_LDS();
    if (tid < 256) {
        const int h = tid >> 6, d = tid & 63;
        float res[2];
#pragma unroll
        for (int br = 0; br < 2; ++br) {
            float M = -1e30f;
#pragma unroll
            for (int w = 0; w < 8; ++w) M = fmaxf(M, PART[(br * 8 + w) * PART_STRIDE + h * 68 + 64]);
            float L = 0.f, O = 0.f;
#pragma unroll
            for (int w = 0; w < 8; ++w) { const LAS float* pp = PART + (br * 8 + w) * PART_STRIDE + h * 68; const float sc = fast_exp2((pp[64] - M) * C2); L += pp[65] * sc; O += pp[d] * sc; }
            res[br] = O / fmaxf(L, 1e-30f);
        }
        const float* GL = (const float*)(ws + WS_GL) + row * 24 + (g * 4 + h) * 3;
        const float gc = 1.f / (1.f + __expf(-GL[0])), gs = 1.f / (1.f + __expf(-GL[1])), gw = 1.f / (1.f + __expf(-GL[2]));
        const float y = gc * OC[h * 64 + d] + gs * res[0] + gw * res[1];
        MIXp[row * DM + 512 + (g * 4 + h) * 64 + d] = (bf16)(pk2(y, 0.f) & 0xffffu);
    }
    __syncthreads();
}
}
constexpr int CW_DIAG = 8192;
__device__ __forceinline__ float* diag_ptr(const Args& a) { return (float*)(a.ws + WS_CTL) + CW_DIAG; }
__device__ __forceinline__ void diag_add(const Args& a, int slot, float v, int lane) { v = wave_sum(v); if (lane == 0) atomicAdd(diag_ptr(a) + slot, v); }
__device__ __forceinline__ void diag_emit_one(const Args& a, size_t off, size_t cap, float value, int tid) {
    size_t n = value <= 0.f ? 0 : (value >= (float)cap ? cap : (size_t)value);
    unsigned* o = (unsigned*)(a.out + off);
    for (size_t i = tid; i < n; i += NTHREADS) o[i] = 0xAAAAAAAAu;
}
__device__ __forceinline__ void diag_cmp_bf16(const Frame& F, const Args& a, const bf16* x, const bf16* y, int ld, int nrows, int c0, int nc, int slot) {
    float num = 0.f, den = 0.f;
    const size_t total = (size_t)nrows * nc;
    for (size_t i = (size_t)F.bid * NTHREADS + F.tid; i < total; i += (size_t)F.G * NTHREADS) {
        const size_t r = i / nc, c = c0 + i % nc; const float xv = bf2f(x[r * ld + c]), yv = bf2f(y[r * ld + c]);
        num += (xv - yv) * (xv - yv); den += yv * yv;
    }
    diag_add(a, slot, num, F.lane); diag_add(a, slot + 1, den, F.lane);
}
__device__ __forceinline__ void diag_cmp_f32(const Frame& F, const Args& a, const float* x, const float* y, size_t n, int slot) {
    float num = 0.f, den = 0.f;
    for (size_t i = (size_t)F.bid * NTHREADS + F.tid; i < n; i += (size_t)F.G * NTHREADS) { const float xv = x[i], yv = y[i]; num += (xv - yv) * (xv - yv); den += yv * yv; }
    diag_add(a, slot, num, F.lane); diag_add(a, slot + 1, den, F.lane);
}
constexpr int N_PHASES = 12;
#ifndef PROBE_TIME
#define PROBE_TIME 0
#endif
#ifndef PROBE_PH0
#define PROBE_PH0 0
#endif
#ifndef PROBE_XBAR
#define PROBE_XBAR 0
#endif
#ifndef PROBE_NSA2
#define PROBE_NSA2 0
#endif
#ifndef PROBE_SNSA
#define PROBE_SNSA 0
#endif
#ifndef PROBE_CMP
#define PROBE_CMP 0
#endif
#ifndef PROBE_MEM
#define PROBE_MEM 0
#endif
#ifndef PROBE_DN
#define PROBE_DN 0
#endif
template <int LO, int HI> __global__ void __launch_bounds__(NTHREADS, 2) fwd(Args a) {
    extern __shared__ __attribute__((aligned(16))) unsigned char lds_raw[];
    Frame F; F.lds = (LAS unsigned char*)lds_raw; F.tid = threadIdx.x; F.lane = F.tid & 63; F.wave = __builtin_amdgcn_readfirstlane(F.tid >> 6); F.G = gridDim.x; F.bid = blockIdx.x;
    volatile LAS unsigned* MISC = (volatile LAS unsigned*)(F.lds + MISC_OFF);
    for (int u = F.tid; u < (LDS_BYTES - MISC_OFF) / 4; u += NTHREADS) ((LAS unsigned*)(F.lds + MISC_OFF))[u] = 0u;
    __syncthreads();
    constexpr int lo = LO, hi = HI;
    unsigned* barw = (unsigned*)(a.ws + WS_CTL) + CW_BAR;
    XcdBarrier bar; bar.bar = barw; bar.x = 0; bar.st = nullptr;
    if (hi - lo > 1) bar = xcd_barrier_post(barw, MISC + 8);
#define IN(k) (lo <= (k) && (k) < hi)
#define REFRAME() do { int t_ = threadIdx.x; asm volatile("" : "+v"(t_)); F.tid = t_; F.lane = t_ & 63; F.wave = __builtin_amdgcn_readfirstlane(t_ >> 6); } while (0)
#if PROBE_TIME
#define STAMP(k) do { if (blockIdx.x == 0 && threadIdx.x == 0) ((unsigned long long*)(a.ws + WS_CTL + 65536))[k] = __builtin_amdgcn_s_memrealtime(); } while (0)
#else
#define STAMP(k) do { } while (0)
#endif
#define SEAM(k) do { if (IN(k) && IN((k) + 1)) xcd_barrier(bar); STAMP((k) + 1); } while (0)
    unsigned char* ws = a.ws;
    STAMP(0);

    if (IN(0)) { REFRAME(); p0_prologue(F, a); }
    SEAM(0);
    if (IN(1)) { REFRAME();
#define P1_COMPRESS() do { for (int u = F.bid; u < 256; u += F.G) cmp::unit<true>(a, F.lds, u >> 1, u & 1, 0, F.tid, (float*)(ws + WS_KCMP_S), (float*)(ws + WS_KCMP_P), 0); __syncthreads(); } while (0)
        if (F.bid & 1) P1_COMPRESS();
        { pg8::Gemm g{(const bf16*)(ws + WS_XB), (const bf16*)(ws + WS_WIN_T), MP, NPROJ_PAD, DM}; SubOrder S; S.init(MP, 12, F.G, F.bid, 6, 2);
          Epi<0> E{a.out, ws, a.in[I_XP], a.in[I_XS]};
          pg8::gemm_phase<Epi<0>, SubOrder, true, true>(F.lds, g, S, E); }
        __syncthreads();
        for (int u = F.bid; u < NPROJ_PAD / 16; u += F.G) sg::unit<0, 8>(a, F.lds, (const bf16*)(ws + WS_XB), (const bf16*)(ws + WS_WIN_T), DM, u, F.tid);
        if (!(F.bid & 1)) { __syncthreads(); P1_COMPRESS(); }
    }
    SEAM(1);
    if (IN(2)) { REFRAME();
        const int pm = a.ph_hi;
        sample_copies(F, a);
        if ((pm & 1) && F.bid >= 32 && F.bid < 112) {
            for (int it = (F.bid - 32) * NWAVES + F.wave; it < DBATCH * 8; it += 80 * NWAVES) sample_dn_wave(a, it >> 3, it & 7, F.lane);
        }
        if (pm & 2) vt_phase(F, a);
        if (F.bid < F.G - 16) { p1_late_transposes(F, a, F.bid * NWAVES + F.wave, (F.G - 16) * NWAVES); }
        __syncthreads();
        {
          pg8::Gemm g{(const bf16*)(ws + WS_XB), (const bf16*)(ws + WS_WIN_T), MP, NPROJ_PAD, DM}; SubOrder S; S.init(MP, 2, F.G, (F.bid + F.G - 112) % F.G, 0, 6);
          Epi<0> E{a.out, ws, a.in[I_XP], a.in[I_XS]};
          pg8::gemm_phase<Epi<0>, SubOrder, true, true>(F.lds, g, S, E); }
        {
          pg8::Gemm g{(const bf16*)(ws + WS_MB), (const bf16*)(ws + WS_WMKV_T), 1024, 2048, DM}; pg8::StaticOrder S; S.init(1024, 2048, F.G, F.bid);
          Epi<1> E{a.out, ws, a.in[I_XP], a.in[I_XS]};
          pg8::gemm_phase<Epi<1>, pg8::StaticOrder, false, true>(F.lds, g, S, E); }
        __syncthreads();
#define P2_COMPRESS() do { if (pm & 4) { const int var = a.ph_lo; float* kcs = var ? (float*)(ws + WS_DBG) : (float*)(ws + WS_KCMP_S), *kcp = var ? (float*)(ws + WS_DBG2) : (float*)(ws + WS_KCMP_P); \
          if (F.bid >= F.G - 16) { const int v = F.bid - (F.G - 16); cmp::unit<false>(a, F.lds, v >> 2, (v >> 1) & 1, v & 1, F.tid, kcs, kcp, var); } \
          } } while (0)
#define P2_PREP() do { if (pm & 8) for (int u = F.bid; u < NB * NCHUNK; u += F.G) { \
            dn::prep_wave(a, F.lds + F.wave * 18432, u >> 6, u & 63, F.wave, F.lane); __syncthreads(); } } while (0)
        if (F.bid & 1) { P2_COMPRESS(); P2_PREP(); } else { P2_PREP(); P2_COMPRESS(); }
    }
    SEAM(3);
    if (IN(4)) { REFRAME();
        unsigned* ctr = (unsigned*)(ws + WS_CTL) + CW_WQ;
        LAS int* slot = (LAS int*)(F.lds + MISC_OFF + 64);
        for (;;) {
            __syncthreads();
            if (F.tid == 0) *slot = (int)atomicAdd(ctr, 1u);
            __syncthreads();
            const int it = *slot;
            if (it >= 800) break;
            if (it < a.ph_lo || it >= a.ph_hi) continue;
            if (it < 32) dn::scan_unit(a, F.lds, it >> 3, it & 7, F.tid, (bf16*)(ws + WS_MIX), a.out + O_PREC);
            else if (it < 32 + 256) { const int u = it - 32, qt = 63 - (u >> 3), bg = u & 7; nsa::unit(a, F.lds, bg >> 1, bg & 1, qt, (bf16*)(ws + WS_MIX), F.tid); }
            else if (it < 32 + 512) { const int u = it - 288; snsa::unit(a, F.lds, u >> 1, u & 1, F.tid, (bf16*)(ws + WS_MIX)); }
            else { const int u = it - 544 + 256, qt = 63 - (u >> 3), bg = u & 7; nsa::unit(a, F.lds, bg >> 1, bg & 1, qt, (bf16*)(ws + WS_MIX), F.tid); }
        }
    }
#if PROBE_NSA2
    if (IN(4)) { __syncthreads(); const int gw = F.bid * NWAVES + F.wave, NGW = F.G * NWAVES; LAS float* scr = (LAS float*)(F.lds + F.wave * 16384);
        for (int r = gw; r < DBATCH * 2; r += NGW) { const int tok = MP + (r >> 1), g = r & 1; nv_nsa_token(a, scr, false, tok - MP, g, PAST, tok, F.lane, (bf16*)(ws + WS_DBG)); } }
#endif
    SEAM(4);
#if PROBE_NSA2
    if (IN(5)) { diag_cmp_bf16(F, a, (const bf16*)(ws + WS_MIX) + (size_t)MP * DM, (const bf16*)(ws + WS_DBG) + (size_t)MP * DM, DM, DBATCH, 512, 512, 0); }
#endif
#if PROBE_SNSA
    if (IN(5)) { diag_cmp_bf16(F, a, (const bf16*)(ws + WS_DBG) + (size_t)MP * DM, (const bf16*)(ws + WS_MIX) + (size_t)MP * DM, DM, DBATCH, 512, 512, 0); }
#endif
#if PROBE_DN
    if (IN(5)) { REFRAME(); diag_cmp_bf16(F, a, (const bf16*)(ws + WS_DBG), (const bf16*)(ws + WS_MIX), DM, MP, 0, 512, 0);
                 diag_cmp_f32(F, a, (const float*)(ws + WS_DBG2), a.out + O_PREC, (size_t)NB * 8 * 4096, 2); }
#endif
    if (IN(5)) { REFRAME(); pg8::Gemm g{(const bf16*)(ws + WS_MIX), (const bf16*)(ws + WS_WOUT_T), MP, DM, DM}; pg8::StaticOrder S; S.init(MP, DM, F.G, F.bid);
        Epi<2> E{a.out, ws, a.in[I_XP], a.in[I_XS]}; pg8::gemm_phase<Epi<2>, pg8::StaticOrder, true, true>(F.lds, g, S, E);
        for (int u = F.G - 1 - F.bid; u < DM / 4; u += F.G) sg::unit<2, 2>(a, F.lds, (const bf16*)(ws + WS_MIX), (const bf16*)(ws + WS_WOUT_T), DM, u, F.tid); }
    SEAM(5);
    if (IN(6)) { REFRAME(); pg8::Gemm g{(const bf16*)(ws + WS_X1B), (const bf16*)(ws + WS_WMQ_T), MP, DM, DM}; pg8::StaticOrder S; S.init(MP, DM, F.G, F.bid);
        Epi<3> E{a.out, ws, a.in[I_XP], a.in[I_XS]}; pg8::gemm_phase<Epi<3>, pg8::StaticOrder, true, true>(F.lds, g, S, E);
        for (int u = F.G - 1 - F.bid; u < DM / 4; u += F.G) sg::unit<3, 2>(a, F.lds, (const bf16*)(ws + WS_X1B), (const bf16*)(ws + WS_WMQ_T), DM, u, F.tid); }
    SEAM(6);
    if (IN(7)) { REFRAME();
#if PROBE_MEM
        { const int gw = F.bid * NWAVES + F.wave, NGW = F.G * NWAVES; LAS float* scr = (LAS float*)(F.lds + F.wave * 16384);
          for (int it = gw; it < (MP + DBATCH) * 4; it += NGW) nv_mem_attn(a, scr, it >> 2, it & 3, F.lane); __syncthreads(); }
        bf16* OMp = (bf16*)(ws + WS_DBG);
#else
        bf16* OMp = (bf16*)(ws + WS_OM);
#endif
        if (F.bid & 1) for (int u = F.bid; u < 512; u += F.G) mem::sample_unit(a, F.lds, u >> 2, u & 3, F.tid, OMp);
        for (int u = F.bid; u < 512; u += F.G) mem::prompt_unit(a, F.lds, u >> 7, (u >> 5) & 3, u & 31, F.tid, OMp);
        if (!(F.bid & 1)) for (int u = F.bid; u < 512; u += F.G) mem::sample_unit(a, F.lds, u >> 2, u & 3, F.tid, OMp);
    }
    SEAM(7);
#if PROBE_MEM
    if (IN(8)) { diag_cmp_bf16(F, a, (const bf16*)(ws + WS_DBG), (const bf16*)(ws + WS_OM), DM, MP, 0, 1024, 0);
                 diag_cmp_bf16(F, a, (const bf16*)(ws + WS_DBG) + (size_t)MP * DM, (const bf16*)(ws + WS_OM) + (size_t)MP * DM, DM, DBATCH, 0, 1024, 2); }
#endif
    if (IN(8)) { REFRAME(); pg8::Gemm g{(const bf16*)(ws + WS_OM), (const bf16*)(ws + WS_WMO_T), MP, DM, DM}; pg8::StaticOrder S; S.init(MP, DM, F.G, F.bid);
        Epi<4> E{a.out, ws, a.in[I_XP], a.in[I_XS]}; pg8::gemm_phase<Epi<4>, pg8::StaticOrder, true, true>(F.lds, g, S, E);
        for (int u = F.G - 1 - F.bid; u < DM / 4; u += F.G) sg::unit<4, 2>(a, F.lds, (const bf16*)(ws + WS_OM), (const bf16*)(ws + WS_WMO_T), DM, u, F.tid); }
    SEAM(8);
    if (IN(9)) { REFRAME(); pg8::Gemm g{(const bf16*)(ws + WS_X2B), (const bf16*)(ws + WS_WUP_T), MP, DFF, DM}; pg8::StaticOrder S; S.init(MP, DFF, F.G, F.bid);
        Epi<5> E{a.out, ws, a.in[I_XP], a.in[I_XS]}; pg8::gemm_phase<Epi<5>, pg8::StaticOrder, true, true>(F.lds, g, S, E);
        for (int u = F.G - 1 - F.bid; u < DFF / 16; u += F.G) sg::unit<5, 8>(a, F.lds, (const bf16*)(ws + WS_X2B), (const bf16*)(ws + WS_WUP_T), DM, u, F.tid); }
    SEAM(9);
    if (IN(10)) { REFRAME(); pg8::Gemm g{(const bf16*)(ws + WS_UP), (const bf16*)(ws + WS_WDN_T), MP, DM, DFF}; pg8::StaticOrder S; S.init(MP, DM, F.G, F.bid);
        EpiFinal E{a.out, ws, a.in[I_LNF]}; pg8::gemm_phase<EpiFinal, pg8::StaticOrder, false, true>(F.lds, g, S, E);
        __syncthreads();
        for (int u = F.G - 1 - F.bid; u < DM / 4; u += F.G) sg::unit<6, 2>(a, F.lds, (const bf16*)(ws + WS_UP), (const bf16*)(ws + WS_WDN_T), DFF, u, F.tid); }
#if PROBE_NSA2
    if (hi - lo > 1) { xcd_barrier(bar);
        if (F.bid == 0) { const float* dg = diag_ptr(a); const float num = __hip_atomic_load(dg + 0, __ATOMIC_RELAXED, __HIP_MEMORY_SCOPE_AGENT), den = __hip_atomic_load(dg + 1, __ATOMIC_RELAXED, __HIP_MEMORY_SCOPE_AGENT);
            diag_emit_one(a, O_SWIN, 16000000, 1.f + 1e6f * num / fmaxf(den, 1e-30f), threadIdx.x);
            diag_emit_one(a, O_PNSA, 8000000, den, threadIdx.x); } }
#endif
#if PROBE_XBAR
    if (hi - lo > 1) for (int i = 0; i < PROBE_XBAR; ++i) xcd_barrier(bar);
#endif
#if PROBE_TIME
    xcd_barrier(bar); STAMP(12);
    if (blockIdx.x == 0) { __syncthreads();
        const unsigned long long* ts = (const unsigned long long*)(a.ws + WS_CTL + 65536);
        const size_t offs[11] = {O_YP, O_YS, O_PNSA, O_PWIN, O_PMEM, O_PCONV, O_PREC, O_SNSA, O_SWIN, O_SCONV, O_SREC};
        const size_t caps[11] = {16000000, 131000, 8000000, 524000, 2000000, 18000, 131000, 65000, 16000000, 589000, 4000000};
        const int PH[11] = {PROBE_PH0, PROBE_PH0 + 1, PROBE_PH0 + 2, PROBE_PH0 + 3, PROBE_PH0 + 4, PROBE_PH0 + 5, PROBE_PH0 + 6, PROBE_PH0 + 7, PROBE_PH0 + 8, PROBE_PH0 + 9, PROBE_PH0 + 10};
        for (int j = 0; j < 11; ++j) { const int ph = PH[j]; if (ph > 11) continue; const float us = (float)(ts[ph + 1] - ts[ph]) * 0.01f; diag_emit_one(a, offs[j], caps[j], us, threadIdx.x); } }
#endif
#undef IN
#undef SEAM
}

template <int LO, int HI> static bool launch_range(int& grid, const Args& a, hipStream_t stream) {
    static bool prepared = false;
    if (!prepared) { if (hipFuncSetAttribute((const void*)fwd<LO, HI>, hipFuncAttributeMaxDynamicSharedMemorySize, LDS_BYTES) != hipSuccess) { fprintf(stderr, "kernel_launch: hipFuncSetAttribute failed\n"); return false; } prepared = true; }
    hipLaunchKernelGGL((fwd<LO, HI>), dim3(grid), dim3(NTHREADS), LDS_BYTES, stream, a);
    return hipPeekAtLastError() == hipSuccess;
}
extern "C" void kernel_launch(void* const* d_in, const int* in_sizes, int n_in, void* d_out, int out_size, void* d_ws, size_t ws_size, hipStream_t stream) {
    static int grid = 0;
    if (grid == 0) {
        if (n_in != N_IN || (size_t)out_size != O_END || ws_size < WS_END) { fprintf(stderr, "kernel_launch: unexpected shapes n_in %d out %d ws %zu\n", n_in, out_size, ws_size); grid = -1; return; }
        int dev = 0, cus = 0;
        if (hipGetDevice(&dev) != hipSuccess || hipDeviceGetAttribute(&cus, hipDeviceAttributeMultiprocessorCount, dev) != hipSuccess) { grid = -1; return; }
        grid = cus < 256 ? cus : 256;
    }
    if (grid < 0) return;
    (void)hipMemsetAsync((char*)d_ws + WS_CTL, 0, CTL_ZERO_BYTES, stream);
    Args a{}; a.ph_lo = 0; a.ph_hi = 0xFFFF;
    for (int i = 0; i < N_IN; ++i) a.in[i] = (const float*)d_in[i];
    a.out = (float*)d_out; a.ws = (unsigned char*)d_ws;
#ifndef MK_ONE_LAUNCH
#define MK_ONE_LAUNCH 1
#endif
#if MK_ONE_LAUNCH
    launch_range<0, 12>(grid, a, stream);
#else
#ifndef PROBE_DUP
#define PROBE_DUP 0
#endif
#ifndef PROBE_WQLO
#define PROBE_WQLO 0
#define PROBE_WQHI 65535
#endif
#define LR(k) do { launch_range<k, k + 1>(grid, a, stream); if (PROBE_DUP & (1 << k)) { Args a2 = a; if (k == 2) { a2.ph_hi = PROBE_WQHI; a2.ph_lo = PROBE_WQLO; } if (k == 4) { (void)hipMemsetAsync((char*)d_ws + WS_CTL + CW_WQ * 4, 0, 4, stream); a2.ph_lo = PROBE_WQLO; a2.ph_hi = PROBE_WQHI; } launch_range<k, k + 1>(grid, a2, stream); } } while (0)
    LR(0); LR(1); LR(2); LR(3); LR(4); LR(5); LR(6); LR(7); LR(8); LR(9); LR(10); LR(11);
#endif
}
```
